# Optimizing an MI355X kernel written in HIP

```python
import jax, jax.numpy as jnp
from jax import lax
import numpy as np

D_MODEL = 1024
BATCH = 32
SEQ = 256
DEPTH = 1
DEC_BATCH = 2
DEC_SEQ = 2048
PAST_LEN = 512

GRID_W = 64
H_RET = 4
HD_RET = 128
W_RET = H_RET * HD_RET
H_ML = 4
HD_ML = 128
W_ML = H_ML * HD_ML
MIX_W = W_RET + W_ML
N_DIR = 2
IN_COLS = 4 * W_RET + 4 * W_ML + 2 * N_DIR * H_ML
D_FF = 4 * D_MODEL
CHUNK = 128
CONV_W = 3
EPS = 1e-6
ROPE_BASE = 10000.0
F32 = jnp.float32

kernel_name = 'bidir_retention_mlstm_hybrid_dit_step'


def rms_norm(x, g):
    xf = x.astype(F32)
    y = xf * lax.rsqrt(jnp.mean(xf * xf, -1, keepdims=True) + EPS)
    return (y * g.astype(F32)).astype(x.dtype)


def group_norm(h, g):
    hf = h.astype(F32)
    mu = jnp.mean(hf, -1, keepdims=True)
    var = jnp.mean(jnp.square(hf - mu), -1, keepdims=True)
    y = (hf - mu) * lax.rsqrt(var + EPS)
    B, T, H, D = h.shape
    return y.reshape(B, T, H * D) * g.astype(F32)


def axial_rope(x):
    T, D = x.shape[1], x.shape[-1]
    rows = T // GRID_W
    row = jnp.repeat(jnp.arange(rows), GRID_W).astype(F32)
    col = jnp.tile(jnp.arange(GRID_W), rows).astype(F32)
    nf = D // 4
    inv = ROPE_BASE ** (-jnp.arange(nf, dtype=F32) / nf)
    ang = jnp.concatenate([row[:, None] * inv, col[:, None] * inv], -1)
    cos = jnp.cos(ang)[None, :, None, :]
    sin = jnp.sin(ang)[None, :, None, :]
    xf = x.astype(F32)
    x1, x2 = xf[..., :D // 2], xf[..., D // 2:]
    return jnp.concatenate([x1 * cos - x2 * sin, x1 * sin + x2 * cos], -1)


def centred_conv(x, w):
    pad = CONV_W // 2
    T = x.shape[1]
    xp = jnp.pad(x, ((0, 0), (pad, pad), (0, 0)))
    out = xp[:, 0:T] * w[0]
    for j in range(1, CONV_W):
        out = out + xp[:, j:j + T] * w[j]
    return out


def to_chunks(a):
    B, H, T = a.shape[:3]
    n = T // CHUNK
    a = a.reshape((B, H, n, CHUNK) + a.shape[3:])
    return jnp.moveaxis(a, 2, 0)


def from_chunks(a):
    n, B, H, L, D = a.shape
    return jnp.moveaxis(a, 0, 2).reshape(B, H, n * L, D)


def retention_scan(q, k, v, log_gamma, s0):
    idx = jnp.arange(CHUNK, dtype=F32)
    lg = log_gamma.astype(F32)[:, None]
    diff = idx[:, None] - idx[None, :]
    mask = diff >= 0
    intra = jnp.where(mask, jnp.exp(lg[:, :, None] * jnp.where(mask, diff, 0.0)), 0.0)
    inter = jnp.exp(lg * (idx + 1.0))
    to_end = jnp.exp(lg * (CHUNK - 1.0 - idx))
    chunk_decay = jnp.exp(lg[:, 0] * CHUNK)

    def step(s, xs):
        qi, ki, vi = xs
        sc = jnp.einsum('bhtd,bhsd->bhts', qi, ki) * intra
        o = jnp.einsum('bhts,bhse->bhte', sc, vi) + jnp.einsum('bhtd,bhde->bhte', qi, s) * inter[..., None]
        s_new = s * chunk_decay[:, None, None] + jnp.einsum('bhsd,bhse->bhde', ki * to_end[..., None], vi)
        return s_new, o

    s_fin, oc = lax.scan(step, s0.astype(F32), (to_chunks(q), to_chunks(k), to_chunks(v)))
    return from_chunks(oc), s_fin


def mlstm_scan(q, k, v, log_i, log_f, C0, n0, m0):
    causal = jnp.tril(jnp.ones((CHUNK, CHUNK), bool))

    def step(carry, xs):
        C, nv, m = carry
        qi, ki, vi, li, lf = xs
        b = jnp.cumsum(lf, -1)
        log_inter = b + m[..., None]
        log_intra = jnp.where(causal, b[..., :, None] - b[..., None, :] + li[..., None, :], -jnp.inf)
        m_t = jnp.maximum(log_inter, jnp.max(log_intra, -1))
        w_inter = jnp.exp(log_inter - m_t)
        w_intra = jnp.exp(log_intra - m_t[..., None])
        sc = jnp.einsum('bhtd,bhsd->bhts', qi, ki) * w_intra
        num = jnp.einsum('bhts,bhse->bhte', sc, vi) + jnp.einsum('bhtd,bhde->bhte', qi, C) * w_inter[..., None]
        den = jnp.sum(sc, -1) + jnp.einsum('bhtd,bhd->bht', qi, nv) * w_inter
        h = num / jnp.maximum(jnp.abs(den), jnp.exp(-m_t))[..., None]
        b_end = b[..., -1]
        log_w_end = b_end[..., None] - b + li
        m_new = jnp.maximum(b_end + m, jnp.max(log_w_end, -1))
        decay = jnp.exp(b_end + m - m_new)
        w_end = jnp.exp(log_w_end - m_new[..., None])
        C_new = C * decay[..., None, None] + jnp.einsum('bhs,bhsd,bhse->bhde', w_end, ki, vi)
        n_new = nv * decay[..., None] + jnp.einsum('bhs,bhsd->bhd', w_end, ki)
        return (C_new, n_new, m_new), h

    xs = (to_chunks(q), to_chunks(k), to_chunks(v), to_chunks(log_i), to_chunks(log_f))
    (C_f, n_f, m_f), hc = lax.scan(step, (C0.astype(F32), n0.astype(F32), m0.astype(F32)), xs)
    return from_chunks(hc), C_f, n_f, m_f


def flip_t(a):
    return jnp.flip(a, axis=2)


def mixer(h, init, latent, w_in, conv_w, ret_decay_logit, mlstm_gate_bias, ret_gn_g, mlstm_gn_g, w_out):
    B, T, _ = h.shape
    s_ret0, C0, n0, m0 = init
    proj = h @ w_in
    cuts = [W_RET, 2 * W_RET, 3 * W_RET, 4 * W_RET, 4 * W_RET + 2 * W_ML, 4 * W_RET + 3 * W_ML, 4 * W_RET + 4 * W_ML]
    rq, rk, rv, rg, mqk, mv, mo, mgate = jnp.split(proj, cuts, axis=-1)

    rq = rq.reshape(B, T, H_RET, HD_RET)
    rk = rk.reshape(B, T, H_RET, HD_RET) * (HD_RET ** -0.5)
    if latent:
        rq, rk = axial_rope(rq), axial_rope(rk)
    q = jnp.transpose(rq.astype(F32), (0, 2, 1, 3))
    k = jnp.transpose(rk.astype(F32), (0, 2, 1, 3))
    v = jnp.transpose(rv.reshape(B, T, H_RET, HD_RET).astype(F32), (0, 2, 1, 3))
    log_gamma = jax.nn.log_sigmoid(ret_decay_logit.astype(F32))
    o_f, s_f = retention_scan(q, k, v, log_gamma[0], s_ret0[:, 0])
    o_b, s_b = retention_scan(flip_t(q), flip_t(k), flip_t(v), log_gamma[1], s_ret0[:, 1])
    o_ret = o_f + flip_t(o_b)
    ret_y = group_norm(jnp.transpose(o_ret, (0, 2, 1, 3)), ret_gn_g) * jax.nn.silu(rg.astype(F32))

    mqk = jax.nn.silu(centred_conv(mqk, conv_w))
    mq, mk = jnp.split(mqk, 2, axis=-1)
    q = jnp.transpose(mq.reshape(B, T, H_ML, HD_ML).astype(F32), (0, 2, 1, 3))
    k = jnp.transpose(mk.reshape(B, T, H_ML, HD_ML).astype(F32), (0, 2, 1, 3)) * (HD_ML ** -0.5)
    v = jnp.transpose(mv.reshape(B, T, H_ML, HD_ML).astype(F32), (0, 2, 1, 3))
    gates = mgate.astype(F32).reshape(B, T, N_DIR, 2, H_ML) + mlstm_gate_bias.astype(F32)
    gates = jnp.transpose(gates, (2, 3, 0, 4, 1))
    log_i = gates[:, 0]
    log_f = jax.nn.log_sigmoid(gates[:, 1])
    h_f, C_f, n_f, m_f = mlstm_scan(q, k, v, log_i[0], log_f[0], C0[:, 0], n0[:, 0], m0[:, 0])
    h_b, C_b, n_b, m_b = mlstm_scan(flip_t(q), flip_t(k), flip_t(v), flip_t(log_i[1]), flip_t(log_f[1]),
                                    C0[:, 1], n0[:, 1], m0[:, 1])
    h_ml = h_f + flip_t(h_b)
    ml_y = group_norm(jnp.transpose(h_ml, (0, 2, 1, 3)), mlstm_gn_g) * jax.nn.sigmoid(mo.astype(F32))

    out = jnp.concatenate([ret_y, ml_y], -1).astype(h.dtype) @ w_out
    new_state = (jnp.stack([s_f, s_b], 1), jnp.stack([C_f, C_b], 1),
                 jnp.stack([n_f, n_b], 1), jnp.stack([m_f, m_b], 1))
    return out, new_state


def layer(x, cond, init, latent, w_ada, b_ada, norm1_g, norm2_g, w_in, conv_w, ret_decay_logit,
          mlstm_gate_bias, ret_gn_g, mlstm_gn_g, w_out, w_ff1, w_ff2):
    mod = (jax.nn.silu(cond) @ w_ada + b_ada)[:, None, :]
    sh1, sc1, g1, sh2, sc2, g2 = jnp.split(mod, 6, axis=-1)
    h = rms_norm(x, norm1_g) * (1 + sc1) + sh1
    a, st = mixer(h, init, latent, w_in, conv_w, ret_decay_logit, mlstm_gate_bias, ret_gn_g, mlstm_gn_g, w_out)
    x = x + g1 * a
    h = rms_norm(x, norm2_g) * (1 + sc2) + sh2
    f = jnp.square(jax.nn.relu(h @ w_ff1)) @ w_ff2
    x = x + g2 * f
    return x, st


def setup_inputs(seed: int = 0) -> dict:
    key = jax.random.key(seed)
    ks = jax.random.split(key, 26)

    def nrm(k, shape, s):
        return jax.random.normal(k, shape, F32) * s

    hidx = jnp.arange(H_RET, dtype=F32)
    gam = 1.0 - 2.0 ** (-5.0 - hidx)
    base_logit = jnp.log(gam) - jnp.log1p(-gam)
    f_bias = jnp.linspace(3.0, 6.0, H_ML, dtype=F32)
    i_b = nrm(ks[16], (DEPTH, N_DIR, 1, H_ML), 0.1)
    f_b = f_bias + nrm(ks[17], (DEPTH, N_DIR, 1, H_ML), 0.1)
    return {
        'x_prompt': nrm(ks[0], (BATCH, SEQ, D_MODEL), 1.0),
        'x_sample': nrm(ks[1], (DEC_BATCH, DEC_SEQ, D_MODEL), 1.0),
        'state_ret': nrm(ks[2], (DEC_BATCH, DEPTH, N_DIR, H_RET, HD_RET, HD_RET), 0.5),
        'state_mlstm_C': nrm(ks[3], (DEC_BATCH, DEPTH, N_DIR, H_ML, HD_ML, HD_ML), 0.5),
        'state_mlstm_n': nrm(ks[4], (DEC_BATCH, DEPTH, N_DIR, H_ML, HD_ML), 0.5),
        'state_mlstm_m': nrm(ks[5], (DEC_BATCH, DEPTH, N_DIR, H_ML), 0.5),
        'c': nrm(ks[6], (DEC_BATCH, D_MODEL), 1.0),
        'c_ctx': nrm(ks[7], (D_MODEL,), 1.0),
        'w_ada': nrm(ks[8], (DEPTH, D_MODEL, 6 * D_MODEL), 0.5 * D_MODEL ** -0.5),
        'b_ada': nrm(ks[9], (DEPTH, 6 * D_MODEL), 0.1),
        'norm1_g': 1.0 + nrm(ks[10], (DEPTH, D_MODEL), 0.05),
        'norm2_g': 1.0 + nrm(ks[11], (DEPTH, D_MODEL), 0.05),
        'w_in': nrm(ks[12], (DEPTH, D_MODEL, IN_COLS), D_MODEL ** -0.5),
        'conv_w': nrm(ks[13], (DEPTH, CONV_W, 2 * W_ML), CONV_W ** -0.5),
        'ret_decay_logit': base_logit + nrm(ks[14], (DEPTH, N_DIR, H_RET), 0.1),
        'mlstm_gate_bias': jnp.concatenate([i_b, f_b], axis=2),
        'ret_gn_g': 1.0 + nrm(ks[18], (DEPTH, W_RET), 0.05),
        'mlstm_gn_g': 1.0 + nrm(ks[19], (DEPTH, W_ML), 0.05),
        'w_out': nrm(ks[20], (DEPTH, MIX_W, D_MODEL), MIX_W ** -0.5),
        'w_ff1': nrm(ks[21], (DEPTH, D_MODEL, D_FF), D_MODEL ** -0.5),
        'w_ff2': nrm(ks[22], (DEPTH, D_FF, D_MODEL), D_FF ** -0.5),
        'final_g': 1.0 + nrm(ks[23], (D_MODEL,), 0.05),
    }


def reference(x_prompt, x_sample, state_ret, state_mlstm_C, state_mlstm_n, state_mlstm_m, c, c_ctx,
              w_ada, b_ada, norm1_g, norm2_g, w_in, conv_w, ret_decay_logit, mlstm_gate_bias,
              ret_gn_g, mlstm_gn_g, w_out, w_ff1, w_ff2, final_g):
    Bp = x_prompt.shape[0]
    ctx_cond = jnp.broadcast_to(c_ctx, (Bp, D_MODEL))
    zero_init = (jnp.zeros((Bp, N_DIR, H_RET, HD_RET, HD_RET), F32),
                 jnp.zeros((Bp, N_DIR, H_ML, HD_ML, HD_ML), F32),
                 jnp.zeros((Bp, N_DIR, H_ML, HD_ML), F32),
                 jnp.zeros((Bp, N_DIR, H_ML), F32))
    xp, xs = x_prompt, x_sample
    new_ret, new_C, new_n, new_m = [], [], [], []
    for l in range(DEPTH):
        lw = (w_ada[l], b_ada[l], norm1_g[l], norm2_g[l], w_in[l], conv_w[l], ret_decay_logit[l],
              mlstm_gate_bias[l], ret_gn_g[l], mlstm_gn_g[l], w_out[l], w_ff1[l], w_ff2[l])
        xp, st = layer(xp, ctx_cond, zero_init, False, *lw)
        new_ret.append(st[0]); new_C.append(st[1]); new_n.append(st[2]); new_m.append(st[3])
        cache = (state_ret[:, l], state_mlstm_C[:, l], state_mlstm_n[:, l], state_mlstm_m[:, l])
        xs, _ = layer(xs, c, cache, True, *lw)
    y_prompt = rms_norm(xp, final_g)
    y_sample = rms_norm(xs, final_g)
    return (y_prompt, y_sample, jnp.stack(new_ret, 1), jnp.stack(new_C, 1), jnp.stack(new_n, 1), jnp.stack(new_m, 1))
```

```cpp
#include <hip/hip_runtime.h>
#include <cstdint>
#include <cstdio>

typedef unsigned short bf16_t;

constexpr int D = 1024, NP = 32 * 256, NS = 2 * 2048, M = NP + NS;
constexpr int TP = 256, TS = 2048;
constexpr int INC = 4112, FF = 4096, NH = 4, HD = 128, W5 = 512;
constexpr float EPS = 1e-6f;

constexpr size_t MiB = 1u << 20;
constexpr size_t WS_CTL = 0;
constexpr size_t WS_MOD = 1 * MiB;
constexpr size_t WS_ROPE = 1 * MiB + 128 * 1024;
constexpr size_t WS_GATES = 2 * MiB;
constexpr size_t WS_GLI = 3 * MiB;
constexpr size_t WS_GCUM = 3 * MiB + 512 * 1024;
constexpr size_t WS_WIN = 4 * MiB;
constexpr size_t WS_WOUT = 12 * MiB;
constexpr size_t WS_W1 = 14 * MiB;
constexpr size_t WS_W2 = 22 * MiB;
constexpr size_t WS_H = 32 * MiB;
constexpr size_t WS_MIX = 56 * MiB;
constexpr size_t WS_RQ = 80 * MiB;
constexpr size_t WS_RK = 92 * MiB;
constexpr size_t WS_RV = 104 * MiB;
constexpr size_t WS_RG = 116 * MiB;
constexpr size_t WS_MQKP = 128 * MiB;
constexpr size_t WS_MV = 152 * MiB;
constexpr size_t WS_MO = 164 * MiB;
constexpr size_t WS_MQ = 176 * MiB;
constexpr size_t WS_MK = 188 * MiB;
constexpr size_t WS_U = 80 * MiB;
constexpr size_t WS_END = 200 * MiB;

constexpr size_t O_Y = 0;
constexpr size_t O_RET = (size_t)M * D;
constexpr size_t O_C = O_RET + (size_t)32 * 2 * 4 * 128 * 128;
constexpr size_t O_N = O_C + (size_t)32 * 2 * 4 * 128 * 128;
constexpr size_t O_M = O_N + (size_t)32 * 2 * 4 * 128;

__device__ __forceinline__ float bf2f(bf16_t v) { return __uint_as_float((unsigned)v << 16); }
__device__ __forceinline__ bf16_t f2bf(float f) { unsigned u = __float_as_uint(f); return (bf16_t)((u + 0x7fffu + ((u >> 16) & 1u)) >> 16); }
__device__ __forceinline__ float siluf(float x) { return x / (1.f + __expf(-x)); }
__device__ __forceinline__ float sigmf(float x) { return 1.f / (1.f + __expf(-x)); }
__device__ __forceinline__ float logsigf(float x) { return fminf(x, 0.f) - log1pf(__expf(-fabsf(x))); }
__device__ __forceinline__ int cond_of(int m) { return m < NP ? 0 : 1 + (m - NP) / TS; }

struct P {
    const float *xp, *xs, *st_ret, *st_C, *st_n, *st_m, *c, *cctx, *w_ada, *b_ada, *n1g, *n2g, *w_in, *conv_w, *decay, *gbias, *rgn, *mgn, *w_out, *w_ff1, *w_ff2, *fg;
    float* out; unsigned char* ws;
};
__device__ __forceinline__ const float* xrow(const P& p, int m) { return m < NP ? p.xp + (size_t)m * D : p.xs + (size_t)(m - NP) * D; }

__global__ void k_wt(const float* W, int ldw, int K, bf16_t* WT) {
    __shared__ float t[32][33];
    const int n0 = blockIdx.x * 32, k0 = blockIdx.y * 32, tx = threadIdx.x, ty = threadIdx.y;
    for (int i = ty; i < 32; i += 8) t[i][tx] = W[(size_t)(k0 + i) * ldw + n0 + tx];
    __syncthreads();
    for (int i = ty; i < 32; i += 8) WT[(size_t)(n0 + i) * K + k0 + tx] = f2bf(t[tx][i]);
}

__global__ void k_mod(P p) {
    const int j = blockIdx.x * 256 + threadIdx.x, cnd = blockIdx.y;
    const float* cv = cnd == 0 ? p.cctx : p.c + (size_t)(cnd - 1) * D;
    float acc = 0.f;
    for (int k = 0; k < D; ++k) acc += siluf(cv[k]) * p.w_ada[(size_t)k * 6144 + j];
    ((float*)(p.ws + WS_MOD))[cnd * 6144 + j] = acc + p.b_ada[j];
}

__global__ void k_rope(P p) {
    const int pos = blockIdx.x, f = threadIdx.x;
    const float inv = (float)exp(-(double)f / 32.0 * log(10000.0));
    const float ang = (float)pos * inv;
    float* rc = (float*)(p.ws + WS_ROPE);
    rc[pos * 32 + f] = (float)cos((double)ang);
    rc[2048 + pos * 32 + f] = (float)sin((double)ang);
}

__device__ __forceinline__ float block_sum256(float v, float* red) {
    for (int o = 32; o > 0; o >>= 1) v += __shfl_xor(v, o);
    __syncthreads();
    if ((threadIdx.x & 63) == 0) red[threadIdx.x >> 6] = v;
    __syncthreads();
    return red[0] + red[1] + red[2] + red[3];
}

__global__ void k_norm(P p, int which) {
    __shared__ float red[4];
    __shared__ float gsum[16][4];
    const int m = blockIdx.x, tid = threadIdx.x, cnd = cond_of(m);
    const float* xr = which == 0 ? xrow(p, m) : p.out + O_Y + (size_t)m * D;
    const float* mod = (const float*)(p.ws + WS_MOD) + cnd * 6144;
    const float* sh = mod + (which == 0 ? 0 : 3072);
    const float* sc = mod + (which == 0 ? 1024 : 4096);
    const float* g = which == 0 ? p.n1g : p.n2g;
    float v[4], ss = 0.f;
    for (int i = 0; i < 4; ++i) { v[i] = xr[tid + 256 * i]; ss += v[i] * v[i]; }
    ss = block_sum256(ss, red);
    const float rstd = rsqrtf(ss * (1.f / D) + EPS);
    bf16_t* H = (bf16_t*)(p.ws + WS_H) + (size_t)m * D;
    float h[4];
    for (int i = 0; i < 4; ++i) { const int k = tid + 256 * i; h[i] = v[i] * rstd * g[k] * (1.f + sc[k]) + sh[k]; H[k] = f2bf(h[i]); }
    if (which == 0) {
        float ga[16];
        for (int j = 0; j < 16; ++j) ga[j] = 0.f;
        for (int i = 0; i < 4; ++i) { const int k = tid + 256 * i; const float* wr = p.w_in + (size_t)k * INC + 4096;
            for (int j = 0; j < 16; ++j) ga[j] += h[i] * wr[j]; }
        for (int j = 0; j < 16; ++j) { float s = ga[j]; for (int o = 32; o > 0; o >>= 1) s += __shfl_xor(s, o); if ((tid & 63) == 0) gsum[j][tid >> 6] = s; }
        __syncthreads();
        if (tid < 16) ((float*)(p.ws + WS_GATES))[(size_t)m * 16 + tid] = gsum[tid][0] + gsum[tid][1] + gsum[tid][2] + gsum[tid][3] + p.gbias[tid];
    }
}

enum { EPI_PROJ = 0, EPI_RES1 = 1, EPI_RELU2 = 2, EPI_RES2 = 3 };
template <int EPI>
__global__ void __launch_bounds__(256) k_gemm(P p, const bf16_t* A, const bf16_t* WT, int K) {
    __shared__ float As[16][68];
    __shared__ float Bs[16][132];
    __shared__ float Cs[64][129];
    const int tid = threadIdx.x, m0 = blockIdx.y * 64, n0 = blockIdx.x * 128;
    const int ty = tid >> 4, tx = tid & 15;
    float acc[4][8];
    for (int i = 0; i < 4; ++i) for (int j = 0; j < 8; ++j) acc[i][j] = 0.f;
    for (int k0 = 0; k0 < K; k0 += 16) {
        { const int r = tid >> 2, kk = (tid & 3) * 4; const bf16_t* a = A + (size_t)(m0 + r) * K + k0 + kk;
          for (int j = 0; j < 4; ++j) As[kk + j][r] = bf2f(a[j]); }
        { const int r = tid >> 1, kk = (tid & 1) * 8; const bf16_t* b = WT + (size_t)(n0 + r) * K + k0 + kk;
          for (int j = 0; j < 8; ++j) Bs[kk + j][r] = bf2f(b[j]); }
        __syncthreads();
        for (int kk = 0; kk < 16; ++kk) {
            float a[4], b[8];
            for (int i = 0; i < 4; ++i) a[i] = As[kk][ty * 4 + i];
            for (int j = 0; j < 8; ++j) b[j] = Bs[kk][tx * 8 + j];
            for (int i = 0; i < 4; ++i) for (int j = 0; j < 8; ++j) acc[i][j] += a[i] * b[j];
        }
        __syncthreads();
    }
    for (int i = 0; i < 4; ++i) for (int j = 0; j < 8; ++j) Cs[ty * 4 + i][tx * 8 + j] = acc[i][j];
    __syncthreads();
    if (EPI == EPI_PROJ) {
        const int sec = n0 / 512, hc = n0 % 512;
        const float* rc = (const float*)(p.ws + WS_ROPE);
        for (int e = tid; e < 64 * 128; e += 256) {
            const int r = e >> 7, d = e & 127, m = m0 + r;
            float v = Cs[r][d];
            if (sec <= 1) {
                if (sec == 1) v *= 0.08838834764831845f;
                if (m >= NP) {
                    const int t = (m - NP) % TS, dd = d & 63, f = dd & 31, pos = dd < 32 ? t / 64 : t % 64;
                    const float cs = rc[pos * 32 + f], sn = rc[2048 + pos * 32 + f];
                    float o = Cs[r][d ^ 64]; if (sec == 1) o *= 0.08838834764831845f;
                    v = d < 64 ? v * cs - o * sn : o * sn + v * cs;
                }
                ((bf16_t*)(p.ws + (sec == 0 ? WS_RQ : WS_RK)))[(size_t)m * W5 + hc + d] = f2bf(v);
            } else if (sec == 2) ((bf16_t*)(p.ws + WS_RV))[(size_t)m * W5 + hc + d] = f2bf(v);
            else if (sec == 3) ((bf16_t*)(p.ws + WS_RG))[(size_t)m * W5 + hc + d] = f2bf(siluf(v));
            else if (sec <= 5) ((bf16_t*)(p.ws + WS_MQKP))[(size_t)m * 1024 + (n0 - 2048) + d] = f2bf(v);
            else if (sec == 6) ((bf16_t*)(p.ws + WS_MV))[(size_t)m * W5 + hc + d] = f2bf(v);
            else ((bf16_t*)(p.ws + WS_MO))[(size_t)m * W5 + hc + d] = f2bf(sigmf(v));
        }
    } else if (EPI == EPI_RES1) {
        for (int e = tid; e < 64 * 128; e += 256) { const int r = e >> 7, n = n0 + (e & 127), m = m0 + r;
            const float g1 = ((const float*)(p.ws + WS_MOD))[cond_of(m) * 6144 + 2048 + n];
            p.out[O_Y + (size_t)m * D + n] = xrow(p, m)[n] + g1 * Cs[r][e & 127]; }
    } else if (EPI == EPI_RELU2) {
        for (int e = tid; e < 64 * 128; e += 256) { const int r = e >> 7, n = n0 + (e & 127), m = m0 + r;
            const float v = fmaxf(Cs[r][e & 127], 0.f);
            ((bf16_t*)(p.ws + WS_U))[(size_t)m * FF + n] = f2bf(v * v); }
    } else {
        for (int e = tid; e < 64 * 128; e += 256) { const int r = e >> 7, n = n0 + (e & 127), m = m0 + r;
            const float g2 = ((const float*)(p.ws + WS_MOD))[cond_of(m) * 6144 + 5120 + n];
            p.out[O_Y + (size_t)m * D + n] += g2 * Cs[r][e & 127]; }
    }
}

__global__ void k_conv(P p) {
    const int m = blockIdx.x, T = m < NP ? TP : TS, t = m < NP ? m % TP : (m - NP) % TS;
    const bf16_t* X = (const bf16_t*)(p.ws + WS_MQKP);
    for (int c = threadIdx.x; c < 1024; c += 256) {
        float v = p.conv_w[1024 + c] * bf2f(X[(size_t)m * 1024 + c]);
        if (t > 0) v += p.conv_w[c] * bf2f(X[(size_t)(m - 1) * 1024 + c]);
        if (t < T - 1) v += p.conv_w[2048 + c] * bf2f(X[(size_t)(m + 1) * 1024 + c]);
        v = siluf(v);
        if (c < 512) ((bf16_t*)(p.ws + WS_MQ))[(size_t)m * W5 + c] = f2bf(v);
        else ((bf16_t*)(p.ws + WS_MK))[(size_t)m * W5 + c - 512] = f2bf(v * 0.08838834764831845f);
    }
}

__global__ void k_gates(P p) {
    const int id = blockIdx.x * 64 + threadIdx.x;
    if (id >= 34 * 8) return;
    const int seq = id / 8, h = id % 4, dir = (id / 4) % 2;
    const int T = seq < 32 ? TP : TS, mbase = seq < 32 ? seq * TP : NP + (seq - 32) * TS;
    const float* G = (const float*)(p.ws + WS_GATES);
    float* LI = (float*)(p.ws + WS_GLI) + (size_t)(dir * 4 + h) * M;
    float* CU = (float*)(p.ws + WS_GCUM) + (size_t)(dir * 4 + h) * M;
    float cum = 0.f;
    for (int i = 0; i < T; ++i) {
        const int m = mbase + (dir == 0 ? i : T - 1 - i);
        cum += logsigf(G[(size_t)m * 16 + dir * 8 + 4 + h]);
        CU[m] = cum; LI[m] = G[(size_t)m * 16 + dir * 8 + h];
    }
}

__global__ void __launch_bounds__(256) k_mix(P p) {
    __shared__ float qs[16][128];
    __shared__ float ks[32][129];
    __shared__ float vs[32][128];
    __shared__ float pf[16][32], pb[16][32];
    __shared__ float os[16][129];
    const int tid = threadIdx.x, m0 = blockIdx.x * 16, h = blockIdx.y, type = blockIdx.z;
    const bool lat = m0 >= NP;
    const int T = lat ? TS : TP, sb = lat ? NP + ((m0 - NP) / TS) * TS : (m0 / TP) * TP, t0 = m0 - sb;
    const bf16_t* Q = (const bf16_t*)(p.ws + (type == 0 ? WS_RQ : WS_MQ));
    const bf16_t* Kp = (const bf16_t*)(p.ws + (type == 0 ? WS_RK : WS_MK));
    const bf16_t* V = (const bf16_t*)(p.ws + (type == 0 ? WS_RV : WS_MV));
    const float lgf = logsigf(p.decay[h]), lgb = logsigf(p.decay[4 + h]);
    const float* LI0 = (const float*)(p.ws + WS_GLI) + (size_t)h * M;
    const float* LI1 = (const float*)(p.ws + WS_GLI) + (size_t)(4 + h) * M;
    const float* CU0 = (const float*)(p.ws + WS_GCUM) + (size_t)h * M;
    const float* CU1 = (const float*)(p.ws + WS_GCUM) + (size_t)(4 + h) * M;
    for (int e = tid; e < 16 * 128; e += 256) qs[e >> 7][e & 127] = bf2f(Q[(size_t)(m0 + (e >> 7)) * W5 + h * HD + (e & 127)]);
    const int e_ = tid & 127, rh = tid >> 7;
    float of[8], ob[8];
    for (int i = 0; i < 8; ++i) { of[i] = 0.f; ob[i] = 0.f; }
    float den = 0.f;
    for (int s0 = 0; s0 < T; s0 += 32) {
        __syncthreads();
        for (int e = tid; e < 32 * 128; e += 256) { const int s = e >> 7, d = e & 127; const size_t a = (size_t)(sb + s0 + s) * W5 + h * HD + d;
            ks[s][d] = bf2f(Kp[a]); vs[s][d] = bf2f(V[a]); }
        __syncthreads();
        for (int e = tid; e < 16 * 32; e += 256) {
            const int r = e >> 5, s = e & 31, t = t0 + r, sg = s0 + s;
            float dot = 0.f;
            for (int d = 0; d < 128; ++d) dot += qs[r][d] * ks[s][d];
            float wf, wb;
            if (type == 0) {
                wf = sg < t ? __expf(lgf * (float)(t - sg)) : (sg > t ? __expf(lgb * (float)(sg - t)) : 2.f);
                wb = 0.f;
            } else {
                wf = sg <= t ? __expf(CU0[sb + t] - CU0[sb + sg] + LI0[sb + sg]) : 0.f;
                wb = sg >= t ? __expf(CU1[sb + t] - CU1[sb + sg] + LI1[sb + sg]) : 0.f;
            }
            pf[r][s] = dot * wf; pb[r][s] = dot * wb;
        }
        __syncthreads();
        if (tid < 32) { const int r = tid & 15; float a = 0.f; for (int s = 0; s < 32; ++s) a += (tid < 16 ? pf[r][s] : pb[r][s]); den += a; }
        for (int s = 0; s < 32; ++s) { const float v = vs[s][e_];
            for (int i = 0; i < 8; ++i) { of[i] += pf[rh * 8 + i][s] * v; ob[i] += pb[rh * 8 + i][s] * v; } }
    }
    __syncthreads();
    float* dens = &pf[0][0];
    if (tid < 32) dens[tid] = den;
    __syncthreads();
    if (lat) {
        const int b = (m0 - NP) / TS;
        const float* S0f = (type == 0 ? p.st_ret : p.st_C) + ((size_t)((b * 2 + 0) * 4 + h)) * 128 * 128;
        const float* S0b = (type == 0 ? p.st_ret : p.st_C) + ((size_t)((b * 2 + 1) * 4 + h)) * 128 * 128;
        for (int i = 0; i < 8; ++i) {
            const int r = rh * 8 + i, t = t0 + r;
            float af = 0.f, ab = 0.f;
            for (int d = 0; d < 128; ++d) { af += qs[r][d] * S0f[d * 128 + e_]; ab += qs[r][d] * S0b[d * 128 + e_]; }
            float cf, cb;
            if (type == 0) { cf = __expf(lgf * (float)(t + 1)); cb = __expf(lgb * (float)(T - t)); }
            else { cf = __expf(CU0[sb + t] + p.st_m[(b * 2 + 0) * 4 + h]); cb = __expf(CU1[sb + t] + p.st_m[(b * 2 + 1) * 4 + h]); }
            of[i] += cf * af; ob[i] += cb * ab;
        }
        if (type == 1 && tid < 32) {
            const int r = tid & 15, dir = tid >> 4, t = t0 + r;
            const float* n0 = p.st_n + (size_t)((b * 2 + dir) * 4 + h) * 128;
            float a = 0.f; for (int d = 0; d < 128; ++d) a += qs[r][d] * n0[d];
            const float cfb = __expf((dir == 0 ? CU0 : CU1)[sb + t] + p.st_m[(b * 2 + dir) * 4 + h]);
            dens[tid] += cfb * a;
        }
        __syncthreads();
    }
    for (int i = 0; i < 8; ++i) {
        const int r = rh * 8 + i;
        float o;
        if (type == 0) o = of[i] + ob[i];
        else o = of[i] / fmaxf(fabsf(dens[r]), 1.f) + ob[i] / fmaxf(fabsf(dens[16 + r]), 1.f);
        os[r][e_] = o;
    }
    __syncthreads();
    for (int i = 0; i < 8; ++i) {
        const int r = rh * 8 + i, m = m0 + r;
        float mu = 0.f; for (int d = 0; d < 128; ++d) mu += os[r][d];
        mu *= (1.f / 128.f);
        float var = 0.f; for (int d = 0; d < 128; ++d) { const float x = os[r][d] - mu; var += x * x; }
        var *= (1.f / 128.f);
        const float y = (os[r][e_] - mu) * rsqrtf(var + EPS);
        const float g = (type == 0 ? p.rgn : p.mgn)[h * HD + e_];
        const float gate = bf2f(((const bf16_t*)(p.ws + (type == 0 ? WS_RG : WS_MO)))[(size_t)m * W5 + h * HD + e_]);
        ((bf16_t*)(p.ws + WS_MIX))[(size_t)m * D + type * 512 + h * HD + e_] = f2bf(y * g * gate);
    }
}

__global__ void __launch_bounds__(256) k_states(P p) {
    __shared__ float ks[32][128], vs[32][128], ws_[256];
    __shared__ float red[4];
    const int tid = threadIdx.x, b = blockIdx.x, h = blockIdx.y, type = blockIdx.z >> 1, dir = blockIdx.z & 1;
    const int sb = b * TP;
    const bf16_t* Kp = (const bf16_t*)(p.ws + (type == 0 ? WS_RK : WS_MK));
    const bf16_t* V = (const bf16_t*)(p.ws + (type == 0 ? WS_RV : WS_MV));
    float mfin = 0.f;
    {
        const int s = tid; float lw;
        if (type == 0) { const float lg = logsigf(p.decay[dir * 4 + h]); lw = lg * (float)(dir == 0 ? TP - 1 - s : s); }
        else {
            const float* LI = (const float*)(p.ws + WS_GLI) + (size_t)(dir * 4 + h) * M;
            const float* CU = (const float*)(p.ws + WS_GCUM) + (size_t)(dir * 4 + h) * M;
            const float tot = CU[sb + (dir == 0 ? TP - 1 : 0)];
            lw = tot - CU[sb + s] + LI[sb + s];
            float mx = lw; for (int o = 32; o > 0; o >>= 1) mx = fmaxf(mx, __shfl_xor(mx, o));
            if ((tid & 63) == 0) red[tid >> 6] = mx;
            __syncthreads();
            mfin = fmaxf(fmaxf(fmaxf(red[0], red[1]), fmaxf(red[2], red[3])), tot);
            lw -= mfin;
        }
        ws_[s] = __expf(lw);
    }
    const int dk0 = (tid >> 4) * 8, dv0 = (tid & 15) * 8;
    float acc[8][8]; float nacc = 0.f;
    for (int i = 0; i < 8; ++i) for (int j = 0; j < 8; ++j) acc[i][j] = 0.f;
    for (int s0 = 0; s0 < TP; s0 += 32) {
        __syncthreads();
        for (int e = tid; e < 32 * 128; e += 256) { const int s = e >> 7, d = e & 127; const size_t a = (size_t)(sb + s0 + s) * W5 + h * HD + d;
            ks[s][d] = bf2f(Kp[a]); vs[s][d] = bf2f(V[a]); }
        __syncthreads();
        for (int s = 0; s < 32; ++s) {
            const float w = ws_[s0 + s];
            float kk[8], vv[8];
            for (int i = 0; i < 8; ++i) { kk[i] = ks[s][dk0 + i] * w; vv[i] = vs[s][dv0 + i]; }
            for (int i = 0; i < 8; ++i) for (int j = 0; j < 8; ++j) acc[i][j] += kk[i] * vv[j];
            if (tid < 128) nacc += w * ks[s][tid];
        }
    }
    float* O = p.out + (type == 0 ? O_RET : O_C) + (size_t)((b * 2 + dir) * 4 + h) * 128 * 128;
    for (int i = 0; i < 8; ++i) for (int j = 0; j < 8; ++j) O[(dk0 + i) * 128 + dv0 + j] = acc[i][j];
    if (type == 1) {
        if (tid < 128) p.out[O_N + (size_t)((b * 2 + dir) * 4 + h) * 128 + tid] = nacc;
        if (tid == 0) p.out[O_M + (b * 2 + dir) * 4 + h] = mfin;
    }
}

__global__ void k_final(P p) {
    __shared__ float red[4];
    const int m = blockIdx.x, tid = threadIdx.x;
    float* xr = p.out + O_Y + (size_t)m * D;
    float v[4], ss = 0.f;
    for (int i = 0; i < 4; ++i) { v[i] = xr[tid + 256 * i]; ss += v[i] * v[i]; }
    ss = block_sum256(ss, red);
    const float rstd = rsqrtf(ss * (1.f / D) + EPS);
    for (int i = 0; i < 4; ++i) xr[tid + 256 * i] = v[i] * rstd * p.fg[tid + 256 * i];
}

extern "C" void kernel_launch(void* const* d_in, const int* in_sizes, int n_in, void* d_out, int out_size, void* d_ws, size_t ws_size, hipStream_t stream) {
    if (n_in != 22 || ws_size < WS_END) { fprintf(stderr, "kernel_launch: unexpected n_in %d / ws_size %zu\n", n_in, ws_size); return; }
    P p{};
    p.xp = (const float*)d_in[0]; p.xs = (const float*)d_in[1]; p.st_ret = (const float*)d_in[2]; p.st_C = (const float*)d_in[3];
    p.st_n = (const float*)d_in[4]; p.st_m = (const float*)d_in[5]; p.c = (const float*)d_in[6]; p.cctx = (const float*)d_in[7];
    p.w_ada = (const float*)d_in[8]; p.b_ada = (const float*)d_in[9]; p.n1g = (const float*)d_in[10]; p.n2g = (const float*)d_in[11];
    p.w_in = (const float*)d_in[12]; p.conv_w = (const float*)d_in[13]; p.decay = (const float*)d_in[14]; p.gbias = (const float*)d_in[15];
    p.rgn = (const float*)d_in[16]; p.mgn = (const float*)d_in[17]; p.w_out = (const float*)d_in[18]; p.w_ff1 = (const float*)d_in[19];
    p.w_ff2 = (const float*)d_in[20]; p.fg = (const float*)d_in[21];
    p.out = (float*)d_out; p.ws = (unsigned char*)d_ws;
    unsigned char* ws = p.ws;
    k_wt<<<dim3(4096 / 32, 1024 / 32), dim3(32, 8), 0, stream>>>(p.w_in, INC, 1024, (bf16_t*)(ws + WS_WIN));
    k_wt<<<dim3(1024 / 32, 1024 / 32), dim3(32, 8), 0, stream>>>(p.w_out, 1024, 1024, (bf16_t*)(ws + WS_WOUT));
    k_wt<<<dim3(4096 / 32, 1024 / 32), dim3(32, 8), 0, stream>>>(p.w_ff1, 4096, 1024, (bf16_t*)(ws + WS_W1));
    k_wt<<<dim3(1024 / 32, 4096 / 32), dim3(32, 8), 0, stream>>>(p.w_ff2, 1024, 4096, (bf16_t*)(ws + WS_W2));
    k_mod<<<dim3(6144 / 256, 3), 256, 0, stream>>>(p);
    k_rope<<<64, 32, 0, stream>>>(p);
    k_norm<<<M, 256, 0, stream>>>(p, 0);
    k_gemm<EPI_PROJ><<<dim3(4096 / 128, M / 64), 256, 0, stream>>>(p, (const bf16_t*)(ws + WS_H), (const bf16_t*)(ws + WS_WIN), 1024);
    k_conv<<<M, 256, 0, stream>>>(p);
    k_gates<<<5, 64, 0, stream>>>(p);
    k_mix<<<dim3(M / 16, 4, 2), 256, 0, stream>>>(p);
    k_states<<<dim3(32, 4, 4), 256, 0, stream>>>(p);
    k_gemm<EPI_RES1><<<dim3(1024 / 128, M / 64), 256, 0, stream>>>(p, (const bf16_t*)(ws + WS_MIX), (const bf16_t*)(ws + WS_WOUT), 1024);
    k_norm<<<M, 256, 0, stream>>>(p, 1);
    k_gemm<EPI_RELU2><<<dim3(4096 / 128, M / 64), 256, 0, stream>>>(p, (const bf16_t*)(ws + WS_H), (const bf16_t*)(ws + WS_W1), 1024);
    k_gemm<EPI_RES2><<<dim3(1024 / 128, M / 64), 256, 0, stream>>>(p, (const bf16_t*)(ws + WS_U), (const bf16_t*)(ws + WS_W2), 4096);
    k_final<<<M, 256, 0, stream>>>(p);
}
```

```cpp
#include <hip/hip_runtime.h>
#include <cstdint>
#include <cstdio>

typedef unsigned short bf16_t;

constexpr int D = 1024, NP = 32 * 256, NS = 2 * 2048, M = NP + NS;
constexpr int TP = 256, TS = 2048;
constexpr int INC = 4112, FF = 4096, NH = 4, HD = 128, W5 = 512;
constexpr float EPS = 1e-6f;

constexpr size_t MiB = 1u << 20;
constexpr size_t WS_CTL = 0;
constexpr size_t WS_MOD = 1 * MiB;
constexpr size_t WS_ROPE = 1 * MiB + 128 * 1024;
constexpr size_t WS_GATES = 2 * MiB;
constexpr size_t WS_GLI = 3 * MiB;
constexpr size_t WS_GCUM = 3 * MiB + 512 * 1024;
constexpr size_t WS_WIN = 4 * MiB;
constexpr size_t WS_WOUT = 12 * MiB;
constexpr size_t WS_W1 = 14 * MiB;
constexpr size_t WS_W2 = 22 * MiB;
constexpr size_t WS_H = 32 * MiB;
constexpr size_t WS_MIX = 56 * MiB;
constexpr size_t WS_RQ = 80 * MiB;
constexpr size_t WS_RK = 92 * MiB;
constexpr size_t WS_RV = 104 * MiB;
constexpr size_t WS_RG = 116 * MiB;
constexpr size_t WS_MQKP = 128 * MiB;
constexpr size_t WS_MV = 152 * MiB;
constexpr size_t WS_MO = 164 * MiB;
constexpr size_t WS_MQ = 176 * MiB;
constexpr size_t WS_MK = 188 * MiB;
constexpr size_t WS_U = 80 * MiB;
constexpr size_t WS_END = 200 * MiB;

constexpr size_t O_Y = 0;
constexpr size_t O_RET = (size_t)M * D;
constexpr size_t O_C = O_RET + (size_t)32 * 2 * 4 * 128 * 128;
constexpr size_t O_N = O_C + (size_t)32 * 2 * 4 * 128 * 128;
constexpr size_t O_M = O_N + (size_t)32 * 2 * 4 * 128;

__device__ __forceinline__ float bf2f(bf16_t v) { return __uint_as_float((unsigned)v << 16); }
__device__ __forceinline__ bf16_t f2bf(float f) { unsigned u = __float_as_uint(f); return (bf16_t)((u + 0x7fffu + ((u >> 16) & 1u)) >> 16); }
__device__ __forceinline__ float siluf(float x) { return x / (1.f + __expf(-x)); }
__device__ __forceinline__ float sigmf(float x) { return 1.f / (1.f + __expf(-x)); }
__device__ __forceinline__ float logsigf(float x) { return fminf(x, 0.f) - log1pf(__expf(-fabsf(x))); }
__device__ __forceinline__ int cond_of(int m) { return m < NP ? 0 : 1 + (m - NP) / TS; }

struct P {
    const float *xp, *xs, *st_ret, *st_C, *st_n, *st_m, *c, *cctx, *w_ada, *b_ada, *n1g, *n2g, *w_in, *conv_w, *decay, *gbias, *rgn, *mgn, *w_out, *w_ff1, *w_ff2, *fg;
    float* out; unsigned char* ws;
};
__device__ __forceinline__ const float* xrow(const P& p, int m) { return m < NP ? p.xp + (size_t)m * D : p.xs + (size_t)(m - NP) * D; }

__global__ void k_wt(const float* W, int ldw, int K, bf16_t* WT) {
    __shared__ float t[32][33];
    const int n0 = blockIdx.x * 32, k0 = blockIdx.y * 32, tx = threadIdx.x, ty = threadIdx.y;
    for (int i = ty; i < 32; i += 8) t[i][tx] = W[(size_t)(k0 + i) * ldw + n0 + tx];
    __syncthreads();
    for (int i = ty; i < 32; i += 8) WT[(size_t)(n0 + i) * K + k0 + tx] = f2bf(t[tx][i]);
}

__global__ void k_mod(P p) {
    const int j = blockIdx.x * 256 + threadIdx.x, cnd = blockIdx.y;
    const float* cv = cnd == 0 ? p.cctx : p.c + (size_t)(cnd - 1) * D;
    float acc = 0.f;
    for (int k = 0; k < D; ++k) acc += siluf(cv[k]) * p.w_ada[(size_t)k * 6144 + j];
    ((float*)(p.ws + WS_MOD))[cnd * 6144 + j] = acc + p.b_ada[j];
}

__global__ void k_rope(P p) {
    const int pos = blockIdx.x, f = threadIdx.x;
    const float inv = (float)exp(-(double)f / 32.0 * log(10000.0));
    const float ang = (float)pos * inv;
    float* rc = (float*)(p.ws + WS_ROPE);
    rc[pos * 32 + f] = (float)cos((double)ang);
    rc[2048 + pos * 32 + f] = (float)sin((double)ang);
}

__device__ __forceinline__ float block_sum256(float v, float* red) {
    for (int o = 32; o > 0; o >>= 1) v += __shfl_xor(v, o);
    __syncthreads();
    if ((threadIdx.x & 63) == 0) red[threadIdx.x >> 6] = v;
    __syncthreads();
    return red[0] + red[1] + red[2] + red[3];
}

__global__ void k_norm(P p, int which) {
    __shared__ float red[4];
    __shared__ float gsum[16][4];
    const int m = blockIdx.x, tid = threadIdx.x, cnd = cond_of(m);
    const float* xr = which == 0 ? xrow(p, m) : p.out + O_Y + (size_t)m * D;
    const float* mod = (const float*)(p.ws + WS_MOD) + cnd * 6144;
    const float* sh = mod + (which == 0 ? 0 : 3072);
    const float* sc = mod + (which == 0 ? 1024 : 4096);
    const float* g = which == 0 ? p.n1g : p.n2g;
    float v[4], ss = 0.f;
    for (int i = 0; i < 4; ++i) { v[i] = xr[tid + 256 * i]; ss += v[i] * v[i]; }
    ss = block_sum256(ss, red);
    const float rstd = rsqrtf(ss * (1.f / D) + EPS);
    bf16_t* H = (bf16_t*)(p.ws + WS_H) + (size_t)m * D;
    float h[4];
    for (int i = 0; i < 4; ++i) { const int k = tid + 256 * i; h[i] = v[i] * rstd * g[k] * (1.f + sc[k]) + sh[k]; H[k] = f2bf(h[i]); }
    if (which == 0) {
        float ga[16];
        for (int j = 0; j < 16; ++j) ga[j] = 0.f;
        for (int i = 0; i < 4; ++i) { const int k = tid + 256 * i; const float* wr = p.w_in + (size_t)k * INC + 4096;
            for (int j = 0; j < 16; ++j) ga[j] += h[i] * wr[j]; }
        for (int j = 0; j < 16; ++j) { float s = ga[j]; for (int o = 32; o > 0; o >>= 1) s += __shfl_xor(s, o); if ((tid & 63) == 0) gsum[j][tid >> 6] = s; }
        __syncthreads();
        if (tid < 16) ((float*)(p.ws + WS_GATES))[(size_t)m * 16 + tid] = gsum[tid][0] + gsum[tid][1] + gsum[tid][2] + gsum[tid][3] + p.gbias[tid];
    }
}

enum { EPI_PROJ = 0, EPI_RES1 = 1, EPI_RELU2 = 2, EPI_RES2 = 3 };
template <int EPI>
__global__ void __launch_bounds__(256) k_gemm(P p, const bf16_t* A, const bf16_t* WT, int K) {
    __shared__ float As[16][68];
    __shared__ float Bs[16][132];
    __shared__ float Cs[64][129];
    const int tid = threadIdx.x, m0 = blockIdx.y * 64, n0 = blockIdx.x * 128;
    const int ty = tid >> 4, tx = tid & 15;
    float acc[4][8];
    for (int i = 0; i < 4; ++i) for (int j = 0; j < 8; ++j) acc[i][j] = 0.f;
    for (int k0 = 0; k0 < K; k0 += 16) {
        { const int r = tid >> 2, kk = (tid & 3) * 4; const bf16_t* a = A + (size_t)(m0 + r) * K + k0 + kk;
          for (int j = 0; j < 4; ++j) As[kk + j][r] = bf2f(a[j]); }
        { const int r = tid >> 1, kk = (tid & 1) * 8; const bf16_t* b = WT + (size_t)(n0 + r) * K + k0 + kk;
          for (int j = 0; j < 8; ++j) Bs[kk + j][r] = bf2f(b[j]); }
        __syncthreads();
        for (int kk = 0; kk < 16; ++kk) {
            float a[4], b[8];
            for (int i = 0; i < 4; ++i) a[i] = As[kk][ty * 4 + i];
            for (int j = 0; j < 8; ++j) b[j] = Bs[kk][tx * 8 + j];
            for (int i = 0; i < 4; ++i) for (int j = 0; j < 8; ++j) acc[i][j] += a[i] * b[j];
        }
        __syncthreads();
    }
    for (int i = 0; i < 4; ++i) for (int j = 0; j < 8; ++j) Cs[ty * 4 + i][tx * 8 + j] = acc[i][j];
    __syncthreads();
    if (EPI == EPI_PROJ) {
        const int sec = n0 / 512, hc = n0 % 512;
        const float* rc = (const float*)(p.ws + WS_ROPE);
        for (int e = tid; e < 64 * 128; e += 256) {
            const int r = e >> 7, d = e & 127, m = m0 + r;
            float v = Cs[r][d];
            if (sec <= 1) {
                if (sec == 1) v *= 0.08838834764831845f;
                if (m >= NP) {
                    const int t = (m - NP) % TS, dd = d & 63, f = dd & 31, pos = dd < 32 ? t / 64 : t % 64;
                    const float cs = rc[pos * 32 + f], sn = rc[2048 + pos * 32 + f];
                    float o = Cs[r][d ^ 64]; if (sec == 1) o *= 0.08838834764831845f;
                    v = d < 64 ? v * cs - o * sn : o * sn + v * cs;
                }
                ((bf16_t*)(p.ws + (sec == 0 ? WS_RQ : WS_RK)))[(size_t)m * W5 + hc + d] = f2bf(v);
            } else if (sec == 2) ((bf16_t*)(p.ws + WS_RV))[(size_t)m * W5 + hc + d] = f2bf(v);
            else if (sec == 3) ((bf16_t*)(p.ws + WS_RG))[(size_t)m * W5 + hc + d] = f2bf(siluf(v));
            else if (sec <= 5) ((bf16_t*)(p.ws + WS_MQKP))[(size_t)m * 1024 + (n0 - 2048) + d] = f2bf(v);
            else if (sec == 6) ((bf16_t*)(p.ws + WS_MV))[(size_t)m * W5 + hc + d] = f2bf(v);
            else ((bf16_t*)(p.ws + WS_MO))[(size_t)m * W5 + hc + d] = f2bf(sigmf(v));
        }
    } else if (EPI == EPI_RES1) {
        for (int e = tid; e < 64 * 128; e += 256) { const int r = e >> 7, n = n0 + (e & 127), m = m0 + r;
            const float g1 = ((const float*)(p.ws + WS_MOD))[cond_of(m) * 6144 + 2048 + n];
            p.out[O_Y + (size_t)m * D + n] = xrow(p, m)[n] + g1 * Cs[r][e & 127]; }
    } else if (EPI == EPI_RELU2) {
        for (int e = tid; e < 64 * 128; e += 256) { const int r = e >> 7, n = n0 + (e & 127), m = m0 + r;
            const float v = fmaxf(Cs[r][e & 127], 0.f);
            ((bf16_t*)(p.ws + WS_U))[(size_t)m * FF + n] = f2bf(v * v); }
    } else {
        for (int e = tid; e < 64 * 128; e += 256) { const int r = e >> 7, n = n0 + (e & 127), m = m0 + r;
            const float g2 = ((const float*)(p.ws + WS_MOD))[cond_of(m) * 6144 + 5120 + n];
            p.out[O_Y + (size_t)m * D + n] += g2 * Cs[r][e & 127]; }
    }
}

__global__ void k_conv(P p) {
    const int m = blockIdx.x, T = m < NP ? TP : TS, t = m < NP ? m % TP : (m - NP) % TS;
    const bf16_t* X = (const bf16_t*)(p.ws + WS_MQKP);
    for (int c = threadIdx.x; c < 1024; c += 256) {
        float v = p.conv_w[1024 + c] * bf2f(X[(size_t)m * 1024 + c]);
        if (t > 0) v += p.conv_w[c] * bf2f(X[(size_t)(m - 1) * 1024 + c]);
        if (t < T - 1) v += p.conv_w[2048 + c] * bf2f(X[(size_t)(m + 1) * 1024 + c]);
        v = siluf(v);
        if (c < 512) ((bf16_t*)(p.ws + WS_MQ))[(size_t)m * W5 + c] = f2bf(v);
        else ((bf16_t*)(p.ws + WS_MK))[(size_t)m * W5 + c - 512] = f2bf(v * 0.08838834764831845f);
    }
}

__global__ void k_gates(P p) {
    const int id = blockIdx.x * 64 + threadIdx.x;
    if (id >= 34 * 8) return;
    const int seq = id / 8, h = id % 4, dir = (id / 4) % 2;
    const int T = seq < 32 ? TP : TS, mbase = seq < 32 ? seq * TP : NP + (seq - 32) * TS;
    const float* G = (const float*)(p.ws + WS_GATES);
    float* LI = (float*)(p.ws + WS_GLI) + (size_t)(dir * 4 + h) * M;
    float* CU = (float*)(p.ws + WS_GCUM) + (size_t)(dir * 4 + h) * M;
    float cum = 0.f;
    for (int i = 0; i < T; ++i) {
        const int m = mbase + (dir == 0 ? i : T - 1 - i);
        cum += logsigf(G[(size_t)m * 16 + dir * 8 + 4 + h]);
        CU[m] = cum; LI[m] = G[(size_t)m * 16 + dir * 8 + h];
    }
}

__global__ void __launch_bounds__(256) k_mix(P p) {
    __shared__ float qs[16][128];
    __shared__ float ks[32][129];
    __shared__ float vs[32][128];
    __shared__ float pf[16][32], pb[16][32];
    __shared__ float os[16][129];
    const int tid = threadIdx.x, m0 = blockIdx.x * 16, h = blockIdx.y, type = blockIdx.z;
    const bool lat = m0 >= NP;
    const int T = lat ? TS : TP, sb = lat ? NP + ((m0 - NP) / TS) * TS : (m0 / TP) * TP, t0 = m0 - sb;
    const bf16_t* Q = (const bf16_t*)(p.ws + (type == 0 ? WS_RQ : WS_MQ));
    const bf16_t* Kp = (const bf16_t*)(p.ws + (type == 0 ? WS_RK : WS_MK));
    const bf16_t* V = (const bf16_t*)(p.ws + (type == 0 ? WS_RV : WS_MV));
    const float lgf = logsigf(p.decay[h]), lgb = logsigf(p.decay[4 + h]);
    const float* LI0 = (const float*)(p.ws + WS_GLI) + (size_t)h * M;
    const float* LI1 = (const float*)(p.ws + WS_GLI) + (size_t)(4 + h) * M;
    const float* CU0 = (const float*)(p.ws + WS_GCUM) + (size_t)h * M;
    const float* CU1 = (const float*)(p.ws + WS_GCUM) + (size_t)(4 + h) * M;
    for (int e = tid; e < 16 * 128; e += 256) qs[e >> 7][e & 127] = bf2f(Q[(size_t)(m0 + (e >> 7)) * W5 + h * HD + (e & 127)]);
    const int e_ = tid & 127, rh = tid >> 7;
    float of[8], ob[8];
    for (int i = 0; i < 8; ++i) { of[i] = 0.f; ob[i] = 0.f; }
    float den = 0.f;
    for (int s0 = 0; s0 < T; s0 += 32) {
        __syncthreads();
        for (int e = tid; e < 32 * 128; e += 256) { const int s = e >> 7, d = e & 127; const size_t a = (size_t)(sb + s0 + s) * W5 + h * HD + d;
            ks[s][d] = bf2f(Kp[a]); vs[s][d] = bf2f(V[a]); }
        __syncthreads();
        for (int e = tid; e < 16 * 32; e += 256) {
            const int r = e >> 5, s = e & 31, t = t0 + r, sg = s0 + s;
            float dot = 0.f;
            for (int d = 0; d < 128; ++d) dot += qs[r][d] * ks[s][d];
            float wf, wb;
            if (type == 0) {
                wf = sg < t ? __expf(lgf * (float)(t - sg)) : (sg > t ? __expf(lgb * (float)(sg - t)) : 2.f);
                wb = 0.f;
            } else {
                wf = sg <= t ? __expf(CU0[sb + t] - CU0[sb + sg] + LI0[sb + sg]) : 0.f;
                wb = sg >= t ? __expf(CU1[sb + t] - CU1[sb + sg] + LI1[sb + sg]) : 0.f;
            }
            pf[r][s] = dot * wf; pb[r][s] = dot * wb;
        }
        __syncthreads();
        if (tid < 32) { const int r = tid & 15; float a = 0.f; for (int s = 0; s < 32; ++s) a += (tid < 16 ? pf[r][s] : pb[r][s]); den += a; }
        for (int s = 0; s < 32; ++s) { const float v = vs[s][e_];
            for (int i = 0; i < 8; ++i) { of[i] += pf[rh * 8 + i][s] * v; ob[i] += pb[rh * 8 + i][s] * v; } }
    }
    __syncthreads();
    float* dens = &pf[0][0];
    if (tid < 32) dens[tid] = den;
    __syncthreads();
    if (lat) {
        const int b = (m0 - NP) / TS;
        const float* S0f = (type == 0 ? p.st_ret : p.st_C) + ((size_t)((b * 2 + 0) * 4 + h)) * 128 * 128;
        const float* S0b = (type == 0 ? p.st_ret : p.st_C) + ((size_t)((b * 2 + 1) * 4 + h)) * 128 * 128;
        for (int i = 0; i < 8; ++i) {
            const int r = rh * 8 + i, t = t0 + r;
            float af = 0.f, ab = 0.f;
            for (int d = 0; d < 128; ++d) { af += qs[r][d] * S0f[d * 128 + e_]; ab += qs[r][d] * S0b[d * 128 + e_]; }
            float cf, cb;
            if (type == 0) { cf = __expf(lgf * (float)(t + 1)); cb = __expf(lgb * (float)(T - t)); }
            else { cf = __expf(CU0[sb + t] + p.st_m[(b * 2 + 0) * 4 + h]); cb = __expf(CU1[sb + t] + p.st_m[(b * 2 + 1) * 4 + h]); }
            of[i] += cf * af; ob[i] += cb * ab;
        }
        if (type == 1 && tid < 32) {
            const int r = tid & 15, dir = tid >> 4, t = t0 + r;
            const float* n0 = p.st_n + (size_t)((b * 2 + dir) * 4 + h) * 128;
            float a = 0.f; for (int d = 0; d < 128; ++d) a += qs[r][d] * n0[d];
            const float cfb = __expf((dir == 0 ? CU0 : CU1)[sb + t] + p.st_m[(b * 2 + dir) * 4 + h]);
            dens[tid] += cfb * a;
        }
        __syncthreads();
    }
    for (int i = 0; i < 8; ++i) {
        const int r = rh * 8 + i;
        float o;
        if (type == 0) o = of[i] + ob[i];
        else o = of[i] / fmaxf(fabsf(dens[r]), 1.f) + ob[i] / fmaxf(fabsf(dens[16 + r]), 1.f);
        os[r][e_] = o;
    }
    __syncthreads();
    for (int i = 0; i < 8; ++i) {
        const int r = rh * 8 + i, m = m0 + r;
        float mu = 0.f; for (int d = 0; d < 128; ++d) mu += os[r][d];
        mu *= (1.f / 128.f);
        float var = 0.f; for (int d = 0; d < 128; ++d) { const float x = os[r][d] - mu; var += x * x; }
        var *= (1.f / 128.f);
        const float y = (os[r][e_] - mu) * rsqrtf(var + EPS);
        const float g = (type == 0 ? p.rgn : p.mgn)[h * HD + e_];
        const float gate = bf2f(((const bf16_t*)(p.ws + (type == 0 ? WS_RG : WS_MO)))[(size_t)m * W5 + h * HD + e_]);
        ((bf16_t*)(p.ws + WS_MIX))[(size_t)m * D + type * 512 + h * HD + e_] = f2bf(y * g * gate);
    }
}

__global__ void __launch_bounds__(256) k_states(P p) {
    __shared__ float ks[32][128], vs[32][128], ws_[256];
    __shared__ float red[4];
    const int tid = threadIdx.x, b = blockIdx.x, h = blockIdx.y, type = blockIdx.z >> 1, dir = blockIdx.z & 1;
    const int sb = b * TP;
    const bf16_t* Kp = (const bf16_t*)(p.ws + (type == 0 ? WS_RK : WS_MK));
    const bf16_t* V = (const bf16_t*)(p.ws + (type == 0 ? WS_RV : WS_MV));
    float mfin = 0.f;
    {
        const int s = tid; float lw;
        if (type == 0) { const float lg = logsigf(p.decay[dir * 4 + h]); lw = lg * (float)(dir == 0 ? TP - 1 - s : s); }
        else {
            const float* LI = (const float*)(p.ws + WS_GLI) + (size_t)(dir * 4 + h) * M;
            const float* CU = (const float*)(p.ws + WS_GCUM) + (size_t)(dir * 4 + h) * M;
            const float tot = CU[sb + (dir == 0 ? TP - 1 : 0)];
            lw = tot - CU[sb + s] + LI[sb + s];
            float mx = lw; for (int o = 32; o > 0; o >>= 1) mx = fmaxf(mx, __shfl_xor(mx, o));
            if ((tid & 63) == 0) red[tid >> 6] = mx;
            __syncthreads();
            mfin = fmaxf(fmaxf(fmaxf(red[0], red[1]), fmaxf(red[2], red[3])), tot);
            lw -= mfin;
        }
        ws_[s] = __expf(lw);
    }
    const int dk0 = (tid >> 4) * 8, dv0 = (tid & 15) * 8;
    float acc[8][8]; float nacc = 0.f;
    for (int i = 0; i < 8; ++i) for (int j = 0; j < 8; ++j) acc[i][j] = 0.f;
    for (int s0 = 0; s0 < TP; s0 += 32) {
        __syncthreads();
        for (int e = tid; e < 32 * 128; e += 256) { const int s = e >> 7, d = e & 127; const size_t a = (size_t)(sb + s0 + s) * W5 + h * HD + d;
            ks[s][d] = bf2f(Kp[a]); vs[s][d] = bf2f(V[a]); }
        __syncthreads();
        for (int s = 0; s < 32; ++s) {
            const float w = ws_[s0 + s];
            float kk[8], vv[8];
            for (int i = 0; i < 8; ++i) { kk[i] = ks[s][dk0 + i] * w; vv[i] = vs[s][dv0 + i]; }
            for (int i = 0; i < 8; ++i) for (int j = 0; j < 8; ++j) acc[i][j] += kk[i] * vv[j];
            if (tid < 128) nacc += w * ks[s][tid];
        }
    }
    float* O = p.out + (type == 0 ? O_RET : O_C) + (size_t)((b * 2 + dir) * 4 + h) * 128 * 128;
    for (int i = 0; i < 8; ++i) for (int j = 0; j < 8; ++j) O[(dk0 + i) * 128 + dv0 + j] = acc[i][j];
    if (type == 1) {
        if (tid < 128) p.out[O_N + (size_t)((b * 2 + dir) * 4 + h) * 128 + tid] = nacc;
        if (tid == 0) p.out[O_M + (b * 2 + dir) * 4 + h] = mfin;
    }
}

__global__ void k_final(P p) {
    __shared__ float red[4];
    const int m = blockIdx.x, tid = threadIdx.x;
    float* xr = p.out + O_Y + (size_t)m * D;
    float v[4], ss = 0.f;
    for (int i = 0; i < 4; ++i) { v[i] = xr[tid + 256 * i]; ss += v[i] * v[i]; }
    ss = block_sum256(ss, red);
    const float rstd = rsqrtf(ss * (1.f / D) + EPS);
    for (int i = 0; i < 4; ++i) xr[tid + 256 * i] = v[i] * rstd * p.fg[tid + 256 * i];
}


namespace pg8 {
#define PG8_LAS __attribute__((address_space(3)))
typedef short bf16x8 __attribute__((ext_vector_type(8)));
typedef float f32x4 __attribute__((ext_vector_type(4)));
typedef unsigned u32x4 __attribute__((ext_vector_type(4)));
constexpr int BM = 256, BK = 64, HALF = 128, HTB = HALF * BK * 2  , STAGE_BYTES = 8 * HTB, NXCD = 8, WGM = 8;

__host__ __device__ __forceinline__ int lds_byte(int r, int c) { const int st = (r >> 4) * 2 + (c >> 5), rr = r & 15, cc = c & 31, ob = rr * 64 + cc * 2; return st * 1024 + (ob ^ (((ob >> 9) & 1) << 5)); }
__host__ __device__ __forceinline__ void stage_rc(int b, int& R, int& C) { const int st = b / 1024, sb = b % 1024, swz = sb ^ (((sb >> 9) & 1) << 5); R = (st >> 1) * 16 + swz / 64; C = (st & 1) * 32 + (swz % 64) / 2; }
__host__ __device__ __forceinline__ int perm32(int rho) { const int n = rho >> 4, i = rho & 15; return 8 * (i >> 2) + 4 * n + (i & 3); }

struct Unit { int pm, pn; };
struct Gemm { const bf16_t* A; const bf16_t* Bt; int M, N, K; };

struct StaticOrder {
    int nM, nN, nwg, G, c;
    __host__ __device__ void init(int M, int N, int G_, int c_) { nM = M / BM; nN = N / BM; nwg = nM * nN; G = G_; c = c_; }
    __host__ __device__ bool next(int i, Unit& u) const {
        const long L = (long)i * G + c; if (L >= nwg) return false;
        int wgid = (int)L; { const int q = nwg / NXCD, r = nwg % NXCD, xcd = wgid % NXCD, off = wgid / NXCD; wgid = (xcd < r ? xcd * (q + 1) : r * (q + 1) + (xcd - r) * q) + off; }
        const int nig = WGM * nN, gid = wgid / nig, fm = gid * WGM, gsz = (nM - fm) < WGM ? (nM - fm) : WGM;
        u.pm = fm + ((wgid % nig) % gsz); u.pn = (wgid % nig) / gsz; return true;
    }
    __device__ __forceinline__ void a_ready(const Unit&) const {}
    __device__ __forceinline__ void done(const Unit&) const {}
};


__device__ __forceinline__ unsigned cvt_pk_bf16(float lo, float hi) { unsigned r; asm volatile("v_cvt_pk_bf16_f32 %0, %1, %2" : "=v"(r) : "v"(lo), "v"(hi)); return r; }
__device__ __forceinline__ u32x4 pack8(const f32x4& a, const f32x4& b) { u32x4 w; w.x = cvt_pk_bf16(a[0], a[1]); w.y = cvt_pk_bf16(a[2], a[3]); w.z = cvt_pk_bf16(b[0], b[1]); w.w = cvt_pk_bf16(b[2], b[3]); return w; }
__device__ __forceinline__ f32x4 silu4(const f32x4& v) { f32x4 o; for (int i = 0; i < 4; ++i) o[i] = v[i] / (1.f + __expf(-v[i])); return o; }
__device__ __forceinline__ f32x4 sigm4(const f32x4& v) { f32x4 o; for (int i = 0; i < 4; ++i) o[i] = 1.f / (1.f + __expf(-v[i])); return o; }

struct EpiProj {
    static constexpr bool PERM = true, PAIR = true, AFTER_DRAIN = false;
    unsigned char* ws; const float* rope;
    __device__ __forceinline__ void operator()(const f32x4 (&acc)[2][2][4][2], const Unit& u, int wr, int wc, int fr, int fq) const {
        const int sec = u.pn >> 1, hh = wc >> 1, dl = 32 * (wc & 1) + 8 * fq;
        bf16_t* dst; int ld, colb;
        if (sec == 4 || sec == 5) { dst = (bf16_t*)(ws + WS_MQKP); ld = 1024; colb = (u.pn - 8) * 256 + hh * 128; }
        else { const size_t off = sec == 0 ? WS_RQ : sec == 1 ? WS_RK : sec == 2 ? WS_RV : sec == 3 ? WS_RG : sec == 6 ? WS_MV : WS_MO;
               dst = (bf16_t*)(ws + off); ld = 512; colb = (u.pn & 1) * 256 + hh * 128; }
        const bool lat = u.pm >= NP / 256;
#pragma unroll
        for (int ai = 0; ai < 2; ++ai)
#pragma unroll
            for (int m = 0; m < 4; ++m) {
                const int row = u.pm * BM + ai * HALF + wr * 64 + m * 16 + fr;
                f32x4 a0 = acc[ai][0][m][0], a1 = acc[ai][0][m][1], b0 = acc[ai][1][m][0], b1 = acc[ai][1][m][1];
                if (sec <= 1) {
                    if (sec == 1) { a0 = a0 * 0.08838834764831845f; a1 = a1 * 0.08838834764831845f; b0 = b0 * 0.08838834764831845f; b1 = b1 * 0.08838834764831845f; }
                    if (lat) {
                        const int t = (row - NP) & (TS - 1), pos = (wc & 1) ? (t & 63) : (t >> 6);
                        const float* rp = rope + pos * 32 + 8 * fq;
                        const f32x4 c0 = *(const f32x4*)rp, c1 = *(const f32x4*)(rp + 4), s0 = *(const f32x4*)(rp + 2048), s1 = *(const f32x4*)(rp + 2052);
                        const f32x4 n0 = a0 * c0 - b0 * s0, n1 = a1 * c1 - b1 * s1, m0 = a0 * s0 + b0 * c0, m1 = a1 * s1 + b1 * c1;
                        a0 = n0; a1 = n1; b0 = m0; b1 = m1;
                    }
                } else if (sec == 3) { a0 = silu4(a0); a1 = silu4(a1); b0 = silu4(b0); b1 = silu4(b1); }
                else if (sec == 7) { a0 = sigm4(a0); a1 = sigm4(a1); b0 = sigm4(b0); b1 = sigm4(b1); }
                bf16_t* rp = dst + (size_t)row * ld + colb + dl;
                *(u32x4*)rp = pack8(a0, a1);
                *(u32x4*)(rp + 64) = pack8(b0, b1);
            }
    }
};
struct EpiRelu2 {
    static constexpr bool PERM = true, PAIR = false, AFTER_DRAIN = false;
    bf16_t* U;
    __device__ __forceinline__ void operator()(const f32x4 (&acc)[2][2][4][2], const Unit& u, int wr, int wc, int fr, int fq) const {
        const int row0 = u.pm * BM + wr * 64 + fr, col0 = u.pn * BM + wc * 32 + 8 * fq;
#pragma unroll
        for (int ai = 0; ai < 2; ++ai)
#pragma unroll
            for (int m = 0; m < 4; ++m) { bf16_t* rowp = U + (size_t)(row0 + ai * HALF + m * 16) * FF + col0;
#pragma unroll
                for (int bj = 0; bj < 2; ++bj) { f32x4 v0 = acc[ai][bj][m][0], v1 = acc[ai][bj][m][1];
                    for (int i = 0; i < 4; ++i) { const float x = fmaxf(v0[i], 0.f), y = fmaxf(v1[i], 0.f); v0[i] = x * x; v1[i] = y * y; }
                    *(u32x4*)(rowp + bj * HALF) = pack8(v0, v1); } }
    }
};
struct EpiRes {
    static constexpr bool PERM = false, PAIR = false, AFTER_DRAIN = false;
    const float* base_p; const float* base_s; float* out; const float* gate;
    __device__ __forceinline__ void operator()(const f32x4 (&acc)[2][2][4][2], const Unit& u, int wr, int wc, int fr, int fq) const {
        const int row0 = u.pm * BM + wr * 64 + fr, col0 = u.pn * BM + wc * 32 + 4 * fq;
        const int cnd = u.pm < NP / 256 ? 0 : 1 + (u.pm - NP / 256) / (TS / 256);
        const float* base = u.pm < NP / 256 ? base_p : base_s - (size_t)NP * D;
        f32x4 gv[2][2];
#pragma unroll
        for (int bj = 0; bj < 2; ++bj)
#pragma unroll
            for (int n = 0; n < 2; ++n) gv[bj][n] = *(const f32x4*)(gate + cnd * 6144 + col0 + bj * HALF + n * 16);
#pragma unroll
        for (int ai = 0; ai < 2; ++ai)
#pragma unroll
            for (int m = 0; m < 4; ++m) { const size_t off = (size_t)(row0 + ai * HALF + m * 16) * D + col0;
#pragma unroll
                for (int bj = 0; bj < 2; ++bj)
#pragma unroll
                    for (int n = 0; n < 2; ++n) { const f32x4 b = *(const f32x4*)(base + off + bj * HALF + n * 16);
                        *(f32x4*)(out + off + bj * HALF + n * 16) = b + gv[bj][n] * acc[ai][bj][m][n]; } }
    }
};
template <class Epi, class Sched, bool ALIGN_EPI = false, bool SP2 = false>
__device__ __forceinline__ void gemm_phase(PG8_LAS unsigned char* lds, const Gemm g, const Sched& S, const Epi& E) {
    const int tid = threadIdx.x, wid = __builtin_amdgcn_readfirstlane(tid >> 6), lane = tid & 63, wr = wid >> 2, wc = wid & 3, fr = lane & 15, fq = lane >> 4;
    const int K = g.K, nt = K / BK;
    unsigned voffA[2], voffB[2];
#pragma unroll
    for (int i = 0; i < 2; ++i) { int R, C; stage_rc(tid * 16 + i * 8192, R, C); int Rb = Epi::PERM ? ((R & ~31) + perm32(R & 31)) : R;
        if (Epi::PAIR) Rb = (Rb >> 6) * 128 + (Rb & 63);
        voffA[i] = (unsigned)(R * K + C) * 2u; voffB[i] = (unsigned)(Rb * K + C) * 2u; }
    const size_t kstep = (size_t)(BK * 2);
    const size_t hstep = (size_t)HALF * K * 2;
    const size_t hstepB = Epi::PAIR ? hstep / 2 : hstep;
    const size_t tstep = 2 * hstep;
    const unsigned ldsw = (unsigned)wid * 1024u;
    const int aoff = lds_byte(wr * 64 + fr, fq * 8), boff = lds_byte(wc * 32 + fr, fq * 8);
#define PG8_SA(b, h) (((b) * 2 + (h)) * HTB)
#define PG8_SB(b, h) ((4 + (b) * 2 + (h)) * HTB)
#define PG8_STAGE(bufoff, gbase, voff) do { _Pragma("unroll") for (int _i = 0; _i < 2; ++_i) \
        __builtin_amdgcn_global_load_lds((const unsigned*)((const char*)(gbase) + (voff)[_i]), (PG8_LAS unsigned*)(lds + (bufoff) + ldsw + _i * 8192), 16, 0, 0); } while (0)
#define PG8_LDA(dst, b, h) do { _Pragma("unroll") for (int m = 0; m < 4; ++m) _Pragma("unroll") for (int k = 0; k < 2; ++k) dst[m][k] = *(const PG8_LAS bf16x8*)(lds + PG8_SA(b, h) + aoff + m * 2048 + k * 1024); } while (0)
#define PG8_LDB(dst, b, h) do { _Pragma("unroll") for (int n = 0; n < 2; ++n) _Pragma("unroll") for (int k = 0; k < 2; ++k) dst[n][k] = *(const PG8_LAS bf16x8*)(lds + PG8_SB(b, h) + boff + n * 2048 + k * 1024); } while (0)
#define PG8_MMA(ai, bj, At, Bt) do { __builtin_amdgcn_s_setprio(1); _Pragma("unroll") for (int m = 0; m < 4; ++m) _Pragma("unroll") for (int n = 0; n < 2; ++n) _Pragma("unroll") for (int k = 0; k < 2; ++k) \
        acc[ai][bj][m][n] = __builtin_amdgcn_mfma_f32_16x16x32_bf16(Bt[n][k], At[m][k], acc[ai][bj][m][n], 0, 0, 0); __builtin_amdgcn_s_setprio(0); } while (0)
#define PG8_WAIT_V(n) asm volatile("s_waitcnt vmcnt(" #n ")" ::: "memory")
#define PG8_WAIT_L(n) asm volatile("s_waitcnt lgkmcnt(" #n ")" ::: "memory")
#define PG8_BAR __builtin_amdgcn_s_barrier()
#define PG8_SCHED __builtin_amdgcn_sched_barrier(0)
    Unit cur, nxt; int ui = 0;
    if (!S.next(0, cur)) return;
    f32x4 acc[2][2][4][2];
#pragma unroll
    for (int a = 0; a < 2; ++a)
#pragma unroll
        for (int b = 0; b < 2; ++b)
#pragma unroll
            for (int m = 0; m < 4; ++m)
#pragma unroll
                for (int n = 0; n < 2; ++n) acc[a][b][m][n] = (f32x4){0.f, 0.f, 0.f, 0.f};
    bf16x8 At[4][2], B0[2][2], B1[2][2];
    const char* cA = (const char*)g.A + (size_t)cur.pm * tstep; const char* cB = (const char*)g.Bt + (size_t)cur.pn * tstep;
    S.a_ready(cur);
    if constexpr (SP2) {
        PG8_STAGE(PG8_SB(0, 0), cB, voffB); PG8_STAGE(PG8_SB(0, 1), cB + hstepB, voffB); PG8_STAGE(PG8_SA(0, 0), cA, voffA); PG8_STAGE(PG8_SA(0, 1), cA + hstep, voffA);
        if (wr == 1) PG8_BAR;
        PG8_WAIT_V(2); PG8_BAR;
        PG8_STAGE(PG8_SB(1, 0), cB + kstep, voffB); PG8_STAGE(PG8_SA(1, 0), cA + kstep, voffA); PG8_STAGE(PG8_SB(1, 1), cB + hstepB + kstep, voffB);
        PG8_WAIT_V(6); PG8_BAR;
    } else {
        PG8_STAGE(PG8_SB(0, 0), cB, voffB); PG8_STAGE(PG8_SA(0, 0), cA, voffA); PG8_STAGE(PG8_SB(0, 1), cB + hstepB, voffB); PG8_STAGE(PG8_SA(0, 1), cA + hstep, voffA);
        if (wr == 1) PG8_BAR;
        PG8_WAIT_V(4); PG8_BAR;
        PG8_STAGE(PG8_SB(1, 0), cB + kstep, voffB); PG8_STAGE(PG8_SA(1, 0), cA + kstep, voffA); PG8_STAGE(PG8_SB(1, 1), cB + hstepB + kstep, voffB);
        PG8_WAIT_V(6); PG8_BAR;
    }
    for (;;) {
        const bool has_next = S.next(ui + 1, nxt);
        const char* nA = has_next ? (const char*)g.A + (size_t)nxt.pm * tstep : cA; const char* nB = has_next ? (const char*)g.Bt + (size_t)nxt.pn * tstep : cB;
        for (int t = 0; t < nt; t += 2) {
            const bool last = (t == nt - 2);
            const char* a1 = cA + (size_t)(t + 1) * kstep;
            const char* a2 = last ? nA : cA + (size_t)(t + 2) * kstep; const char* b2 = last ? nB : cB + (size_t)(t + 2) * kstep;
            const char* a3 = a2 + kstep; const char* b3 = b2 + kstep;
            if (last && has_next) S.a_ready(nxt);
            if constexpr (SP2) {
            PG8_LDB(B0, 0, 0); PG8_LDB(B1, 0, 1); PG8_SCHED; PG8_LDA(At, 0, 0); PG8_STAGE(PG8_SA(1, 1), a1 + hstep, voffA);
            PG8_WAIT_V(8); PG8_WAIT_L(0); PG8_BAR; PG8_MMA(0, 0, At, B0); PG8_MMA(0, 1, At, B1); PG8_BAR; PG8_SCHED;
            PG8_LDA(At, 0, 1); PG8_STAGE(PG8_SB(0, 0), b2, voffB); PG8_STAGE(PG8_SB(0, 1), b2 + hstepB, voffB); PG8_STAGE(PG8_SA(0, 0), a2, voffA);
            PG8_WAIT_V(8); PG8_WAIT_L(0); PG8_BAR; PG8_MMA(1, 0, At, B0); PG8_MMA(1, 1, At, B1); PG8_BAR; PG8_SCHED;
            PG8_LDB(B0, 1, 0); PG8_LDB(B1, 1, 1); PG8_SCHED; PG8_LDA(At, 1, 0); PG8_STAGE(PG8_SA(0, 1), a2 + hstep, voffA);
            PG8_WAIT_V(8); PG8_WAIT_L(0); PG8_BAR; PG8_MMA(0, 0, At, B0); PG8_MMA(0, 1, At, B1); PG8_BAR; PG8_SCHED;
            PG8_LDA(At, 1, 1); PG8_STAGE(PG8_SB(1, 0), b3, voffB); PG8_STAGE(PG8_SB(1, 1), b3 + hstepB, voffB); PG8_STAGE(PG8_SA(1, 0), a3, voffA);
            PG8_WAIT_V(8); PG8_WAIT_L(0); PG8_BAR; PG8_MMA(1, 0, At, B0); PG8_MMA(1, 1, At, B1); PG8_BAR; PG8_SCHED;
            } else {
            PG8_LDB(B0, 0, 0); PG8_SCHED; PG8_LDA(At, 0, 0); PG8_STAGE(PG8_SA(1, 1), a1 + hstep, voffA);
            PG8_WAIT_L(8); PG8_BAR; PG8_WAIT_L(0); PG8_MMA(0, 0, At, B0); PG8_BAR; PG8_SCHED;
            PG8_LDB(B1, 0, 1); PG8_STAGE(PG8_SB(0, 0), b2, voffB);
            PG8_BAR; PG8_WAIT_L(0); PG8_MMA(0, 1, At, B1); PG8_BAR;
            PG8_LDA(At, 0, 1); PG8_STAGE(PG8_SA(0, 0), a2, voffA);
            PG8_BAR; PG8_WAIT_L(0); PG8_MMA(1, 0, At, B0); PG8_BAR; PG8_SCHED;
            PG8_STAGE(PG8_SB(0, 1), b2 + hstepB, voffB);
            PG8_WAIT_V(6); PG8_BAR; PG8_MMA(1, 1, At, B1); PG8_BAR;
            PG8_LDB(B0, 1, 0); PG8_SCHED; PG8_LDA(At, 1, 0); PG8_STAGE(PG8_SA(0, 1), a2 + hstep, voffA);
            PG8_WAIT_L(8); PG8_BAR; PG8_WAIT_L(0); PG8_MMA(0, 0, At, B0); PG8_BAR; PG8_SCHED;
            PG8_LDB(B1, 1, 1); PG8_STAGE(PG8_SB(1, 0), b3, voffB);
            PG8_BAR; PG8_WAIT_L(0); PG8_MMA(0, 1, At, B1); PG8_BAR;
            PG8_LDA(At, 1, 1); PG8_STAGE(PG8_SA(1, 0), a3, voffA);
            PG8_BAR; PG8_WAIT_L(0); PG8_MMA(1, 0, At, B0); PG8_BAR; PG8_SCHED;
            PG8_STAGE(PG8_SB(1, 1), b3 + hstepB, voffB);
            PG8_WAIT_V(6); PG8_BAR; PG8_MMA(1, 1, At, B1); PG8_BAR;
            }
        }
        if constexpr (ALIGN_EPI) { if (wr == 0) PG8_BAR; }
        if constexpr (!Epi::AFTER_DRAIN) { E(acc, cur, wr, wc, fr, fq); S.done(cur); }
        if (!has_next) break;
#pragma unroll
        for (int a = 0; a < 2; ++a)
#pragma unroll
            for (int b = 0; b < 2; ++b)
#pragma unroll
                for (int m = 0; m < 4; ++m)
#pragma unroll
                    for (int n = 0; n < 2; ++n) acc[a][b][m][n] = (f32x4){0.f, 0.f, 0.f, 0.f};
        cur = nxt; cA = nA; cB = nB; ++ui;
        if constexpr (ALIGN_EPI) { if (wr == 1) PG8_BAR; }
    }
    PG8_WAIT_V(0);
    if constexpr (!ALIGN_EPI) { if (wr == 0) PG8_BAR; }
    PG8_BAR;
    if constexpr (Epi::AFTER_DRAIN) { E.fused(acc, cur, wr, wc, fr, fq, lds, wid, lane); S.done(cur); }
#undef PG8_SA
#undef PG8_SB
#undef PG8_STAGE
#undef PG8_LDA
#undef PG8_LDB
#undef PG8_MMA
#undef PG8_WAIT_V
#undef PG8_WAIT_L
#undef PG8_BAR
#undef PG8_SCHED
}
}


constexpr int NWAVES = 8;
constexpr int RING_OFF = 0, RING_BYTES = 131072;
constexpr int LDSCTL_OFF = RING_BYTES, MISC_OFF = LDSCTL_OFF + 320;
constexpr int LDS_BYTES = 147456;
#define GAS __attribute__((address_space(1)))
#define LAS __attribute__((address_space(3)))
typedef unsigned v4u __attribute__((ext_vector_type(4)));
typedef float f32x4 __attribute__((ext_vector_type(4)));
typedef GAS unsigned gu32;
#define LDS_WAIT() asm volatile("s_waitcnt lgkmcnt(0)" ::: "memory")
#define VM_WAIT() asm volatile("s_waitcnt vmcnt(0)" ::: "memory")
constexpr int CW_BAR = 4096;
constexpr size_t CTL_ZERO_BYTES = 256 * 1024;

#define XB_TMO      128
#define XB_XCNT(j)  (256  + 64 * (j))
#define XB_XSUB(j)  (1280 + 64 * (j))
#define XB_XGEN(j)  (2304 + 64 * (j))
#define XB_TOP      3328
#define XB_TOPGEN   3392
#define XCD_BAR_WORDS 3456
#define XB_SPIN_CAP (1u << 18)
__device__ __forceinline__ unsigned xb_ld(unsigned* p)              { return __hip_atomic_load(p, __ATOMIC_RELAXED, __HIP_MEMORY_SCOPE_AGENT); }
__device__ __forceinline__ unsigned xb_add(unsigned* p, unsigned v) { return __hip_atomic_fetch_add(p, v, __ATOMIC_RELAXED, __HIP_MEMORY_SCOPE_AGENT); }
__device__ __forceinline__ unsigned xb_xcc_id() { return (unsigned)__builtin_amdgcn_s_getreg((3 << 11) | 20) & 0xFu; }
#define XB_SPIN(cond, bar) do { unsigned _sp = 0; while (cond) { __builtin_amdgcn_s_sleep(1); \
    if ((++_sp & 255u) == 0u) { if (xb_ld(&(bar)[XB_TMO])) break; if (_sp > XB_SPIN_CAP) { atomicAdd(&(bar)[XB_TMO], 1u); break; } } } } while (0)
struct XcdBarrier { unsigned* bar; unsigned x; volatile LAS unsigned* st; };
__device__ __forceinline__ XcdBarrier xcd_barrier_post(unsigned* bar, volatile LAS unsigned* st) {
    XcdBarrier b; b.bar = bar; b.x = xb_xcc_id(); b.st = st;
    if (threadIdx.x == 0) (void)xb_add(&bar[XB_XCNT(b.x)], 1u);
    return b;
}
__device__ __forceinline__ void xcd_barrier_complete(unsigned* bar, unsigned x, unsigned& nloc, unsigned& nx) {
    const unsigned G = gridDim.x * gridDim.y * gridDim.z;
    unsigned sum, cnt, mine, sp = 0u;
    for (;;) {
        sum = 0u; cnt = 0u; mine = 0u;
#pragma unroll
        for (unsigned j = 0; j < 16; ++j) { const unsigned c = xb_ld(&bar[XB_XCNT(j)]); sum += c; cnt += (c > 0u) ? 1u : 0u; mine = (j == x) ? c : mine; }
        if (sum == G) break;
        __builtin_amdgcn_s_sleep(1);
        if ((++sp & 255u) == 0u) { if (xb_ld(&bar[XB_TMO])) break; if (sp > XB_SPIN_CAP) { atomicAdd(&bar[XB_TMO], 1u); break; } }
    }
    nloc = mine > 0u ? mine : 1u; nx = cnt > 0u ? cnt : 1u;
}
__device__ __forceinline__ void xcd_barrier(const XcdBarrier& b) {
    asm volatile("s_waitcnt vmcnt(0)" ::: "memory");
    __syncthreads();
    if (threadIdx.x == 0) {
        unsigned* bar = b.bar;
        __builtin_amdgcn_s_waitcnt(0);
        unsigned nloc = b.st[0], nx = b.st[1];
        if (nloc == 0u) { xcd_barrier_complete(bar, b.x, nloc, nx); b.st[0] = nloc; b.st[1] = nx; }
        const unsigned old = xb_add(&bar[XB_XSUB(b.x)], 1u);
        const unsigned gen = old / nloc;
        if (old + 1u == (gen + 1u) * nloc) {
            __builtin_amdgcn_fence(__ATOMIC_RELEASE, "agent");
            asm volatile("s_waitcnt vmcnt(0)" ::: "memory");
            const unsigned og = xb_add(&bar[XB_TOP], 1u);
            const unsigned tg = og / nx;
            if (og + 1u == (tg + 1u) * nx) xb_add(&bar[XB_TOPGEN], 1u);
            else XB_SPIN(xb_ld(&bar[XB_TOPGEN]) == tg, bar);
            __builtin_amdgcn_fence(__ATOMIC_ACQUIRE, "agent");
            xb_add(&bar[XB_XGEN(b.x)], 1u);
            asm volatile("s_waitcnt vmcnt(0)" ::: "memory");
        } else {
            XB_SPIN(xb_ld(&bar[XB_XGEN(b.x)]) == gen, bar);
            __builtin_amdgcn_fence(__ATOMIC_ACQUIRE, "agent");
            asm volatile("s_waitcnt vmcnt(0)" ::: "memory");
        }
    }
    __syncthreads();
}

struct Frame {
    LAS unsigned char* lds; volatile LAS unsigned* MISC; gu32* ctl;
    int tid, lane, wave, vcu, G;
};
__device__ __forceinline__ float wave_sum(float v) {
#pragma unroll
    for (int o = 1; o < 64; o <<= 1) v += __shfl_xor(v, o);
    return v;
}
__device__ __forceinline__ unsigned pk2(float lo, float hi) { return (unsigned)f2bf(lo) | ((unsigned)f2bf(hi) << 16); }
__device__ __forceinline__ void p0_transpose_item(const float* W, int K, int N, int ldw, bf16_t* WT, LAS float* scr, int item, int lane) {
    const int nblk = N / 32, kb = item / nblk, nb = item % nblk, k0 = 64 * kb, n0 = 32 * nb;
#pragma unroll 8
    for (int i = 0; i < 32; ++i) { const int kk = 2 * i + (lane >> 5); scr[kk * 33 + (lane & 31)] = W[(size_t)(k0 + kk) * ldw + n0 + (lane & 31)]; }
    LDS_WAIT(); asm volatile("" ::: "memory");
    const int c = lane & 7;
#pragma unroll
    for (int j = 0; j < 4; ++j) { const int n = (lane >> 3) + 8 * j; const LAS float* s = scr + (8 * c) * 33 + n;
        v4u o; o.x = pk2(s[0 * 33], s[1 * 33]); o.y = pk2(s[2 * 33], s[3 * 33]); o.z = pk2(s[4 * 33], s[5 * 33]); o.w = pk2(s[6 * 33], s[7 * 33]);
        *(GAS v4u*)(WT + (size_t)(n0 + n) * K + k0 + 8 * c) = o; }
    LDS_WAIT(); asm volatile("" ::: "memory");
}

struct Args { const float* in[22]; float* out; unsigned char* ws; int ph_lo, ph_hi, li, pad; };

__device__ __forceinline__ void p0_prologue(Frame& F, const Args& a) {
    unsigned char* ws = a.ws;
    if (F.wave == 0 && F.vcu < 96) {
        const int j = F.vcu * 64 + F.lane;
        const float* wa = a.in[8] + j; const float* cc = a.in[6]; const float* cx = a.in[7];
        float a0 = 0.f, a1 = 0.f, a2 = 0.f;
#pragma unroll 8
        for (int k = 0; k < D; ++k) { const float w = wa[(size_t)k * 6144]; a0 += siluf(cx[k]) * w; a1 += siluf(cc[k]) * w; a2 += siluf(cc[D + k]) * w; }
        float* mod = (float*)(ws + WS_MOD); const float bb = a.in[9][j];
        mod[j] = a0 + bb; mod[6144 + j] = a1 + bb; mod[12288 + j] = a2 + bb;
    }
    if (F.vcu == 100) {
        for (int e = F.tid; e < 2048; e += NWAVES * 64) { const int pos = e >> 5, f = e & 31;
            const float inv = exp2f(-(float)f * (13.287712379549449f / 32.f)); const float ang = (float)pos * inv;
            float sn, cs; sincosf(ang, &sn, &cs);
            float* rc = (float*)(ws + WS_ROPE); rc[e] = cs; rc[2048 + e] = sn; }
    }
    LAS float* scr = (LAS float*)(F.lds + RING_OFF + F.wave * 16384);
    const int gw = F.vcu * NWAVES + F.wave, NGW = F.G * NWAVES;
    constexpr int I_IN = (D / 64) * (4096 / 32), I_O = (D / 64) * (D / 32), I_1 = (D / 64) * (FF / 32), I_2 = (FF / 64) * (D / 32);
    constexpr int NITEMS = I_IN + I_O + I_1 + I_2;
    for (int it = NITEMS - 1 - gw; it >= 0; it -= NGW) {
        int r = it;
        if (r < I_IN) { p0_transpose_item(a.in[12], D, 4096, INC, (bf16_t*)(ws + WS_WIN), scr, r, F.lane); continue; } r -= I_IN;
        if (r < I_O) { p0_transpose_item(a.in[18], D, D, D, (bf16_t*)(ws + WS_WOUT), scr, r, F.lane); continue; } r -= I_O;
        if (r < I_1) { p0_transpose_item(a.in[19], D, FF, FF, (bf16_t*)(ws + WS_W1), scr, r, F.lane); continue; } r -= I_1;
        p0_transpose_item(a.in[20], FF, D, D, (bf16_t*)(ws + WS_W2), scr, r, F.lane);
    }
}

__device__ __forceinline__ void p1_norm_gates(Frame& F, const Args& a) {
    LAS float* wg = (LAS float*)(F.lds + RING_OFF);
    for (int e = F.tid; e < 1024 * 16; e += NWAVES * 64) { const int k = e >> 4, j = e & 15; wg[k * 20 + j] = a.in[12][(size_t)k * INC + 4096 + j]; }
    __syncthreads();
    const int gw = F.vcu * NWAVES + F.wave, NGW = F.G * NWAVES, lane = F.lane;
    const float* mod = (const float*)(a.ws + WS_MOD);
    float A1[16], S1[16]; int cur = -1;
    for (int m = gw; m < M; m += NGW) {
        const int cnd = cond_of(m);
        if (cnd != cur) { cur = cnd;
#pragma unroll
            for (int i = 0; i < 16; ++i) { const int k = lane + 64 * i; A1[i] = a.in[10][k] * (1.f + mod[cnd * 6144 + 1024 + k]); S1[i] = mod[cnd * 6144 + k]; } }
        const float* xr = m < NP ? a.in[0] + (size_t)m * D : a.in[1] + (size_t)(m - NP) * D;
        float v[16]; float ss = 0.f;
#pragma unroll
        for (int i = 0; i < 16; ++i) { v[i] = xr[lane + 64 * i]; ss += v[i] * v[i]; }
        ss = wave_sum(ss);
        const float rstd = rsqrtf(ss * (1.f / D) + EPS);
        bf16_t* H = (bf16_t*)(a.ws + WS_H) + (size_t)m * D;
        float ga[16];
#pragma unroll
        for (int j = 0; j < 16; ++j) ga[j] = 0.f;
#pragma unroll
        for (int i = 0; i < 16; ++i) {
            const float h = v[i] * rstd * A1[i] + S1[i];
            H[lane + 64 * i] = f2bf(h);
            const LAS f32x4* wr = (const LAS f32x4*)(wg + (lane + 64 * i) * 20);
            const f32x4 w0 = wr[0], w1 = wr[1], w2 = wr[2], w3 = wr[3];
#pragma unroll
            for (int j = 0; j < 4; ++j) { ga[j] += h * w0[j]; ga[4 + j] += h * w1[j]; ga[8 + j] += h * w2[j]; ga[12 + j] += h * w3[j]; }
            if (i & 1) asm volatile("" ::: "memory");
        }
        { const bool hi = lane & 32;
#pragma unroll
          for (int j = 0; j < 8; ++j) { const float keep = hi ? ga[j + 8] : ga[j], give = hi ? ga[j] : ga[j + 8]; ga[j] = keep + __shfl_xor(give, 32); } }
        { const bool hi = lane & 16;
#pragma unroll
          for (int j = 0; j < 4; ++j) { const float keep = hi ? ga[j + 4] : ga[j], give = hi ? ga[j] : ga[j + 4]; ga[j] = keep + __shfl_xor(give, 16); } }
        { const bool hi = lane & 8;
#pragma unroll
          for (int j = 0; j < 2; ++j) { const float keep = hi ? ga[j + 2] : ga[j], give = hi ? ga[j] : ga[j + 2]; ga[j] = keep + __shfl_xor(give, 8); } }
        { const bool hi = lane & 4; const float keep = hi ? ga[1] : ga[0], give = hi ? ga[0] : ga[1]; ga[0] = keep + __shfl_xor(give, 4); }
        ga[0] += __shfl_xor(ga[0], 2); ga[0] += __shfl_xor(ga[0], 1);
        if ((lane & 3) == 0) ((float*)(a.ws + WS_GATES))[(size_t)m * 16 + (lane >> 2)] = ga[0] + a.in[15][lane >> 2];
    }
}

__global__ void __launch_bounds__(NWAVES * 64, 2) mega(Args args) {
    extern __shared__ __attribute__((aligned(16))) unsigned char lds[];
    Frame F;
    F.lds = (LAS unsigned char*)lds;
    F.MISC = (volatile LAS unsigned*)(F.lds + MISC_OFF);
    F.tid = threadIdx.x; F.lane = F.tid & 63; F.wave = __builtin_amdgcn_readfirstlane(F.tid >> 6);
    F.G = gridDim.x; { const int bx = blockIdx.x; F.vcu = (F.G % 8 == 0) ? (bx % 8) * (F.G / 8) + bx / 8 : bx; }
    unsigned char* ws = args.ws;
    F.ctl = (gu32*)(ws + WS_CTL);
    for (int u = F.tid; u < (LDS_BYTES - LDSCTL_OFF) / 4; u += NWAVES * 64) ((LAS unsigned*)(F.lds + LDSCTL_OFF))[u] = 0u;
    __syncthreads();
    XcdBarrier bar = xcd_barrier_post((unsigned*)(F.ctl + CW_BAR) + args.li * XCD_BAR_WORDS, F.MISC + 8);
    const int lo = args.ph_lo, hi = args.ph_hi;
#define IN(k) (lo <= (k) && (k) < hi)
#define BOTH(k) (IN(k) && IN((k) + 1))
    if (IN(0)) { p0_prologue(F, args); if (BOTH(0)) xcd_barrier(bar); }
    if (IN(1)) { p1_norm_gates(F, args); if (BOTH(1)) xcd_barrier(bar); }
    if (IN(2)) {
        pg8::Gemm g{(const bf16_t*)(ws + WS_H), (const bf16_t*)(ws + WS_WIN), M, 4096, D}; pg8::StaticOrder S; S.init(M, 4096, F.G, (int)blockIdx.x);
        pg8::EpiProj E{ws, (const float*)(ws + WS_ROPE)};
        pg8::gemm_phase<pg8::EpiProj, pg8::StaticOrder, true, true>(F.lds + RING_OFF, g, S, E);
        if (BOTH(2)) xcd_barrier(bar);
    }
    if (IN(4)) {
        pg8::Gemm g{(const bf16_t*)(ws + WS_MIX), (const bf16_t*)(ws + WS_WOUT), M, D, D}; pg8::StaticOrder S; S.init(M, D, F.G, (int)blockIdx.x);
        pg8::EpiRes E{args.in[0], args.in[1], args.out + O_Y, (const float*)(ws + WS_MOD) + 2048};
        pg8::gemm_phase<pg8::EpiRes, pg8::StaticOrder, true, true>(F.lds + RING_OFF, g, S, E);
        if (BOTH(4)) xcd_barrier(bar);
    }
    if (IN(6)) {
        pg8::Gemm g{(const bf16_t*)(ws + WS_H), (const bf16_t*)(ws + WS_W1), M, FF, D}; pg8::StaticOrder S; S.init(M, FF, F.G, (int)blockIdx.x);
        pg8::EpiRelu2 E{(bf16_t*)(ws + WS_U)};
        pg8::gemm_phase<pg8::EpiRelu2, pg8::StaticOrder, true, true>(F.lds + RING_OFF, g, S, E);
        if (BOTH(6)) xcd_barrier(bar);
    }
    if (IN(7)) {
        pg8::Gemm g{(const bf16_t*)(ws + WS_U), (const bf16_t*)(ws + WS_W2), M, D, FF}; pg8::StaticOrder S; S.init(M, D, F.G, (int)blockIdx.x);
        pg8::EpiRes E{args.out + O_Y, args.out + O_Y + (size_t)NP * D, args.out + O_Y, (const float*)(ws + WS_MOD) + 5120};
        pg8::gemm_phase<pg8::EpiRes, pg8::StaticOrder, true, true>(F.lds + RING_OFF, g, S, E);
        if (BOTH(7)) xcd_barrier(bar);
    }
#undef IN
#undef BOTH
}

extern "C" void kernel_launch(void* const* d_in, const int* in_sizes, int n_in, void* d_out, int out_size, void* d_ws, size_t ws_size, hipStream_t stream) {
    static int grid = 0;
    if (grid == 0) {
        if (n_in != 22 || ws_size < WS_END) { fprintf(stderr, "kernel_launch: unexpected n_in %d / ws_size %zu\n", n_in, ws_size); grid = -1; return; }
        int dev = 0, cus = 0, per_cu = 0;
        if (hipGetDevice(&dev) != hipSuccess || hipDeviceGetAttribute(&cus, hipDeviceAttributeMultiprocessorCount, dev) != hipSuccess) { grid = -1; return; }
        if (hipFuncSetAttribute((const void*)mega, hipFuncAttributeMaxDynamicSharedMemorySize, LDS_BYTES) != hipSuccess) { fprintf(stderr, "kernel_launch: hipFuncSetAttribute failed\n"); grid = -1; return; }
        if (hipOccupancyMaxActiveBlocksPerMultiprocessor(&per_cu, (const void*)mega, NWAVES * 64, LDS_BYTES) != hipSuccess || per_cu < 1) fprintf(stderr, "kernel_launch: occupancy query says %d\n", per_cu);
        (void)hipGetLastError();
        grid = cus;
    }
    if (grid < 0) return;
    P p{};
    p.xp = (const float*)d_in[0]; p.xs = (const float*)d_in[1]; p.st_ret = (const float*)d_in[2]; p.st_C = (const float*)d_in[3];
    p.st_n = (const float*)d_in[4]; p.st_m = (const float*)d_in[5]; p.c = (const float*)d_in[6]; p.cctx = (const float*)d_in[7];
    p.w_ada = (const float*)d_in[8]; p.b_ada = (const float*)d_in[9]; p.n1g = (const float*)d_in[10]; p.n2g = (const float*)d_in[11];
    p.w_in = (const float*)d_in[12]; p.conv_w = (const float*)d_in[13]; p.decay = (const float*)d_in[14]; p.gbias = (const float*)d_in[15];
    p.rgn = (const float*)d_in[16]; p.mgn = (const float*)d_in[17]; p.w_out = (const float*)d_in[18]; p.w_ff1 = (const float*)d_in[19];
    p.w_ff2 = (const float*)d_in[20]; p.fg = (const float*)d_in[21];
    p.out = (float*)d_out; p.ws = (unsigned char*)d_ws;
    (void)hipMemsetAsync((char*)d_ws + WS_CTL, 0, CTL_ZERO_BYTES, stream);
    Args a{};
    for (int i = 0; i < 22; ++i) a.in[i] = (const float*)d_in[i];
    a.out = (float*)d_out; a.ws = (unsigned char*)d_ws;
    int li = 0;
#define MEGA(lo_, hi_) do { a.ph_lo = (lo_); a.ph_hi = (hi_); a.li = li++; hipLaunchKernelGGL(mega, dim3(grid), dim3(NWAVES * 64), LDS_BYTES, stream, a); } while (0)
    MEGA(0, 3);
    k_conv<<<M, 256, 0, stream>>>(p);
    k_gates<<<5, 64, 0, stream>>>(p);
    k_mix<<<dim3(M / 16, 4, 2), 256, 0, stream>>>(p);
    k_states<<<dim3(32, 4, 4), 256, 0, stream>>>(p);
    MEGA(4, 5);
    k_norm<<<M, 256, 0, stream>>>(p, 1);
    MEGA(6, 8);
    k_final<<<M, 256, 0, stream>>>(p);
}
```

```cpp
#include <hip/hip_runtime.h>
#include <cstdint>
#include <cstdio>

typedef unsigned short bf16_t;

constexpr int D = 1024, NP = 32 * 256, NS = 2 * 2048, M = NP + NS;
constexpr int TP = 256, TS = 2048;
constexpr int INC = 4112, FF = 4096, NH = 4, HD = 128, W5 = 512;
constexpr float EPS = 1e-6f;

constexpr size_t MiB = 1u << 20;
constexpr size_t WS_CTL = 0;
constexpr size_t WS_MOD = 1 * MiB;
constexpr size_t WS_ROPE = 1 * MiB + 128 * 1024;
constexpr size_t WS_GATES = 2 * MiB;
constexpr size_t WS_GLI = 3 * MiB;
constexpr size_t WS_GCUM = 3 * MiB + 512 * 1024;
constexpr size_t WS_WIN = 4 * MiB;
constexpr size_t WS_WOUT = 12 * MiB;
constexpr size_t WS_W1 = 14 * MiB;
constexpr size_t WS_W2 = 22 * MiB;
constexpr size_t WS_H = 32 * MiB;
constexpr size_t WS_MIX = 56 * MiB;
constexpr size_t WS_RQ = 80 * MiB;
constexpr size_t WS_RK = 92 * MiB;
constexpr size_t WS_RV = 104 * MiB;
constexpr size_t WS_RG = 116 * MiB;
constexpr size_t WS_MQKP = 128 * MiB;
constexpr size_t WS_MV = 152 * MiB;
constexpr size_t WS_MO = 164 * MiB;
constexpr size_t WS_MQ = 176 * MiB;
constexpr size_t WS_MK = 188 * MiB;
constexpr size_t WS_U = 80 * MiB;
constexpr size_t WS_END = 200 * MiB;

constexpr size_t O_Y = 0;
constexpr size_t O_RET = (size_t)M * D;
constexpr size_t O_C = O_RET + (size_t)32 * 2 * 4 * 128 * 128;
constexpr size_t O_N = O_C + (size_t)32 * 2 * 4 * 128 * 128;
constexpr size_t O_M = O_N + (size_t)32 * 2 * 4 * 128;

__device__ __forceinline__ float bf2f(bf16_t v) { return __uint_as_float((unsigned)v << 16); }
__device__ __forceinline__ bf16_t f2bf(float f) { unsigned u = __float_as_uint(f); return (bf16_t)((u + 0x7fffu + ((u >> 16) & 1u)) >> 16); }
__device__ __forceinline__ float siluf(float x) { return x / (1.f + __expf(-x)); }
__device__ __forceinline__ float sigmf(float x) { return 1.f / (1.f + __expf(-x)); }
__device__ __forceinline__ float logsigf(float x) { return fminf(x, 0.f) - log1pf(__expf(-fabsf(x))); }
__device__ __forceinline__ int cond_of(int m) { return m < NP ? 0 : 1 + (m - NP) / TS; }

struct P {
    const float *xp, *xs, *st_ret, *st_C, *st_n, *st_m, *c, *cctx, *w_ada, *b_ada, *n1g, *n2g, *w_in, *conv_w, *decay, *gbias, *rgn, *mgn, *w_out, *w_ff1, *w_ff2, *fg;
    float* out; unsigned char* ws;
};
__device__ __forceinline__ const float* xrow(const P& p, int m) { return m < NP ? p.xp + (size_t)m * D : p.xs + (size_t)(m - NP) * D; }

__global__ void k_wt(const float* W, int ldw, int K, bf16_t* WT) {
    __shared__ float t[32][33];
    const int n0 = blockIdx.x * 32, k0 = blockIdx.y * 32, tx = threadIdx.x, ty = threadIdx.y;
    for (int i = ty; i < 32; i += 8) t[i][tx] = W[(size_t)(k0 + i) * ldw + n0 + tx];
    __syncthreads();
    for (int i = ty; i < 32; i += 8) WT[(size_t)(n0 + i) * K + k0 + tx] = f2bf(t[tx][i]);
}

__global__ void k_mod(P p) {
    const int j = blockIdx.x * 256 + threadIdx.x, cnd = blockIdx.y;
    const float* cv = cnd == 0 ? p.cctx : p.c + (size_t)(cnd - 1) * D;
    float acc = 0.f;
    for (int k = 0; k < D; ++k) acc += siluf(cv[k]) * p.w_ada[(size_t)k * 6144 + j];
    ((float*)(p.ws + WS_MOD))[cnd * 6144 + j] = acc + p.b_ada[j];
}

__global__ void k_rope(P p) {
    const int pos = blockIdx.x, f = threadIdx.x;
    const float inv = (float)exp(-(double)f / 32.0 * log(10000.0));
    const float ang = (float)pos * inv;
    float* rc = (float*)(p.ws + WS_ROPE);
    rc[pos * 32 + f] = (float)cos((double)ang);
    rc[2048 + pos * 32 + f] = (float)sin((double)ang);
}

__device__ __forceinline__ float block_sum256(float v, float* red) {
    for (int o = 32; o > 0; o >>= 1) v += __shfl_xor(v, o);
    __syncthreads();
    if ((threadIdx.x & 63) == 0) red[threadIdx.x >> 6] = v;
    __syncthreads();
    return red[0] + red[1] + red[2] + red[3];
}

__global__ void k_norm(P p, int which) {
    __shared__ float red[4];
    __shared__ float gsum[16][4];
    const int m = blockIdx.x, tid = threadIdx.x, cnd = cond_of(m);
    const float* xr = which == 0 ? xrow(p, m) : p.out + O_Y + (size_t)m * D;
    const float* mod = (const float*)(p.ws + WS_MOD) + cnd * 6144;
    const float* sh = mod + (which == 0 ? 0 : 3072);
    const float* sc = mod + (which == 0 ? 1024 : 4096);
    const float* g = which == 0 ? p.n1g : p.n2g;
    float v[4], ss = 0.f;
    for (int i = 0; i < 4; ++i) { v[i] = xr[tid + 256 * i]; ss += v[i] * v[i]; }
    ss = block_sum256(ss, red);
    const float rstd = rsqrtf(ss * (1.f / D) + EPS);
    bf16_t* H = (bf16_t*)(p.ws + WS_H) + (size_t)m * D;
    float h[4];
    for (int i = 0; i < 4; ++i) { const int k = tid + 256 * i; h[i] = v[i] * rstd * g[k] * (1.f + sc[k]) + sh[k]; H[k] = f2bf(h[i]); }
    if (which == 0) {
        float ga[16];
        for (int j = 0; j < 16; ++j) ga[j] = 0.f;
        for (int i = 0; i < 4; ++i) { const int k = tid + 256 * i; const float* wr = p.w_in + (size_t)k * INC + 4096;
            for (int j = 0; j < 16; ++j) ga[j] += h[i] * wr[j]; }
        for (int j = 0; j < 16; ++j) { float s = ga[j]; for (int o = 32; o > 0; o >>= 1) s += __shfl_xor(s, o); if ((tid & 63) == 0) gsum[j][tid >> 6] = s; }
        __syncthreads();
        if (tid < 16) ((float*)(p.ws + WS_GATES))[(size_t)m * 16 + tid] = gsum[tid][0] + gsum[tid][1] + gsum[tid][2] + gsum[tid][3] + p.gbias[tid];
    }
}

enum { EPI_PROJ = 0, EPI_RES1 = 1, EPI_RELU2 = 2, EPI_RES2 = 3 };
template <int EPI>
__global__ void __launch_bounds__(256) k_gemm(P p, const bf16_t* A, const bf16_t* WT, int K) {
    __shared__ float As[16][68];
    __shared__ float Bs[16][132];
    __shared__ float Cs[64][129];
    const int tid = threadIdx.x, m0 = blockIdx.y * 64, n0 = blockIdx.x * 128;
    const int ty = tid >> 4, tx = tid & 15;
    float acc[4][8];
    for (int i = 0; i < 4; ++i) for (int j = 0; j < 8; ++j) acc[i][j] = 0.f;
    for (int k0 = 0; k0 < K; k0 += 16) {
        { const int r = tid >> 2, kk = (tid & 3) * 4; const bf16_t* a = A + (size_t)(m0 + r) * K + k0 + kk;
          for (int j = 0; j < 4; ++j) As[kk + j][r] = bf2f(a[j]); }
        { const int r = tid >> 1, kk = (tid & 1) * 8; const bf16_t* b = WT + (size_t)(n0 + r) * K + k0 + kk;
          for (int j = 0; j < 8; ++j) Bs[kk + j][r] = bf2f(b[j]); }
        __syncthreads();
        for (int kk = 0; kk < 16; ++kk) {
            float a[4], b[8];
            for (int i = 0; i < 4; ++i) a[i] = As[kk][ty * 4 + i];
            for (int j = 0; j < 8; ++j) b[j] = Bs[kk][tx * 8 + j];
            for (int i = 0; i < 4; ++i) for (int j = 0; j < 8; ++j) acc[i][j] += a[i] * b[j];
        }
        __syncthreads();
    }
    for (int i = 0; i < 4; ++i) for (int j = 0; j < 8; ++j) Cs[ty * 4 + i][tx * 8 + j] = acc[i][j];
    __syncthreads();
    if (EPI == EPI_PROJ) {
        const int sec = n0 / 512, hc = n0 % 512;
        const float* rc = (const float*)(p.ws + WS_ROPE);
        for (int e = tid; e < 64 * 128; e += 256) {
            const int r = e >> 7, d = e & 127, m = m0 + r;
            float v = Cs[r][d];
            if (sec <= 1) {
                if (sec == 1) v *= 0.08838834764831845f;
                if (m >= NP) {
                    const int t = (m - NP) % TS, dd = d & 63, f = dd & 31, pos = dd < 32 ? t / 64 : t % 64;
                    const float cs = rc[pos * 32 + f], sn = rc[2048 + pos * 32 + f];
                    float o = Cs[r][d ^ 64]; if (sec == 1) o *= 0.08838834764831845f;
                    v = d < 64 ? v * cs - o * sn : o * sn + v * cs;
                }
                ((bf16_t*)(p.ws + (sec == 0 ? WS_RQ : WS_RK)))[(size_t)m * W5 + hc + d] = f2bf(v);
            } else if (sec == 2) ((bf16_t*)(p.ws + WS_RV))[(size_t)m * W5 + hc + d] = f2bf(v);
            else if (sec == 3) ((bf16_t*)(p.ws + WS_RG))[(size_t)m * W5 + hc + d] = f2bf(siluf(v));
            else if (sec <= 5) ((bf16_t*)(p.ws + WS_MQKP))[(size_t)m * 1024 + (n0 - 2048) + d] = f2bf(v);
            else if (sec == 6) ((bf16_t*)(p.ws + WS_MV))[(size_t)m * W5 + hc + d] = f2bf(v);
            else ((bf16_t*)(p.ws + WS_MO))[(size_t)m * W5 + hc + d] = f2bf(sigmf(v));
        }
    } else if (EPI == EPI_RES1) {
        for (int e = tid; e < 64 * 128; e += 256) { const int r = e >> 7, n = n0 + (e & 127), m = m0 + r;
            const float g1 = ((const float*)(p.ws + WS_MOD))[cond_of(m) * 6144 + 2048 + n];
            p.out[O_Y + (size_t)m * D + n] = xrow(p, m)[n] + g1 * Cs[r][e & 127]; }
    } else if (EPI == EPI_RELU2) {
        for (int e = tid; e < 64 * 128; e += 256) { const int r = e >> 7, n = n0 + (e & 127), m = m0 + r;
            const float v = fmaxf(Cs[r][e & 127], 0.f);
            ((bf16_t*)(p.ws + WS_U))[(size_t)m * FF + n] = f2bf(v * v); }
    } else {
        for (int e = tid; e < 64 * 128; e += 256) { const int r = e >> 7, n = n0 + (e & 127), m = m0 + r;
            const float g2 = ((const float*)(p.ws + WS_MOD))[cond_of(m) * 6144 + 5120 + n];
            p.out[O_Y + (size_t)m * D + n] += g2 * Cs[r][e & 127]; }
    }
}

__global__ void k_conv(P p) {
    const int m = blockIdx.x, T = m < NP ? TP : TS, t = m < NP ? m % TP : (m - NP) % TS;
    const bf16_t* X = (const bf16_t*)(p.ws + WS_MQKP);
    for (int c = threadIdx.x; c < 1024; c += 256) {
        float v = p.conv_w[1024 + c] * bf2f(X[(size_t)m * 1024 + c]);
        if (t > 0) v += p.conv_w[c] * bf2f(X[(size_t)(m - 1) * 1024 + c]);
        if (t < T - 1) v += p.conv_w[2048 + c] * bf2f(X[(size_t)(m + 1) * 1024 + c]);
        v = siluf(v);
        if (c < 512) ((bf16_t*)(p.ws + WS_MQ))[(size_t)m * W5 + c] = f2bf(v);
        else ((bf16_t*)(p.ws + WS_MK))[(size_t)m * W5 + c - 512] = f2bf(v * 0.08838834764831845f);
    }
}

__global__ void k_gates(P p) {
    const int id = blockIdx.x * 64 + threadIdx.x;
    if (id >= 34 * 8) return;
    const int seq = id / 8, h = id % 4, dir = (id / 4) % 2;
    const int T = seq < 32 ? TP : TS, mbase = seq < 32 ? seq * TP : NP + (seq - 32) * TS;
    const float* G = (const float*)(p.ws + WS_GATES);
    float* LI = (float*)(p.ws + WS_GLI) + (size_t)(dir * 4 + h) * M;
    float* CU = (float*)(p.ws + WS_GCUM) + (size_t)(dir * 4 + h) * M;
    float cum = 0.f;
    for (int i = 0; i < T; ++i) {
        const int m = mbase + (dir == 0 ? i : T - 1 - i);
        cum += logsigf(G[(size_t)m * 16 + dir * 8 + 4 + h]);
        CU[m] = cum; LI[m] = G[(size_t)m * 16 + dir * 8 + h];
    }
}

__global__ void __launch_bounds__(256) k_mix(P p) {
    __shared__ float qs[16][128];
    __shared__ float ks[32][129];
    __shared__ float vs[32][128];
    __shared__ float pf[16][32], pb[16][32];
    __shared__ float os[16][129];
    const int tid = threadIdx.x, m0 = blockIdx.x * 16, h = blockIdx.y, type = blockIdx.z;
    const bool lat = m0 >= NP;
    const int T = lat ? TS : TP, sb = lat ? NP + ((m0 - NP) / TS) * TS : (m0 / TP) * TP, t0 = m0 - sb;
    const bf16_t* Q = (const bf16_t*)(p.ws + (type == 0 ? WS_RQ : WS_MQ));
    const bf16_t* Kp = (const bf16_t*)(p.ws + (type == 0 ? WS_RK : WS_MK));
    const bf16_t* V = (const bf16_t*)(p.ws + (type == 0 ? WS_RV : WS_MV));
    const float lgf = logsigf(p.decay[h]), lgb = logsigf(p.decay[4 + h]);
    const float* LI0 = (const float*)(p.ws + WS_GLI) + (size_t)h * M;
    const float* LI1 = (const float*)(p.ws + WS_GLI) + (size_t)(4 + h) * M;
    const float* CU0 = (const float*)(p.ws + WS_GCUM) + (size_t)h * M;
    const float* CU1 = (const float*)(p.ws + WS_GCUM) + (size_t)(4 + h) * M;
    for (int e = tid; e < 16 * 128; e += 256) qs[e >> 7][e & 127] = bf2f(Q[(size_t)(m0 + (e >> 7)) * W5 + h * HD + (e & 127)]);
    const int e_ = tid & 127, rh = tid >> 7;
    float of[8], ob[8];
    for (int i = 0; i < 8; ++i) { of[i] = 0.f; ob[i] = 0.f; }
    float den = 0.f;
    for (int s0 = 0; s0 < T; s0 += 32) {
        __syncthreads();
        for (int e = tid; e < 32 * 128; e += 256) { const int s = e >> 7, d = e & 127; const size_t a = (size_t)(sb + s0 + s) * W5 + h * HD + d;
            ks[s][d] = bf2f(Kp[a]); vs[s][d] = bf2f(V[a]); }
        __syncthreads();
        for (int e = tid; e < 16 * 32; e += 256) {
            const int r = e >> 5, s = e & 31, t = t0 + r, sg = s0 + s;
            float dot = 0.f;
            for (int d = 0; d < 128; ++d) dot += qs[r][d] * ks[s][d];
            float wf, wb;
            if (type == 0) {
                wf = sg < t ? __expf(lgf * (float)(t - sg)) : (sg > t ? __expf(lgb * (float)(sg - t)) : 2.f);
                wb = 0.f;
            } else {
                wf = sg <= t ? __expf(CU0[sb + t] - CU0[sb + sg] + LI0[sb + sg]) : 0.f;
                wb = sg >= t ? __expf(CU1[sb + t] - CU1[sb + sg] + LI1[sb + sg]) : 0.f;
            }
            pf[r][s] = dot * wf; pb[r][s] = dot * wb;
        }
        __syncthreads();
        if (tid < 32) { const int r = tid & 15; float a = 0.f; for (int s = 0; s < 32; ++s) a += (tid < 16 ? pf[r][s] : pb[r][s]); den += a; }
        for (int s = 0; s < 32; ++s) { const float v = vs[s][e_];
            for (int i = 0; i < 8; ++i) { of[i] += pf[rh * 8 + i][s] * v; ob[i] += pb[rh * 8 + i][s] * v; } }
    }
    __syncthreads();
    float* dens = &pf[0][0];
    if (tid < 32) dens[tid] = den;
    __syncthreads();
    if (lat) {
        const int b = (m0 - NP) / TS;
        const float* S0f = (type == 0 ? p.st_ret : p.st_C) + ((size_t)((b * 2 + 0) * 4 + h)) * 128 * 128;
        const float* S0b = (type == 0 ? p.st_ret : p.st_C) + ((size_t)((b * 2 + 1) * 4 + h)) * 128 * 128;
        for (int i = 0; i < 8; ++i) {
            const int r = rh * 8 + i, t = t0 + r;
            float af = 0.f, ab = 0.f;
            for (int d = 0; d < 128; ++d) { af += qs[r][d] * S0f[d * 128 + e_]; ab += qs[r][d] * S0b[d * 128 + e_]; }
            float cf, cb;
            if (type == 0) { cf = __expf(lgf * (float)(t + 1)); cb = __expf(lgb * (float)(T - t)); }
            else { cf = __expf(CU0[sb + t] + p.st_m[(b * 2 + 0) * 4 + h]); cb = __expf(CU1[sb + t] + p.st_m[(b * 2 + 1) * 4 + h]); }
            of[i] += cf * af; ob[i] += cb * ab;
        }
        if (type == 1 && tid < 32) {
            const int r = tid & 15, dir = tid >> 4, t = t0 + r;
            const float* n0 = p.st_n + (size_t)((b * 2 + dir) * 4 + h) * 128;
            float a = 0.f; for (int d = 0; d < 128; ++d) a += qs[r][d] * n0[d];
            const float cfb = __expf((dir == 0 ? CU0 : CU1)[sb + t] + p.st_m[(b * 2 + dir) * 4 + h]);
            dens[tid] += cfb * a;
        }
        __syncthreads();
    }
    for (int i = 0; i < 8; ++i) {
        const int r = rh * 8 + i;
        float o;
        if (type == 0) o = of[i] + ob[i];
        else o = of[i] / fmaxf(fabsf(dens[r]), 1.f) + ob[i] / fmaxf(fabsf(dens[16 + r]), 1.f);
        os[r][e_] = o;
    }
    __syncthreads();
    for (int i = 0; i < 8; ++i) {
        const int r = rh * 8 + i, m = m0 + r;
        float mu = 0.f; for (int d = 0; d < 128; ++d) mu += os[r][d];
        mu *= (1.f / 128.f);
        float var = 0.f; for (int d = 0; d < 128; ++d) { const float x = os[r][d] - mu; var += x * x; }
        var *= (1.f / 128.f);
        const float y = (os[r][e_] - mu) * rsqrtf(var + EPS);
        const float g = (type == 0 ? p.rgn : p.mgn)[h * HD + e_];
        const float gate = bf2f(((const bf16_t*)(p.ws + (type == 0 ? WS_RG : WS_MO)))[(size_t)m * W5 + h * HD + e_]);
        ((bf16_t*)(p.ws + WS_MIX))[(size_t)m * D + type * 512 + h * HD + e_] = f2bf(y * g * gate);
    }
}

__global__ void __launch_bounds__(256) k_states(P p) {
    __shared__ float ks[32][128], vs[32][128], ws_[256];
    __shared__ float red[4];
    const int tid = threadIdx.x, b = blockIdx.x, h = blockIdx.y, type = blockIdx.z >> 1, dir = blockIdx.z & 1;
    const int sb = b * TP;
    const bf16_t* Kp = (const bf16_t*)(p.ws + (type == 0 ? WS_RK : WS_MK));
    const bf16_t* V = (const bf16_t*)(p.ws + (type == 0 ? WS_RV : WS_MV));
    float mfin = 0.f;
    {
        const int s = tid; float lw;
        if (type == 0) { const float lg = logsigf(p.decay[dir * 4 + h]); lw = lg * (float)(dir == 0 ? TP - 1 - s : s); }
        else {
            const float* LI = (const float*)(p.ws + WS_GLI) + (size_t)(dir * 4 + h) * M;
            const float* CU = (const float*)(p.ws + WS_GCUM) + (size_t)(dir * 4 + h) * M;
            const float tot = CU[sb + (dir == 0 ? TP - 1 : 0)];
            lw = tot - CU[sb + s] + LI[sb + s];
            float mx = lw; for (int o = 32; o > 0; o >>= 1) mx = fmaxf(mx, __shfl_xor(mx, o));
            if ((tid & 63) == 0) red[tid >> 6] = mx;
            __syncthreads();
            mfin = fmaxf(fmaxf(fmaxf(red[0], red[1]), fmaxf(red[2], red[3])), tot);
            lw -= mfin;
        }
        ws_[s] = __expf(lw);
    }
    const int dk0 = (tid >> 4) * 8, dv0 = (tid & 15) * 8;
    float acc[8][8]; float nacc = 0.f;
    for (int i = 0; i < 8; ++i) for (int j = 0; j < 8; ++j) acc[i][j] = 0.f;
    for (int s0 = 0; s0 < TP; s0 += 32) {
        __syncthreads();
        for (int e = tid; e < 32 * 128; e += 256) { const int s = e >> 7, d = e & 127; const size_t a = (size_t)(sb + s0 + s) * W5 + h * HD + d;
            ks[s][d] = bf2f(Kp[a]); vs[s][d] = bf2f(V[a]); }
        __syncthreads();
        for (int s = 0; s < 32; ++s) {
            const float w = ws_[s0 + s];
            float kk[8], vv[8];
            for (int i = 0; i < 8; ++i) { kk[i] = ks[s][dk0 + i] * w; vv[i] = vs[s][dv0 + i]; }
            for (int i = 0; i < 8; ++i) for (int j = 0; j < 8; ++j) acc[i][j] += kk[i] * vv[j];
            if (tid < 128) nacc += w * ks[s][tid];
        }
    }
    float* O = p.out + (type == 0 ? O_RET : O_C) + (size_t)((b * 2 + dir) * 4 + h) * 128 * 128;
    for (int i = 0; i < 8; ++i) for (int j = 0; j < 8; ++j) O[(dk0 + i) * 128 + dv0 + j] = acc[i][j];
    if (type == 1) {
        if (tid < 128) p.out[O_N + (size_t)((b * 2 + dir) * 4 + h) * 128 + tid] = nacc;
        if (tid == 0) p.out[O_M + (b * 2 + dir) * 4 + h] = mfin;
    }
}

__global__ void k_final(P p) {
    __shared__ float red[4];
    const int m = blockIdx.x, tid = threadIdx.x;
    float* xr = p.out + O_Y + (size_t)m * D;
    float v[4], ss = 0.f;
    for (int i = 0; i < 4; ++i) { v[i] = xr[tid + 256 * i]; ss += v[i] * v[i]; }
    ss = block_sum256(ss, red);
    const float rstd = rsqrtf(ss * (1.f / D) + EPS);
    for (int i = 0; i < 4; ++i) xr[tid + 256 * i] = v[i] * rstd * p.fg[tid + 256 * i];
}


namespace pg8 {
#define PG8_LAS __attribute__((address_space(3)))
typedef short bf16x8 __attribute__((ext_vector_type(8)));
typedef float f32x4 __attribute__((ext_vector_type(4)));
typedef unsigned u32x4 __attribute__((ext_vector_type(4)));
constexpr int BM = 256, BK = 64, HALF = 128, HTB = HALF * BK * 2  , STAGE_BYTES = 8 * HTB, NXCD = 8, WGM = 8;

__host__ __device__ __forceinline__ int lds_byte(int r, int c) { const int st = (r >> 4) * 2 + (c >> 5), rr = r & 15, cc = c & 31, ob = rr * 64 + cc * 2; return st * 1024 + (ob ^ (((ob >> 9) & 1) << 5)); }
__host__ __device__ __forceinline__ void stage_rc(int b, int& R, int& C) { const int st = b / 1024, sb = b % 1024, swz = sb ^ (((sb >> 9) & 1) << 5); R = (st >> 1) * 16 + swz / 64; C = (st & 1) * 32 + (swz % 64) / 2; }
__host__ __device__ __forceinline__ int perm32(int rho) { const int n = rho >> 4, i = rho & 15; return 8 * (i >> 2) + 4 * n + (i & 3); }

struct Unit { int pm, pn; };
struct Gemm { const bf16_t* A; const bf16_t* Bt; int M, N, K; };

struct StaticOrder {
    int nM, nN, nwg, G, c;
    __host__ __device__ void init(int M, int N, int G_, int c_) { nM = M / BM; nN = N / BM; nwg = nM * nN; G = G_; c = c_; }
    __host__ __device__ bool next(int i, Unit& u) const {
        const long L = (long)i * G + c; if (L >= nwg) return false;
        int wgid = (int)L; { const int q = nwg / NXCD, r = nwg % NXCD, xcd = wgid % NXCD, off = wgid / NXCD; wgid = (xcd < r ? xcd * (q + 1) : r * (q + 1) + (xcd - r) * q) + off; }
        const int nig = WGM * nN, gid = wgid / nig, fm = gid * WGM, gsz = (nM - fm) < WGM ? (nM - fm) : WGM;
        u.pm = fm + ((wgid % nig) % gsz); u.pn = (wgid % nig) / gsz; return true;
    }
    __device__ __forceinline__ void a_ready(const Unit&) const {}
    __device__ __forceinline__ void done(const Unit&) const {}
};


__device__ __forceinline__ unsigned cvt_pk_bf16(float lo, float hi) { unsigned r; asm volatile("v_cvt_pk_bf16_f32 %0, %1, %2" : "=v"(r) : "v"(lo), "v"(hi)); return r; }
__device__ __forceinline__ u32x4 pack8(const f32x4& a, const f32x4& b) { u32x4 w; w.x = cvt_pk_bf16(a[0], a[1]); w.y = cvt_pk_bf16(a[2], a[3]); w.z = cvt_pk_bf16(b[0], b[1]); w.w = cvt_pk_bf16(b[2], b[3]); return w; }
__device__ __forceinline__ f32x4 silu4(const f32x4& v) { f32x4 o; for (int i = 0; i < 4; ++i) o[i] = v[i] / (1.f + __expf(-v[i])); return o; }
__device__ __forceinline__ f32x4 sigm4(const f32x4& v) { f32x4 o; for (int i = 0; i < 4; ++i) o[i] = 1.f / (1.f + __expf(-v[i])); return o; }

struct EpiProj {
    static constexpr bool PERM = true, PAIR = true, AFTER_DRAIN = false;
    unsigned char* ws; const float* rope;
    __device__ __forceinline__ void operator()(const f32x4 (&acc)[2][2][4][2], const Unit& u, int wr, int wc, int fr, int fq) const {
        const int sec = u.pn >> 1, hh = wc >> 1, dl = 32 * (wc & 1) + 8 * fq;
        bf16_t* dst; int ld, colb;
        if (sec == 4 || sec == 5) { dst = (bf16_t*)(ws + WS_MQKP); ld = 1024; colb = (u.pn - 8) * 256 + hh * 128; }
        else { const size_t off = sec == 0 ? WS_RQ : sec == 1 ? WS_RK : sec == 2 ? WS_RV : sec == 3 ? WS_RG : sec == 6 ? WS_MV : WS_MO;
               dst = (bf16_t*)(ws + off); ld = 512; colb = (u.pn & 1) * 256 + hh * 128; }
        const bool lat = u.pm >= NP / 256;
#pragma unroll
        for (int ai = 0; ai < 2; ++ai)
#pragma unroll
            for (int m = 0; m < 4; ++m) {
                const int row = u.pm * BM + ai * HALF + wr * 64 + m * 16 + fr;
                f32x4 a0 = acc[ai][0][m][0], a1 = acc[ai][0][m][1], b0 = acc[ai][1][m][0], b1 = acc[ai][1][m][1];
                if (sec <= 1) {
                    if (sec == 1) { a0 = a0 * 0.08838834764831845f; a1 = a1 * 0.08838834764831845f; b0 = b0 * 0.08838834764831845f; b1 = b1 * 0.08838834764831845f; }
                    if (lat) {
                        const int t = (row - NP) & (TS - 1), pos = (wc & 1) ? (t & 63) : (t >> 6);
                        const float* rp = rope + pos * 32 + 8 * fq;
                        const f32x4 c0 = *(const f32x4*)rp, c1 = *(const f32x4*)(rp + 4), s0 = *(const f32x4*)(rp + 2048), s1 = *(const f32x4*)(rp + 2052);
                        const f32x4 n0 = a0 * c0 - b0 * s0, n1 = a1 * c1 - b1 * s1, m0 = a0 * s0 + b0 * c0, m1 = a1 * s1 + b1 * c1;
                        a0 = n0; a1 = n1; b0 = m0; b1 = m1;
                    }
                } else if (sec == 3) { a0 = silu4(a0); a1 = silu4(a1); b0 = silu4(b0); b1 = silu4(b1); }
                else if (sec == 7) { a0 = sigm4(a0); a1 = sigm4(a1); b0 = sigm4(b0); b1 = sigm4(b1); }
                bf16_t* rp = dst + (size_t)row * ld + colb + dl;
                *(u32x4*)rp = pack8(a0, a1);
                *(u32x4*)(rp + 64) = pack8(b0, b1);
            }
    }
};
struct EpiRelu2 {
    static constexpr bool PERM = true, PAIR = false, AFTER_DRAIN = false;
    bf16_t* U;
    __device__ __forceinline__ void operator()(const f32x4 (&acc)[2][2][4][2], const Unit& u, int wr, int wc, int fr, int fq) const {
        const int row0 = u.pm * BM + wr * 64 + fr, col0 = u.pn * BM + wc * 32 + 8 * fq;
#pragma unroll
        for (int ai = 0; ai < 2; ++ai)
#pragma unroll
            for (int m = 0; m < 4; ++m) { bf16_t* rowp = U + (size_t)(row0 + ai * HALF + m * 16) * FF + col0;
#pragma unroll
                for (int bj = 0; bj < 2; ++bj) { f32x4 v0 = acc[ai][bj][m][0], v1 = acc[ai][bj][m][1];
                    for (int i = 0; i < 4; ++i) { const float x = fmaxf(v0[i], 0.f), y = fmaxf(v1[i], 0.f); v0[i] = x * x; v1[i] = y * y; }
                    *(u32x4*)(rowp + bj * HALF) = pack8(v0, v1); } }
    }
};
struct EpiRes {
    static constexpr bool PERM = false, PAIR = false, AFTER_DRAIN = false;
    const float* base_p; const float* base_s; float* out; const float* gate;
    __device__ __forceinline__ void operator()(const f32x4 (&acc)[2][2][4][2], const Unit& u, int wr, int wc, int fr, int fq) const {
        const int row0 = u.pm * BM + wr * 64 + fr, col0 = u.pn * BM + wc * 32 + 4 * fq;
        const int cnd = u.pm < NP / 256 ? 0 : 1 + (u.pm - NP / 256) / (TS / 256);
        const float* base = u.pm < NP / 256 ? base_p : base_s - (size_t)NP * D;
        f32x4 gv[2][2];
#pragma unroll
        for (int bj = 0; bj < 2; ++bj)
#pragma unroll
            for (int n = 0; n < 2; ++n) gv[bj][n] = *(const f32x4*)(gate + cnd * 6144 + col0 + bj * HALF + n * 16);
#pragma unroll
        for (int ai = 0; ai < 2; ++ai)
#pragma unroll
            for (int m = 0; m < 4; ++m) { const size_t off = (size_t)(row0 + ai * HALF + m * 16) * D + col0;
#pragma unroll
                for (int bj = 0; bj < 2; ++bj)
#pragma unroll
                    for (int n = 0; n < 2; ++n) { const f32x4 b = *(const f32x4*)(base + off + bj * HALF + n * 16);
                        *(f32x4*)(out + off + bj * HALF + n * 16) = b + gv[bj][n] * acc[ai][bj][m][n]; } }
    }
};
template <class Epi, class Sched, bool ALIGN_EPI = false, bool SP2 = false>
__device__ __forceinline__ void gemm_phase(PG8_LAS unsigned char* lds, const Gemm g, const Sched& S, const Epi& E) {
    const int tid = threadIdx.x, wid = __builtin_amdgcn_readfirstlane(tid >> 6), lane = tid & 63, wr = wid >> 2, wc = wid & 3, fr = lane & 15, fq = lane >> 4;
    const int K = g.K, nt = K / BK;
    unsigned voffA[2], voffB[2];
#pragma unroll
    for (int i = 0; i < 2; ++i) { int R, C; stage_rc(tid * 16 + i * 8192, R, C); int Rb = Epi::PERM ? ((R & ~31) + perm32(R & 31)) : R;
        if (Epi::PAIR) Rb = (Rb >> 6) * 128 + (Rb & 63);
        voffA[i] = (unsigned)(R * K + C) * 2u; voffB[i] = (unsigned)(Rb * K + C) * 2u; }
    const size_t kstep = (size_t)(BK * 2);
    const size_t hstep = (size_t)HALF * K * 2;
    const size_t hstepB = Epi::PAIR ? hstep / 2 : hstep;
    const size_t tstep = 2 * hstep;
    const unsigned ldsw = (unsigned)wid * 1024u;
    const int aoff = lds_byte(wr * 64 + fr, fq * 8), boff = lds_byte(wc * 32 + fr, fq * 8);
#define PG8_SA(b, h) (((b) * 2 + (h)) * HTB)
#define PG8_SB(b, h) ((4 + (b) * 2 + (h)) * HTB)
#define PG8_STAGE(bufoff, gbase, voff) do { _Pragma("unroll") for (int _i = 0; _i < 2; ++_i) \
        __builtin_amdgcn_global_load_lds((const unsigned*)((const char*)(gbase) + (voff)[_i]), (PG8_LAS unsigned*)(lds + (bufoff) + ldsw + _i * 8192), 16, 0, 0); } while (0)
#define PG8_LDA(dst, b, h) do { _Pragma("unroll") for (int m = 0; m < 4; ++m) _Pragma("unroll") for (int k = 0; k < 2; ++k) dst[m][k] = *(const PG8_LAS bf16x8*)(lds + PG8_SA(b, h) + aoff + m * 2048 + k * 1024); } while (0)
#define PG8_LDB(dst, b, h) do { _Pragma("unroll") for (int n = 0; n < 2; ++n) _Pragma("unroll") for (int k = 0; k < 2; ++k) dst[n][k] = *(const PG8_LAS bf16x8*)(lds + PG8_SB(b, h) + boff + n * 2048 + k * 1024); } while (0)
#define PG8_MMA(ai, bj, At, Bt) do { __builtin_amdgcn_s_setprio(1); _Pragma("unroll") for (int m = 0; m < 4; ++m) _Pragma("unroll") for (int n = 0; n < 2; ++n) _Pragma("unroll") for (int k = 0; k < 2; ++k) \
        acc[ai][bj][m][n] = __builtin_amdgcn_mfma_f32_16x16x32_bf16(Bt[n][k], At[m][k], acc[ai][bj][m][n], 0, 0, 0); __builtin_amdgcn_s_setprio(0); } while (0)
#define PG8_WAIT_V(n) asm volatile("s_waitcnt vmcnt(" #n ")" ::: "memory")
#define PG8_WAIT_L(n) asm volatile("s_waitcnt lgkmcnt(" #n ")" ::: "memory")
#define PG8_BAR __builtin_amdgcn_s_barrier()
#define PG8_SCHED __builtin_amdgcn_sched_barrier(0)
    Unit cur, nxt; int ui = 0;
    if (!S.next(0, cur)) return;
    f32x4 acc[2][2][4][2];
#pragma unroll
    for (int a = 0; a < 2; ++a)
#pragma unroll
        for (int b = 0; b < 2; ++b)
#pragma unroll
            for (int m = 0; m < 4; ++m)
#pragma unroll
                for (int n = 0; n < 2; ++n) acc[a][b][m][n] = (f32x4){0.f, 0.f, 0.f, 0.f};
    bf16x8 At[4][2], B0[2][2], B1[2][2];
    const char* cA = (const char*)g.A + (size_t)cur.pm * tstep; const char* cB = (const char*)g.Bt + (size_t)cur.pn * tstep;
    S.a_ready(cur);
    if constexpr (SP2) {
        PG8_STAGE(PG8_SB(0, 0), cB, voffB); PG8_STAGE(PG8_SB(0, 1), cB + hstepB, voffB); PG8_STAGE(PG8_SA(0, 0), cA, voffA); PG8_STAGE(PG8_SA(0, 1), cA + hstep, voffA);
        if (wr == 1) PG8_BAR;
        PG8_WAIT_V(2); PG8_BAR;
        PG8_STAGE(PG8_SB(1, 0), cB + kstep, voffB); PG8_STAGE(PG8_SA(1, 0), cA + kstep, voffA); PG8_STAGE(PG8_SB(1, 1), cB + hstepB + kstep, voffB);
        PG8_WAIT_V(6); PG8_BAR;
    } else {
        PG8_STAGE(PG8_SB(0, 0), cB, voffB); PG8_STAGE(PG8_SA(0, 0), cA, voffA); PG8_STAGE(PG8_SB(0, 1), cB + hstepB, voffB); PG8_STAGE(PG8_SA(0, 1), cA + hstep, voffA);
        if (wr == 1) PG8_BAR;
        PG8_WAIT_V(4); PG8_BAR;
        PG8_STAGE(PG8_SB(1, 0), cB + kstep, voffB); PG8_STAGE(PG8_SA(1, 0), cA + kstep, voffA); PG8_STAGE(PG8_SB(1, 1), cB + hstepB + kstep, voffB);
        PG8_WAIT_V(6); PG8_BAR;
    }
    for (;;) {
        const bool has_next = S.next(ui + 1, nxt);
        const char* nA = has_next ? (const char*)g.A + (size_t)nxt.pm * tstep : cA; const char* nB = has_next ? (const char*)g.Bt + (size_t)nxt.pn * tstep : cB;
        for (int t = 0; t < nt; t += 2) {
            const bool last = (t == nt - 2);
            const char* a1 = cA + (size_t)(t + 1) * kstep;
            const char* a2 = last ? nA : cA + (size_t)(t + 2) * kstep; const char* b2 = last ? nB : cB + (size_t)(t + 2) * kstep;
            const char* a3 = a2 + kstep; const char* b3 = b2 + kstep;
            if (last && has_next) S.a_ready(nxt);
            if constexpr (SP2) {
            PG8_LDB(B0, 0, 0); PG8_LDB(B1, 0, 1); PG8_SCHED; PG8_LDA(At, 0, 0); PG8_STAGE(PG8_SA(1, 1), a1 + hstep, voffA);
            PG8_WAIT_V(8); PG8_WAIT_L(0); PG8_BAR; PG8_MMA(0, 0, At, B0); PG8_MMA(0, 1, At, B1); PG8_BAR; PG8_SCHED;
            PG8_LDA(At, 0, 1); PG8_STAGE(PG8_SB(0, 0), b2, voffB); PG8_STAGE(PG8_SB(0, 1), b2 + hstepB, voffB); PG8_STAGE(PG8_SA(0, 0), a2, voffA);
            PG8_WAIT_V(8); PG8_WAIT_L(0); PG8_BAR; PG8_MMA(1, 0, At, B0); PG8_MMA(1, 1, At, B1); PG8_BAR; PG8_SCHED;
            PG8_LDB(B0, 1, 0); PG8_LDB(B1, 1, 1); PG8_SCHED; PG8_LDA(At, 1, 0); PG8_STAGE(PG8_SA(0, 1), a2 + hstep, voffA);
            PG8_WAIT_V(8); PG8_WAIT_L(0); PG8_BAR; PG8_MMA(0, 0, At, B0); PG8_MMA(0, 1, At, B1); PG8_BAR; PG8_SCHED;
            PG8_LDA(At, 1, 1); PG8_STAGE(PG8_SB(1, 0), b3, voffB); PG8_STAGE(PG8_SB(1, 1), b3 + hstepB, voffB); PG8_STAGE(PG8_SA(1, 0), a3, voffA);
            PG8_WAIT_V(8); PG8_WAIT_L(0); PG8_BAR; PG8_MMA(1, 0, At, B0); PG8_MMA(1, 1, At, B1); PG8_BAR; PG8_SCHED;
            } else {
            PG8_LDB(B0, 0, 0); PG8_SCHED; PG8_LDA(At, 0, 0); PG8_STAGE(PG8_SA(1, 1), a1 + hstep, voffA);
            PG8_WAIT_L(8); PG8_BAR; PG8_WAIT_L(0); PG8_MMA(0, 0, At, B0); PG8_BAR; PG8_SCHED;
            PG8_LDB(B1, 0, 1); PG8_STAGE(PG8_SB(0, 0), b2, voffB);
            PG8_BAR; PG8_WAIT_L(0); PG8_MMA(0, 1, At, B1); PG8_BAR;
            PG8_LDA(At, 0, 1); PG8_STAGE(PG8_SA(0, 0), a2, voffA);
            PG8_BAR; PG8_WAIT_L(0); PG8_MMA(1, 0, At, B0); PG8_BAR; PG8_SCHED;
            PG8_STAGE(PG8_SB(0, 1), b2 + hstepB, voffB);
            PG8_WAIT_V(6); PG8_BAR; PG8_MMA(1, 1, At, B1); PG8_BAR;
            PG8_LDB(B0, 1, 0); PG8_SCHED; PG8_LDA(At, 1, 0); PG8_STAGE(PG8_SA(0, 1), a2 + hstep, voffA);
            PG8_WAIT_L(8); PG8_BAR; PG8_WAIT_L(0); PG8_MMA(0, 0, At, B0); PG8_BAR; PG8_SCHED;
            PG8_LDB(B1, 1, 1); PG8_STAGE(PG8_SB(1, 0), b3, voffB);
            PG8_BAR; PG8_WAIT_L(0); PG8_MMA(0, 1, At, B1); PG8_BAR;
            PG8_LDA(At, 1, 1); PG8_STAGE(PG8_SA(1, 0), a3, voffA);
            PG8_BAR; PG8_WAIT_L(0); PG8_MMA(1, 0, At, B0); PG8_BAR; PG8_SCHED;
            PG8_STAGE(PG8_SB(1, 1), b3 + hstepB, voffB);
            PG8_WAIT_V(6); PG8_BAR; PG8_MMA(1, 1, At, B1); PG8_BAR;
            }
        }
        if constexpr (ALIGN_EPI) { if (wr == 0) PG8_BAR; }
        if constexpr (!Epi::AFTER_DRAIN) { E(acc, cur, wr, wc, fr, fq); S.done(cur); }
        if (!has_next) break;
#pragma unroll
        for (int a = 0; a < 2; ++a)
#pragma unroll
            for (int b = 0; b < 2; ++b)
#pragma unroll
                for (int m = 0; m < 4; ++m)
#pragma unroll
                    for (int n = 0; n < 2; ++n) acc[a][b][m][n] = (f32x4){0.f, 0.f, 0.f, 0.f};
        cur = nxt; cA = nA; cB = nB; ++ui;
        if constexpr (ALIGN_EPI) { if (wr == 1) PG8_BAR; }
    }
    PG8_WAIT_V(0);
    if constexpr (!ALIGN_EPI) { if (wr == 0) PG8_BAR; }
    PG8_BAR;
    if constexpr (Epi::AFTER_DRAIN) { E.fused(acc, cur, wr, wc, fr, fq, lds, wid, lane); S.done(cur); }
#undef PG8_SA
#undef PG8_SB
#undef PG8_STAGE
#undef PG8_LDA
#undef PG8_LDB
#undef PG8_MMA
#undef PG8_WAIT_V
#undef PG8_WAIT_L
#undef PG8_BAR
#undef PG8_SCHED
}
}


constexpr int NWAVES = 8;
constexpr int RING_OFF = 0, RING_BYTES = 131072;
constexpr int LDS_BYTES = 163840;
constexpr int LDSCTL_OFF = LDS_BYTES - 2048, MISC_OFF = LDSCTL_OFF + 320;
#define GAS __attribute__((address_space(1)))
#define LAS __attribute__((address_space(3)))
typedef unsigned v4u __attribute__((ext_vector_type(4)));
typedef float f32x4 __attribute__((ext_vector_type(4)));
typedef GAS unsigned gu32;
#define LDS_WAIT() asm volatile("s_waitcnt lgkmcnt(0)" ::: "memory")
#define VM_WAIT() asm volatile("s_waitcnt vmcnt(0)" ::: "memory")
constexpr int CW_BAR = 4096;
constexpr size_t CTL_ZERO_BYTES = 256 * 1024;

#define XB_TMO      128
#define XB_XCNT(j)  (256  + 64 * (j))
#define XB_XSUB(j)  (1280 + 64 * (j))
#define XB_XGEN(j)  (2304 + 64 * (j))
#define XB_TOP      3328
#define XB_TOPGEN   3392
#define XCD_BAR_WORDS 3456
#define XB_SPIN_CAP (1u << 18)
__device__ __forceinline__ unsigned xb_ld(unsigned* p)              { return __hip_atomic_load(p, __ATOMIC_RELAXED, __HIP_MEMORY_SCOPE_AGENT); }
__device__ __forceinline__ unsigned xb_add(unsigned* p, unsigned v) { return __hip_atomic_fetch_add(p, v, __ATOMIC_RELAXED, __HIP_MEMORY_SCOPE_AGENT); }
__device__ __forceinline__ unsigned xb_xcc_id() { return (unsigned)__builtin_amdgcn_s_getreg((3 << 11) | 20) & 0xFu; }
#define XB_SPIN(cond, bar) do { unsigned _sp = 0; while (cond) { __builtin_amdgcn_s_sleep(1); \
    if ((++_sp & 255u) == 0u) { if (xb_ld(&(bar)[XB_TMO])) break; if (_sp > XB_SPIN_CAP) { atomicAdd(&(bar)[XB_TMO], 1u); break; } } } } while (0)
struct XcdBarrier { unsigned* bar; unsigned x; volatile LAS unsigned* st; };
__device__ __forceinline__ XcdBarrier xcd_barrier_post(unsigned* bar, volatile LAS unsigned* st) {
    XcdBarrier b; b.bar = bar; b.x = xb_xcc_id(); b.st = st;
    if (threadIdx.x == 0) (void)xb_add(&bar[XB_XCNT(b.x)], 1u);
    return b;
}
__device__ __forceinline__ void xcd_barrier_complete(unsigned* bar, unsigned x, unsigned& nloc, unsigned& nx) {
    const unsigned G = gridDim.x * gridDim.y * gridDim.z;
    unsigned sum, cnt, mine, sp = 0u;
    for (;;) {
        sum = 0u; cnt = 0u; mine = 0u;
#pragma unroll
        for (unsigned j = 0; j < 16; ++j) { const unsigned c = xb_ld(&bar[XB_XCNT(j)]); sum += c; cnt += (c > 0u) ? 1u : 0u; mine = (j == x) ? c : mine; }
        if (sum == G) break;
        __builtin_amdgcn_s_sleep(1);
        if ((++sp & 255u) == 0u) { if (xb_ld(&bar[XB_TMO])) break; if (sp > XB_SPIN_CAP) { atomicAdd(&bar[XB_TMO], 1u); break; } }
    }
    nloc = mine > 0u ? mine : 1u; nx = cnt > 0u ? cnt : 1u;
}
__device__ __forceinline__ void xcd_barrier(const XcdBarrier& b) {
    asm volatile("s_waitcnt vmcnt(0)" ::: "memory");
    __syncthreads();
    if (threadIdx.x == 0) {
        unsigned* bar = b.bar;
        __builtin_amdgcn_s_waitcnt(0);
        unsigned nloc = b.st[0], nx = b.st[1];
        if (nloc == 0u) { xcd_barrier_complete(bar, b.x, nloc, nx); b.st[0] = nloc; b.st[1] = nx; }
        const unsigned old = xb_add(&bar[XB_XSUB(b.x)], 1u);
        const unsigned gen = old / nloc;
        if (old + 1u == (gen + 1u) * nloc) {
            __builtin_amdgcn_fence(__ATOMIC_RELEASE, "agent");
            asm volatile("s_waitcnt vmcnt(0)" ::: "memory");
            const unsigned og = xb_add(&bar[XB_TOP], 1u);
            const unsigned tg = og / nx;
            if (og + 1u == (tg + 1u) * nx) xb_add(&bar[XB_TOPGEN], 1u);
            else XB_SPIN(xb_ld(&bar[XB_TOPGEN]) == tg, bar);
            __builtin_amdgcn_fence(__ATOMIC_ACQUIRE, "agent");
            xb_add(&bar[XB_XGEN(b.x)], 1u);
            asm volatile("s_waitcnt vmcnt(0)" ::: "memory");
        } else {
            XB_SPIN(xb_ld(&bar[XB_XGEN(b.x)]) == gen, bar);
            __builtin_amdgcn_fence(__ATOMIC_ACQUIRE, "agent");
            asm volatile("s_waitcnt vmcnt(0)" ::: "memory");
        }
    }
    __syncthreads();
}

struct Frame {
    LAS unsigned char* lds; volatile LAS unsigned* MISC; gu32* ctl;
    int tid, lane, wave, vcu, G;
};
__device__ __forceinline__ float wave_sum(float v) {
#pragma unroll
    for (int o = 1; o < 64; o <<= 1) v += __shfl_xor(v, o);
    return v;
}
__device__ __forceinline__ unsigned pk2(float lo, float hi) { return (unsigned)f2bf(lo) | ((unsigned)f2bf(hi) << 16); }
__device__ __forceinline__ void p0_transpose_item(const float* W, int K, int N, int ldw, bf16_t* WT, LAS float* scr, int item, int lane) {
    const int nblk = N / 32, kb = item / nblk, nb = item % nblk, k0 = 64 * kb, n0 = 32 * nb;
#pragma unroll 8
    for (int i = 0; i < 32; ++i) { const int kk = 2 * i + (lane >> 5); scr[kk * 33 + (lane & 31)] = W[(size_t)(k0 + kk) * ldw + n0 + (lane & 31)]; }
    LDS_WAIT(); asm volatile("" ::: "memory");
    const int c = lane & 7;
#pragma unroll
    for (int j = 0; j < 4; ++j) { const int n = (lane >> 3) + 8 * j; const LAS float* s = scr + (8 * c) * 33 + n;
        v4u o; o.x = pk2(s[0 * 33], s[1 * 33]); o.y = pk2(s[2 * 33], s[3 * 33]); o.z = pk2(s[4 * 33], s[5 * 33]); o.w = pk2(s[6 * 33], s[7 * 33]);
        *(GAS v4u*)(WT + (size_t)(n0 + n) * K + k0 + 8 * c) = o; }
    LDS_WAIT(); asm volatile("" ::: "memory");
}

struct Args { const float* in[22]; float* out; unsigned char* ws; int ph_lo, ph_hi, li, pad; };

__device__ __forceinline__ void p0_prologue(Frame& F, const Args& a) {
    unsigned char* ws = a.ws;
    if (F.wave == 0 && F.vcu < 96) {
        const int j = F.vcu * 64 + F.lane;
        const float* wa = a.in[8] + j; const float* cc = a.in[6]; const float* cx = a.in[7];
        float a0 = 0.f, a1 = 0.f, a2 = 0.f;
#pragma unroll 8
        for (int k = 0; k < D; ++k) { const float w = wa[(size_t)k * 6144]; a0 += siluf(cx[k]) * w; a1 += siluf(cc[k]) * w; a2 += siluf(cc[D + k]) * w; }
        float* mod = (float*)(ws + WS_MOD); const float bb = a.in[9][j];
        mod[j] = a0 + bb; mod[6144 + j] = a1 + bb; mod[12288 + j] = a2 + bb;
    }
    if (F.vcu == 100) {
        for (int e = F.tid; e < 2048; e += NWAVES * 64) { const int pos = e >> 5, f = e & 31;
            const float inv = exp2f(-(float)f * (13.287712379549449f / 32.f)); const float ang = (float)pos * inv;
            float sn, cs; sincosf(ang, &sn, &cs);
            float* rc = (float*)(ws + WS_ROPE); rc[e] = cs; rc[2048 + e] = sn; }
    }
    LAS float* scr = (LAS float*)(F.lds + RING_OFF + F.wave * 16384);
    const int gw = F.vcu * NWAVES + F.wave, NGW = F.G * NWAVES;
    constexpr int I_IN = (D / 64) * (4096 / 32), I_O = (D / 64) * (D / 32), I_1 = (D / 64) * (FF / 32), I_2 = (FF / 64) * (D / 32);
    constexpr int NITEMS = I_IN + I_O + I_1 + I_2;
    for (int it = NITEMS - 1 - gw; it >= 0; it -= NGW) {
        int r = it;
        if (r < I_IN) { p0_transpose_item(a.in[12], D, 4096, INC, (bf16_t*)(ws + WS_WIN), scr, r, F.lane); continue; } r -= I_IN;
        if (r < I_O) { p0_transpose_item(a.in[18], D, D, D, (bf16_t*)(ws + WS_WOUT), scr, r, F.lane); continue; } r -= I_O;
        if (r < I_1) { p0_transpose_item(a.in[19], D, FF, FF, (bf16_t*)(ws + WS_W1), scr, r, F.lane); continue; } r -= I_1;
        p0_transpose_item(a.in[20], FF, D, D, (bf16_t*)(ws + WS_W2), scr, r, F.lane);
    }
}

__device__ __forceinline__ void p1_norm_gates(Frame& F, const Args& a) {
    LAS float* wg = (LAS float*)(F.lds + RING_OFF);
    for (int e = F.tid; e < 1024 * 16; e += NWAVES * 64) { const int k = e >> 4, j = e & 15; wg[k * 20 + j] = a.in[12][(size_t)k * INC + 4096 + j]; }
    __syncthreads();
    const int gw = F.vcu * NWAVES + F.wave, NGW = F.G * NWAVES, lane = F.lane;
    const float* mod = (const float*)(a.ws + WS_MOD);
    float A1[16], S1[16]; int cur = -1;
    for (int m = gw; m < M; m += NGW) {
        const int cnd = cond_of(m);
        if (cnd != cur) { cur = cnd;
#pragma unroll
            for (int i = 0; i < 16; ++i) { const int k = lane + 64 * i; A1[i] = a.in[10][k] * (1.f + mod[cnd * 6144 + 1024 + k]); S1[i] = mod[cnd * 6144 + k]; } }
        const float* xr = m < NP ? a.in[0] + (size_t)m * D : a.in[1] + (size_t)(m - NP) * D;
        float v[16]; float ss = 0.f;
#pragma unroll
        for (int i = 0; i < 16; ++i) { v[i] = xr[lane + 64 * i]; ss += v[i] * v[i]; }
        ss = wave_sum(ss);
        const float rstd = rsqrtf(ss * (1.f / D) + EPS);
        bf16_t* H = (bf16_t*)(a.ws + WS_H) + (size_t)m * D;
        float ga[16];
#pragma unroll
        for (int j = 0; j < 16; ++j) ga[j] = 0.f;
#pragma unroll
        for (int i = 0; i < 16; ++i) {
            const float h = v[i] * rstd * A1[i] + S1[i];
            H[lane + 64 * i] = f2bf(h);
            const LAS f32x4* wr = (const LAS f32x4*)(wg + (lane + 64 * i) * 20);
            const f32x4 w0 = wr[0], w1 = wr[1], w2 = wr[2], w3 = wr[3];
#pragma unroll
            for (int j = 0; j < 4; ++j) { ga[j] += h * w0[j]; ga[4 + j] += h * w1[j]; ga[8 + j] += h * w2[j]; ga[12 + j] += h * w3[j]; }
            if (i & 1) asm volatile("" ::: "memory");
        }
        { const bool hi = lane & 32;
#pragma unroll
          for (int j = 0; j < 8; ++j) { const float keep = hi ? ga[j + 8] : ga[j], give = hi ? ga[j] : ga[j + 8]; ga[j] = keep + __shfl_xor(give, 32); } }
        { const bool hi = lane & 16;
#pragma unroll
          for (int j = 0; j < 4; ++j) { const float keep = hi ? ga[j + 4] : ga[j], give = hi ? ga[j] : ga[j + 4]; ga[j] = keep + __shfl_xor(give, 16); } }
        { const bool hi = lane & 8;
#pragma unroll
          for (int j = 0; j < 2; ++j) { const float keep = hi ? ga[j + 2] : ga[j], give = hi ? ga[j] : ga[j + 2]; ga[j] = keep + __shfl_xor(give, 8); } }
        { const bool hi = lane & 4; const float keep = hi ? ga[1] : ga[0], give = hi ? ga[0] : ga[1]; ga[0] = keep + __shfl_xor(give, 4); }
        ga[0] += __shfl_xor(ga[0], 2); ga[0] += __shfl_xor(ga[0], 1);
        if ((lane & 3) == 0) ((float*)(a.ws + WS_GATES))[(size_t)m * 16 + (lane >> 2)] = ga[0] + a.in[15][lane >> 2];
    }
}


__device__ __forceinline__ void p3_conv_cumsum(Frame& F, const Args& a) {
    unsigned char* ws = a.ws;
    const int gw = F.vcu * NWAVES + F.wave, NGW = F.G * NWAVES, lane = F.lane;
    if (gw < 34 * 8) {
        const int seq = gw >> 3, dir = (gw >> 2) & 1, h = gw & 3;
        const int T = seq < 32 ? TP : TS, mbase = seq < 32 ? seq * TP : NP + (seq - 32) * TS, per = T / 64;
        const float* G = (const float*)(ws + WS_GATES);
        float* LI = (float*)(ws + WS_GLI) + (size_t)(dir * 4 + h) * M;
        float* CU = (float*)(ws + WS_GCUM) + (size_t)(dir * 4 + h) * M;
        float tot = 0.f;
        for (int i = 0; i < per; ++i) { const int p = lane * per + i, m = mbase + (dir == 0 ? p : T - 1 - p); tot += logsigf(G[(size_t)m * 16 + dir * 8 + 4 + h]); }
        float incl = tot;
#pragma unroll
        for (int o = 1; o < 64; o <<= 1) { const float v = __shfl_up(incl, o); if (lane >= o) incl += v; }
        float cum = incl - tot;
        for (int i = 0; i < per; ++i) { const int p = lane * per + i, m = mbase + (dir == 0 ? p : T - 1 - p);
            cum += logsigf(G[(size_t)m * 16 + dir * 8 + 4 + h]); CU[m] = cum; LI[m] = G[(size_t)m * 16 + dir * 8 + h]; }
    }
    const bf16_t* X = (const bf16_t*)(ws + WS_MQKP);
    float cw[2][3][8];
#pragma unroll
    for (int i = 0; i < 2; ++i)
#pragma unroll
        for (int j = 0; j < 3; ++j)
#pragma unroll
            for (int e = 0; e < 8; ++e) cw[i][j][e] = a.in[13][j * 1024 + (lane + 64 * i) * 8 + e];
    for (int m = gw; m < M; m += NGW) {
        const int T = m < NP ? TP : TS, t = m < NP ? (m & (TP - 1)) : ((m - NP) & (TS - 1));
#pragma unroll
        for (int i = 0; i < 2; ++i) {
            const size_t off = (size_t)m * 1024 + (lane + 64 * i) * 8;
            const v4u x1 = *(const v4u*)(X + off);
            v4u x0 = {0u, 0u, 0u, 0u}, x2 = {0u, 0u, 0u, 0u};
            if (t > 0) x0 = *(const v4u*)(X + off - 1024);
            if (t < T - 1) x2 = *(const v4u*)(X + off + 1024);
            float o[8];
#pragma unroll
            for (int e = 0; e < 8; ++e) {
                const unsigned w0 = x0[e >> 1], w1 = x1[e >> 1], w2 = x2[e >> 1];
                const float f0 = __uint_as_float((e & 1) ? (w0 & 0xffff0000u) : (w0 << 16)), f1 = __uint_as_float((e & 1) ? (w1 & 0xffff0000u) : (w1 << 16)), f2 = __uint_as_float((e & 1) ? (w2 & 0xffff0000u) : (w2 << 16));
                float v = cw[i][0][e] * f0 + cw[i][1][e] * f1 + cw[i][2][e] * f2;
                v = siluf(v);
                o[e] = i == 0 ? v : v * 0.08838834764831845f;
            }
            v4u w; w.x = pk2(o[0], o[1]); w.y = pk2(o[2], o[3]); w.z = pk2(o[4], o[5]); w.w = pk2(o[6], o[7]);
            *(v4u*)((bf16_t*)(ws + (i == 0 ? WS_MQ : WS_MK)) + (size_t)m * W5 + lane * 8) = w;
        }
    }
}

typedef short bf16x8 __attribute__((ext_vector_type(8)));
typedef short s16x4 __attribute__((ext_vector_type(4)));
typedef short v4i16_t __attribute__((ext_vector_type(4)));
typedef float f32x16 __attribute__((ext_vector_type(16)));
typedef float f32x2_t __attribute__((ext_vector_type(2)));
typedef __bf16 bf16x2_t __attribute__((ext_vector_type(2)));
#define MFMA32(a_, b_, c_) __builtin_amdgcn_mfma_f32_32x32x16_bf16((a_), (b_), (c_), 0, 0, 0)
constexpr int RS = 272, TRS = 320;
constexpr int MX_QS = 0, MX_KS = 34816, MX_VS = 75776, MX_PX = 116736, MX_SM = 149504;
constexpr int MX_CF = MX_SM, MX_CB = MX_SM + 512, MX_DEN = MX_SM + 1024, MX_ST = MX_SM + 3072, MX_W = MX_SM + 5120, MX_RED = MX_SM + 7168;
static_assert(MX_RED + 64 <= LDSCTL_OFF && MX_KS + 128 * TRS <= MX_VS && MX_VS + 128 * TRS <= MX_PX && MX_PX + 32768 <= MX_SM, "mixer LDS map");
__device__ __forceinline__ unsigned cvtpk(float lo, float hi) { f32x2_t v = {lo, hi}; bf16x2_t b = __builtin_convertvector(v, bf16x2_t); return __builtin_bit_cast(unsigned, b); }
__device__ __forceinline__ s16x4 vtr(const LAS unsigned char* p) { return __builtin_bit_cast(s16x4, __builtin_amdgcn_ds_read_tr16_b64_v4i16((LAS v4i16_t*)p)); }
#define ROW_FRAG(base_r, row0, ks) (*(const LAS bf16x8*)((base_r) + (row0) * RS + (ks) * 32))
__device__ __forceinline__ bf16x8 tr_frag2(const LAS unsigned char* base_t, int off0, int off1) {
    const s16x4 lo = vtr(base_t + off0), hi = vtr(base_t + off1);
    return __builtin_shufflevector(lo, hi, 0, 1, 2, 3, 4, 5, 6, 7);
}
#define TR_FRAG(base_t, r0, r1, c) tr_frag2((base_t), (r0) * TRS + (c) * 64, (r1) * TRS + (c) * 64)
__device__ __forceinline__ void stage_tile(LAS unsigned char* dst, int rs, const bf16_t* src, int ld, int tid) {
#pragma unroll
    for (int i = 0; i < 4; ++i) { const int n = tid + 512 * i, row = n >> 4, ch = n & 15;
        const v4u v = *(const v4u*)(src + (size_t)row * ld + ch * 8);
        *(LAS v4u*)(dst + row * rs + ch * 16) = v; }
}
__device__ __forceinline__ void stage_tile_f32(LAS unsigned char* dst, const float* src, int tid) {
#pragma unroll
    for (int i = 0; i < 4; ++i) { const int n = tid + 512 * i, row = n >> 4, ch = n & 15;
        const f32x4 x = *(const f32x4*)(src + row * 128 + ch * 8), y = *(const f32x4*)(src + row * 128 + ch * 8 + 4);
        v4u v; v.x = cvtpk(x[0], x[1]); v.y = cvtpk(x[2], x[3]); v.z = cvtpk(y[0], y[1]); v.w = cvtpk(y[2], y[3]);
        *(LAS v4u*)(dst + row * TRS + ch * 16) = v; }
}

struct MixSrc { const bf16_t *Q, *K, *V, *GT; const float *cumF, *liF, *cumB, *liB, *gain; float lgf, lgb; };

__device__ __forceinline__ void mix_pv(f32x16 (&O)[2], const LAS unsigned char* vbase, const LAS unsigned char* pxbase) {
#pragma unroll
    for (int khp = 0; khp < 2; ++khp)
#pragma unroll
        for (int f = 0; f < 4; ++f) {
            const bf16x8 pb = *(const LAS bf16x8*)(pxbase + (khp * 4 + f) * 1024);
            const int kb0 = 64 * khp + 32 * (f >> 1) + 16 * (f & 1);
#pragma unroll
            for (int eb = 0; eb < 2; ++eb) O[eb] = MFMA32(TR_FRAG(vbase, kb0, kb0 + 8, eb), pb, O[eb]);
            if (f & 1) asm volatile("" ::: "memory");
        }
}

__device__ __forceinline__ void mix_attn_item(Frame& F, const Args& a, const MixSrc& X, int type, int seq, int h, int qt) {
    LAS unsigned char* lds = F.lds;
    int tid = F.tid; asm volatile("" : "+v"(tid));
    const int lane = tid & 63, wave = F.wave, rg = wave >> 1, kh = wave & 1, c31 = lane & 31, hh = lane >> 5;
    const int T = seq < 32 ? TP : TS, sb = seq < 32 ? seq * TP : NP + (seq - 32) * TS, nk = T / 128;
    const int t_rel = 32 * rg + c31, t_seq = 128 * qt + t_rel, m_t = sb + t_seq;
    LAS float* CF = (LAS float*)(lds + MX_CF); LAS float* CB = (LAS float*)(lds + MX_CB);
    const LAS unsigned char* qbase = lds + MX_QS + (32 * rg + c31) * RS + hh * 16;
    const LAS unsigned char* kbase = lds + MX_KS + (64 * kh + c31) * RS + hh * 16;
    const int trl = ((lane & 15) >> 2) * TRS + ((lane >> 4) & 1) * 32 + (lane & 3) * 8;
    const LAS unsigned char* vbase = lds + MX_VS + trl + hh * 4 * TRS + kh * 128;
    const LAS unsigned char* vnat = lds + MX_VS + trl + hh * 8 * TRS + kh * 128;
    LAS unsigned char* pxw = lds + MX_PX + wave * 4096 + lane * 16;
    const LAS unsigned char* pxr = lds + MX_PX + (wave & ~1) * 4096 + lane * 16;
    float cumF_t, cumB_t, refF, refB;
    if (type == 1) { cumF_t = X.cumF[m_t]; cumB_t = X.cumB[m_t]; refF = qt == 0 ? 0.f : X.cumF[sb + 128 * qt - 1]; refB = qt == nk - 1 ? 0.f : X.cumB[sb + 128 * (qt + 1)]; }
    else { cumF_t = X.lgf * (float)(t_seq + 1); cumB_t = X.lgb * (float)(T - t_seq); refF = X.lgf * (float)(128 * qt); refB = X.lgb * (float)(T - 128 * (qt + 1)); }
    f32x16 Of[2], Ob[2];
#pragma unroll
    for (int e = 0; e < 2; ++e)
#pragma unroll
        for (int r = 0; r < 16; ++r) { Of[e][r] = 0.f; Ob[e][r] = 0.f; }
    float denf = 0.f, denb = 0.f;
    __syncthreads();
    stage_tile(lds + MX_QS, RS, X.Q + (size_t)(sb + 128 * qt) * W5 + h * HD, W5, tid);
    if (seq >= 32) {
        const int b = seq - 32;
        const float* S0 = (type == 0 ? a.in[2] : a.in[3]) + (size_t)((b * 2) * 4 + h) * 16384;
        stage_tile_f32(lds + MX_VS, S0, tid);
        { const int row = tid >> 4, ch = tid & 15; v4u v = {0u, 0u, 0u, 0u};
          if (type == 1 && row < 2) { const float* n0 = a.in[4] + (size_t)((b * 2 + row) * 4 + h) * 128 + ch * 8; v.x = cvtpk(n0[0], n0[1]); v.y = cvtpk(n0[2], n0[3]); v.z = cvtpk(n0[4], n0[5]); v.w = cvtpk(n0[6], n0[7]); }
          *(LAS v4u*)(lds + MX_KS + row * RS + ch * 16) = v; }
        const float m0f = type == 1 ? a.in[5][(b * 2 + 0) * 4 + h] : 0.f, m0b = type == 1 ? a.in[5][(b * 2 + 1) * 4 + h] : 0.f;
        const float scF = __expf(refF + m0f), scB = __expf(refB + m0b);
        __syncthreads();
        f32x16 Sx;
#pragma unroll
        for (int r = 0; r < 16; ++r) Sx[r] = 0.f;
        const LAS unsigned char* nbase = lds + MX_KS + c31 * RS + hh * 16;
#pragma unroll
        for (int ks = 0; ks < 8; ++ks) {
            const bf16x8 qf = ROW_FRAG(qbase, 0, ks);
            Sx = MFMA32(ROW_FRAG(nbase, 0, ks), qf, Sx);
#pragma unroll
            for (int eb = 0; eb < 2; ++eb) Of[eb] = MFMA32(TR_FRAG(vnat, 16 * ks, 16 * ks + 4, eb), qf, Of[eb]);
            if (ks & 1) asm volatile("" ::: "memory");
        }
        if (kh == 0 && hh == 0) { denf = scF * Sx[0]; denb = scB * Sx[1]; }
#pragma unroll
        for (int eb = 0; eb < 2; ++eb) Of[eb] = Of[eb] * scF;
        __syncthreads();
        stage_tile_f32(lds + MX_VS, S0 + 4 * 16384, tid);
        __syncthreads();
#pragma unroll
        for (int ks = 0; ks < 8; ++ks) {
            const bf16x8 qf = ROW_FRAG(qbase, 0, ks);
#pragma unroll
            for (int eb = 0; eb < 2; ++eb) Ob[eb] = MFMA32(TR_FRAG(vnat, 16 * ks, 16 * ks + 4, eb), qf, Ob[eb]);
            if (ks & 1) asm volatile("" ::: "memory");
        }
#pragma unroll
        for (int eb = 0; eb < 2; ++eb) Ob[eb] = Ob[eb] * scB;
        __syncthreads();
    }
    f32x16 S[2];
#define MIX_STAGE_SCORES(j_, mode_) do { \
        stage_tile(lds + MX_KS, RS, X.K + (size_t)(sb + 128 * (j_)) * W5 + h * HD, W5, tid); \
        stage_tile(lds + MX_VS, TRS, X.V + (size_t)(sb + 128 * (j_)) * W5 + h * HD, W5, tid); \
        if (tid < 128) { \
            const int ts = 128 * (j_) + tid, ms = sb + ts; \
            float aF, aB; \
            if (type == 1) { aF = X.liF[ms] - X.cumF[ms]; aB = X.liB[ms] - X.cumB[ms]; } \
            else { aF = -X.lgf * (float)(ts + 1); aB = -X.lgb * (float)(T - ts); } \
            if ((mode_) == 0) CF[tid] = __expf(refF + aF); \
            else if ((mode_) == 1) CF[tid] = __expf(refB + aB); \
            else { CF[tid] = aF; CB[tid] = aB; } \
        } \
        __syncthreads(); \
        _Pragma("unroll") for (int kb = 0; kb < 2; ++kb) _Pragma("unroll") for (int r = 0; r < 16; ++r) S[kb][r] = 0.f; \
        _Pragma("unroll") for (int ks = 0; ks < 8; ++ks) { \
            const bf16x8 qf = ROW_FRAG(qbase, 0, ks); \
            _Pragma("unroll") for (int kb = 0; kb < 2; ++kb) S[kb] = MFMA32(ROW_FRAG(kbase, 32 * kb, ks), qf, S[kb]); \
            if (ks & 1) asm volatile("" ::: "memory"); \
        } } while (0)
    const LAS float* cfl = CF + 64 * kh + 4 * hh; const LAS float* cbl = CB + 64 * kh + 4 * hh;
    for (int step = 0; step < nk - 1; ++step) {
        const int j = step < qt ? step : nk - 1 - (step - qt);
        const int mode = j < qt ? 0 : 1;
        MIX_STAGE_SCORES(j, mode);
        float dsum = 0.f;
#pragma unroll
        for (int f = 0; f < 4; ++f) {
            v4u w;
#pragma unroll
            for (int g2 = 0; g2 < 2; ++g2) { const int g = 2 * (f & 1) + g2; const f32x4 c = *(const LAS f32x4*)(cfl + 32 * (f >> 1) + 8 * g);
                const float p0 = S[f >> 1][4 * g + 0] * c[0], p1 = S[f >> 1][4 * g + 1] * c[1], p2 = S[f >> 1][4 * g + 2] * c[2], p3 = S[f >> 1][4 * g + 3] * c[3];
                dsum += (p0 + p1) + (p2 + p3);
                if (g2 == 0) { w.x = cvtpk(p0, p1); w.y = cvtpk(p2, p3); } else { w.z = cvtpk(p0, p1); w.w = cvtpk(p2, p3); } }
            *(LAS v4u*)(pxw + f * 1024) = w;
        }
        __syncthreads();
        if (mode == 0) { denf += dsum; mix_pv(Of, vbase, pxr); } else { denb += dsum; mix_pv(Ob, vbase, pxr); }
        __syncthreads();
    }
    {
        const float rf = __expf(cumF_t - refF), rb = __expf(cumB_t - refB);
#pragma unroll
        for (int eb = 0; eb < 2; ++eb) { Of[eb] = Of[eb] * rf; Ob[eb] = Ob[eb] * rb; }
        denf *= rf; denb *= rb;
        MIX_STAGE_SCORES(qt, 2);
        int t_loc = t_rel; asm volatile("" : "+v"(t_loc));
#pragma unroll
        for (int dirp = 0; dirp < 2; ++dirp) {
            float dsum = 0.f;
#pragma unroll
            for (int f = 0; f < 4; ++f) {
                v4u w;
#pragma unroll
                for (int g2 = 0; g2 < 2; ++g2) { const int g = 2 * (f & 1) + g2, s0 = 64 * kh + 32 * (f >> 1) + 8 * g + 4 * hh;
                    const f32x4 c = *(const LAS f32x4*)((dirp == 0 ? cfl : cbl) + 32 * (f >> 1) + 8 * g);
                    float pv[4];
#pragma unroll
                    for (int i = 0; i < 4; ++i) { const bool on = dirp == 0 ? (s0 + i) <= t_loc : (s0 + i) >= t_loc;
                        const float wgt = on ? __expf((dirp == 0 ? cumF_t : cumB_t) + c[i]) : 0.f; pv[i] = S[f >> 1][4 * g + i] * wgt; dsum += pv[i]; }
                    if (g2 == 0) { w.x = cvtpk(pv[0], pv[1]); w.y = cvtpk(pv[2], pv[3]); } else { w.z = cvtpk(pv[0], pv[1]); w.w = cvtpk(pv[2], pv[3]); } }
                *(LAS v4u*)(pxw + f * 1024) = w;
            }
            __syncthreads();
            if (dirp == 0) { denf += dsum; mix_pv(Of, vbase, pxr); } else { denb += dsum; mix_pv(Ob, vbase, pxr); }
            __syncthreads();
        }
    }
#undef MIX_STAGE_SCORES
    LAS float* DEN = (LAS float*)(lds + MX_DEN); LAS float* ST = (LAS float*)(lds + MX_ST);
    float hv[2][16];
    if (type == 1) {
        denf += __shfl_xor(denf, 32); denb += __shfl_xor(denb, 32);
        if (hh == 0) { DEN[(wave * 2 + 0) * 32 + c31] = denf; DEN[(wave * 2 + 1) * 32 + c31] = denb; }
        __syncthreads();
        denf += DEN[((wave ^ 1) * 2 + 0) * 32 + c31]; denb += DEN[((wave ^ 1) * 2 + 1) * 32 + c31];
        const float inf_ = 1.f / fmaxf(fabsf(denf), 1.f), inb_ = 1.f / fmaxf(fabsf(denb), 1.f);
#pragma unroll
        for (int eb = 0; eb < 2; ++eb)
#pragma unroll
            for (int r = 0; r < 16; ++r) hv[eb][r] = Of[eb][r] * inf_ + Ob[eb][r] * inb_;
    } else {
#pragma unroll
        for (int eb = 0; eb < 2; ++eb)
#pragma unroll
            for (int r = 0; r < 16; ++r) hv[eb][r] = Of[eb][r] + Ob[eb][r];
    }
    float s1 = 0.f;
#pragma unroll
    for (int eb = 0; eb < 2; ++eb)
#pragma unroll
        for (int r = 0; r < 16; ++r) s1 += hv[eb][r];
    s1 += __shfl_xor(s1, 32);
    if (hh == 0) ST[(wave * 2 + 0) * 32 + c31] = s1;
    __syncthreads();
    const float mean = (s1 + ST[((wave ^ 1) * 2 + 0) * 32 + c31]) * (1.f / 128.f);
    float s2 = 0.f;
#pragma unroll
    for (int eb = 0; eb < 2; ++eb)
#pragma unroll
        for (int r = 0; r < 16; ++r) { hv[eb][r] -= mean; s2 += hv[eb][r] * hv[eb][r]; }
    s2 += __shfl_xor(s2, 32);
    if (hh == 0) ST[(wave * 2 + 1) * 32 + c31] = s2;
    __syncthreads();
    const float rstd = rsqrtf((s2 + ST[((wave ^ 1) * 2 + 1) * 32 + c31]) * (1.f / 128.f) + EPS);
    bf16_t* outp = (bf16_t*)(a.ws + WS_MIX) + (size_t)m_t * D + type * 512 + h * HD;
    const bf16_t* gtp = X.GT + (size_t)m_t * W5 + h * HD;
#pragma unroll
    for (int eb = 0; eb < 2; ++eb)
#pragma unroll
        for (int g = 0; g < 4; ++g) {
            const int e0 = 64 * kh + 32 * eb + 8 * g + 4 * hh;
            const f32x4 gn = *(const f32x4*)(X.gain + h * HD + e0);
            const unsigned long long gw_ = *(const unsigned long long*)(gtp + e0);
            const unsigned g01 = (unsigned)gw_, g23 = (unsigned)(gw_ >> 32);
            const float y0 = hv[eb][4 * g + 0] * rstd * gn[0] * __uint_as_float(g01 << 16), y1 = hv[eb][4 * g + 1] * rstd * gn[1] * __uint_as_float(g01 & 0xffff0000u);
            const float y2 = hv[eb][4 * g + 2] * rstd * gn[2] * __uint_as_float(g23 << 16), y3 = hv[eb][4 * g + 3] * rstd * gn[3] * __uint_as_float(g23 & 0xffff0000u);
            *(unsigned long long*)(outp + e0) = (unsigned long long)cvtpk(y0, y1) | ((unsigned long long)cvtpk(y2, y3) << 32);
        }
}

__device__ __forceinline__ void mix_state_item(Frame& F, const Args& a, const MixSrc& X, int type, int b, int h) {
    LAS unsigned char* lds = F.lds;
    int tid = F.tid; asm volatile("" : "+v"(tid));
    const int lane = tid & 63, wave = F.wave, c31 = lane & 31, hh = lane >> 5, sb = b * TP;
    LAS float* WSM = (LAS float*)(lds + MX_W); LAS float* RED = (LAS float*)(lds + MX_RED);
    __syncthreads();
    {
        const int dir = tid >> 8, s = tid & 255; float lw, mfin = 0.f;
        if (type == 1) {
            const float* cu = dir == 0 ? X.cumF : X.cumB; const float* li = dir == 0 ? X.liF : X.liB;
            const float tot = cu[sb + (dir == 0 ? TP - 1 : 0)];
            lw = tot - cu[sb + s] + li[sb + s];
            float mx = lw;
#pragma unroll
            for (int o = 32; o > 0; o >>= 1) mx = fmaxf(mx, __shfl_xor(mx, o));
            if (lane == 0) RED[wave] = mx;
            __syncthreads();
            mfin = fmaxf(fmaxf(fmaxf(RED[dir * 4 + 0], RED[dir * 4 + 1]), fmaxf(RED[dir * 4 + 2], RED[dir * 4 + 3])), tot);
            lw -= mfin;
            if (s == 0) a.out[O_M + (b * 2 + dir) * 4 + h] = mfin;
        } else lw = (dir == 0 ? X.lgf : X.lgb) * (float)(dir == 0 ? TP - 1 - s : s);
        WSM[dir * 256 + s] = __expf(lw);
    }
    const int dir = wave >> 2, dkb = wave & 3;
    const int trl = ((lane & 15) >> 2) * TRS + ((lane >> 4) & 1) * 32 + (lane & 3) * 8 + hh * 8 * TRS;
    const LAS unsigned char* kt = lds + MX_KS + trl + dkb * 64;
    const LAS unsigned char* vt = lds + MX_VS + trl;
    const LAS float* wl = WSM + dir * 256 + 8 * hh;
    f32x16 acc[4], accn;
#pragma unroll
    for (int r = 0; r < 16; ++r) { accn[r] = 0.f;
#pragma unroll
        for (int v = 0; v < 4; ++v) acc[v][r] = 0.f; }
    bf16x8 ones;
#pragma unroll
    for (int j = 0; j < 8; ++j) ones[j] = (short)0x3F80;
    for (int jt = 0; jt < 2; ++jt) {
        __syncthreads();
        stage_tile(lds + MX_KS, TRS, X.K + (size_t)(sb + 128 * jt) * W5 + h * HD, W5, tid);
        stage_tile(lds + MX_VS, TRS, X.V + (size_t)(sb + 128 * jt) * W5 + h * HD, W5, tid);
        __syncthreads();
#pragma unroll
        for (int ks = 0; ks < 8; ++ks) {
            const bf16x8 kr = TR_FRAG(kt, 16 * ks, 16 * ks + 4, 0);
            const f32x4 w0 = *(const LAS f32x4*)(wl + 128 * jt + 16 * ks), w1 = *(const LAS f32x4*)(wl + 128 * jt + 16 * ks + 4);
            const v4u ku = __builtin_bit_cast(v4u, kr);
            v4u kw;
            kw.x = cvtpk(__uint_as_float(ku.x << 16) * w0[0], __uint_as_float(ku.x & 0xffff0000u) * w0[1]);
            kw.y = cvtpk(__uint_as_float(ku.y << 16) * w0[2], __uint_as_float(ku.y & 0xffff0000u) * w0[3]);
            kw.z = cvtpk(__uint_as_float(ku.z << 16) * w1[0], __uint_as_float(ku.z & 0xffff0000u) * w1[1]);
            kw.w = cvtpk(__uint_as_float(ku.w << 16) * w1[2], __uint_as_float(ku.w & 0xffff0000u) * w1[3]);
            const bf16x8 ka = __builtin_bit_cast(bf16x8, kw);
#pragma unroll
            for (int v = 0; v < 4; ++v) acc[v] = MFMA32(ka, TR_FRAG(vt, 16 * ks, 16 * ks + 4, v), acc[v]);
            if (type == 1) accn = MFMA32(ka, ones, accn);
        }
    }
    float* O = a.out + (type == 0 ? O_RET : O_C) + (size_t)((b * 2 + dir) * 4 + h) * 16384;
#pragma unroll
    for (int v = 0; v < 4; ++v)
#pragma unroll
        for (int r = 0; r < 16; ++r) O[(32 * dkb + (r & 3) + 8 * (r >> 2) + 4 * hh) * 128 + 32 * v + c31] = acc[v][r];
    if (type == 1 && c31 == 0) {
#pragma unroll
        for (int r = 0; r < 16; ++r) a.out[O_N + (size_t)((b * 2 + dir) * 4 + h) * 128 + 32 * dkb + (r & 3) + 8 * (r >> 2) + 4 * hh] = accn[r];
    }
}

__device__ __forceinline__ void p4_mixer(Frame& F, const Args& a) {
    unsigned char* ws = a.ws;
    for (int item = F.vcu; item < 768; item += F.G) {
        const int kind = item >> 8, idx = item & 255, type = idx >> 7, r = idx & 127;
        MixSrc X;
        X.Q = (const bf16_t*)(ws + (type == 0 ? WS_RQ : WS_MQ)); X.K = (const bf16_t*)(ws + (type == 0 ? WS_RK : WS_MK)); X.V = (const bf16_t*)(ws + (type == 0 ? WS_RV : WS_MV));
        X.GT = (const bf16_t*)(ws + (type == 0 ? WS_RG : WS_MO)); X.gain = type == 0 ? a.in[16] : a.in[17];
        int h, seq, qt0 = 0, nq = 1;
        if (kind == 0) { seq = 32 + (r >> 6); h = (r >> 4) & 3; qt0 = r & 15; } else { seq = r >> 2; h = r & 3; nq = 2; }
        X.cumF = (const float*)(ws + WS_GCUM) + (size_t)h * M; X.cumB = (const float*)(ws + WS_GCUM) + (size_t)(4 + h) * M;
        X.liF = (const float*)(ws + WS_GLI) + (size_t)h * M; X.liB = (const float*)(ws + WS_GLI) + (size_t)(4 + h) * M;
        X.lgf = logsigf(a.in[14][h]); X.lgb = logsigf(a.in[14][4 + h]);
        if (kind < 2) { for (int q = 0; q < nq; ++q) mix_attn_item(F, a, X, type, seq, h, qt0 + q); }
        else mix_state_item(F, a, X, type, seq, h);
    }
    __syncthreads();
}

__device__ __forceinline__ void p6_norm2(Frame& F, const Args& a) {
    const int gw = F.vcu * NWAVES + F.wave, NGW = F.G * NWAVES, lane = F.lane;
    const float* mod = (const float*)(a.ws + WS_MOD);
    for (int m = gw; m < M; m += NGW) {
        const int cnd = cond_of(m);
        const f32x4* xr = (const f32x4*)(a.out + O_Y + (size_t)m * D) + lane;
        f32x4 v[4]; float ss = 0.f;
#pragma unroll
        for (int j = 0; j < 4; ++j) { v[j] = xr[64 * j]; ss += (v[j].x * v[j].x + v[j].y * v[j].y) + (v[j].z * v[j].z + v[j].w * v[j].w); }
        const float rstd = rsqrtf(wave_sum(ss) * (1.f / D) + EPS);
        unsigned long long* o8 = (unsigned long long*)((bf16_t*)(a.ws + WS_H) + (size_t)m * D) + lane;
#pragma unroll
        for (int j = 0; j < 4; ++j) { const int k = 4 * (lane + 64 * j);
            const f32x4 g = *(const f32x4*)(a.in[11] + k), sc = *(const f32x4*)(mod + cnd * 6144 + 4096 + k), sh = *(const f32x4*)(mod + cnd * 6144 + 3072 + k);
            const f32x4 hh_ = v[j] * rstd * g * (sc + 1.f) + sh;
            o8[64 * j] = (unsigned long long)cvtpk(hh_.x, hh_.y) | ((unsigned long long)cvtpk(hh_.z, hh_.w) << 32); }
    }
}
__device__ __forceinline__ void p9_final(Frame& F, const Args& a) {
    const int gw = F.vcu * NWAVES + F.wave, NGW = F.G * NWAVES, lane = F.lane;
    for (int m = gw; m < M; m += NGW) {
        f32x4* xr = (f32x4*)(a.out + O_Y + (size_t)m * D) + lane;
        f32x4 v[4]; float ss = 0.f;
#pragma unroll
        for (int j = 0; j < 4; ++j) { v[j] = xr[64 * j]; ss += (v[j].x * v[j].x + v[j].y * v[j].y) + (v[j].z * v[j].z + v[j].w * v[j].w); }
        const float rstd = rsqrtf(wave_sum(ss) * (1.f / D) + EPS);
#pragma unroll
        for (int j = 0; j < 4; ++j) xr[64 * j] = v[j] * rstd * *(const f32x4*)(a.in[21] + 4 * (lane + 64 * j));
    }
}

__global__ void __launch_bounds__(NWAVES * 64, 2) mega(Args args) {
    extern __shared__ __attribute__((aligned(16))) unsigned char lds[];
    Frame F;
    F.lds = (LAS unsigned char*)lds;
    F.MISC = (volatile LAS unsigned*)(F.lds + MISC_OFF);
    F.tid = threadIdx.x; F.lane = F.tid & 63; F.wave = __builtin_amdgcn_readfirstlane(F.tid >> 6);
    F.G = gridDim.x; { const int bx = blockIdx.x; F.vcu = (F.G % 8 == 0) ? (bx % 8) * (F.G / 8) + bx / 8 : bx; }
    unsigned char* ws = args.ws;
    F.ctl = (gu32*)(ws + WS_CTL);
    for (int u = F.tid; u < (LDS_BYTES - LDSCTL_OFF) / 4; u += NWAVES * 64) ((LAS unsigned*)(F.lds + LDSCTL_OFF))[u] = 0u;
    __syncthreads();
    XcdBarrier bar = xcd_barrier_post((unsigned*)(F.ctl + CW_BAR) + args.li * XCD_BAR_WORDS, F.MISC + 8);
    const int lo = args.ph_lo, hi = args.ph_hi;
#define IN(k) (lo <= (k) && (k) < hi)
#define BOTH(k) (IN(k) && IN((k) + 1))
    if (IN(0)) { p0_prologue(F, args); if (BOTH(0)) xcd_barrier(bar); }
    if (IN(1)) { p1_norm_gates(F, args); if (BOTH(1)) xcd_barrier(bar); }
    if (IN(2)) {
        pg8::Gemm g{(const bf16_t*)(ws + WS_H), (const bf16_t*)(ws + WS_WIN), M, 4096, D}; pg8::StaticOrder S; S.init(M, 4096, F.G, (int)blockIdx.x);
        pg8::EpiProj E{ws, (const float*)(ws + WS_ROPE)};
        pg8::gemm_phase<pg8::EpiProj, pg8::StaticOrder, true, true>(F.lds + RING_OFF, g, S, E);
        if (BOTH(2)) xcd_barrier(bar);
    }
    if (IN(3)) { p3_conv_cumsum(F, args); if (BOTH(3)) xcd_barrier(bar); }
    if (IN(4)) { p4_mixer(F, args); if (BOTH(4)) xcd_barrier(bar); }
    if (IN(5)) {
        pg8::Gemm g{(const bf16_t*)(ws + WS_MIX), (const bf16_t*)(ws + WS_WOUT), M, D, D}; pg8::StaticOrder S; S.init(M, D, F.G, (int)blockIdx.x);
        pg8::EpiRes E{args.in[0], args.in[1], args.out + O_Y, (const float*)(ws + WS_MOD) + 2048};
        pg8::gemm_phase<pg8::EpiRes, pg8::StaticOrder, true, true>(F.lds + RING_OFF, g, S, E);
        if (BOTH(5)) xcd_barrier(bar);
    }
    if (IN(6)) { p6_norm2(F, args); if (BOTH(6)) xcd_barrier(bar); }
    if (IN(7)) {
        pg8::Gemm g{(const bf16_t*)(ws + WS_H), (const bf16_t*)(ws + WS_W1), M, FF, D}; pg8::StaticOrder S; S.init(M, FF, F.G, (int)blockIdx.x);
        pg8::EpiRelu2 E{(bf16_t*)(ws + WS_U)};
        pg8::gemm_phase<pg8::EpiRelu2, pg8::StaticOrder, true, true>(F.lds + RING_OFF, g, S, E);
        if (BOTH(7)) xcd_barrier(bar);
    }
    if (IN(8)) {
        pg8::Gemm g{(const bf16_t*)(ws + WS_U), (const bf16_t*)(ws + WS_W2), M, D, FF}; pg8::StaticOrder S; S.init(M, D, F.G, (int)blockIdx.x);
        pg8::EpiRes E{args.out + O_Y, args.out + O_Y + (size_t)NP * D, args.out + O_Y, (const float*)(ws + WS_MOD) + 5120};
        pg8::gemm_phase<pg8::EpiRes, pg8::StaticOrder, true, true>(F.lds + RING_OFF, g, S, E);
        if (BOTH(8)) xcd_barrier(bar);
    }
    if (IN(9)) p9_final(F, args);
#undef IN
#undef BOTH
}

extern "C" void kernel_launch(void* const* d_in, const int* in_sizes, int n_in, void* d_out, int out_size, void* d_ws, size_t ws_size, hipStream_t stream) {
    static int grid = 0;
    if (grid == 0) {
        if (n_in != 22 || ws_size < WS_END) { fprintf(stderr, "kernel_launch: unexpected n_in %d / ws_size %zu\n", n_in, ws_size); grid = -1; return; }
        int dev = 0, cus = 0, per_cu = 0;
        if (hipGetDevice(&dev) != hipSuccess || hipDeviceGetAttribute(&cus, hipDeviceAttributeMultiprocessorCount, dev) != hipSuccess) { grid = -1; return; }
        if (hipFuncSetAttribute((const void*)mega, hipFuncAttributeMaxDynamicSharedMemorySize, LDS_BYTES) != hipSuccess) { fprintf(stderr, "kernel_launch: hipFuncSetAttribute failed\n"); grid = -1; return; }
        if (hipOccupancyMaxActiveBlocksPerMultiprocessor(&per_cu, (const void*)mega, NWAVES * 64, LDS_BYTES) != hipSuccess || per_cu < 1) fprintf(stderr, "kernel_launch: occupancy query says %d\n", per_cu);
        (void)hipGetLastError();
        grid = cus;
    }
    if (grid < 0) return;
    P p{};
    p.xp = (const float*)d_in[0]; p.xs = (const float*)d_in[1]; p.st_ret = (const float*)d_in[2]; p.st_C = (const float*)d_in[3];
    p.st_n = (const float*)d_in[4]; p.st_m = (const float*)d_in[5]; p.c = (const float*)d_in[6]; p.cctx = (const float*)d_in[7];
    p.w_ada = (const float*)d_in[8]; p.b_ada = (const float*)d_in[9]; p.n1g = (const float*)d_in[10]; p.n2g = (const float*)d_in[11];
    p.w_in = (const float*)d_in[12]; p.conv_w = (const float*)d_in[13]; p.decay = (const float*)d_in[14]; p.gbias = (const float*)d_in[15];
    p.rgn = (const float*)d_in[16]; p.mgn = (const float*)d_in[17]; p.w_out = (const float*)d_in[18]; p.w_ff1 = (const float*)d_in[19];
    p.w_ff2 = (const float*)d_in[20]; p.fg = (const float*)d_in[21];
    p.out = (float*)d_out; p.ws = (unsigned char*)d_ws;
    (void)hipMemsetAsync((char*)d_ws + WS_CTL, 0, CTL_ZERO_BYTES, stream);
    Args a{};
    for (int i = 0; i < 22; ++i) a.in[i] = (const float*)d_in[i];
    a.out = (float*)d_out; a.ws = (unsigned char*)d_ws;
    int li = 0;
#define MEGA(lo_, hi_) do { a.ph_lo = (lo_); a.ph_hi = (hi_); a.li = li++; hipLaunchKernelGGL(mega, dim3(grid), dim3(NWAVES * 64), LDS_BYTES, stream, a); } while (0)
#ifndef MIX_NAIVE
#define MIX_NAIVE 0
#endif
#if MIX_NAIVE
    MEGA(0, 4);
    k_mix<<<dim3(M / 16, 4, 2), 256, 0, stream>>>(p);
    k_states<<<dim3(32, 4, 4), 256, 0, stream>>>(p);
    MEGA(5, 10);
#else
    MEGA(0, 10);
#endif
}
```

```cpp
#include <hip/hip_runtime.h>
#include <cstdint>
#include <cstdio>

typedef unsigned short bf16_t;

constexpr int D = 1024, NP = 32 * 256, NS = 2 * 2048, M = NP + NS;
constexpr int TP = 256, TS = 2048;
constexpr int INC = 4112, FF = 4096, NH = 4, HD = 128, W5 = 512;
constexpr float EPS = 1e-6f;

constexpr size_t MiB = 1u << 20;
constexpr size_t WS_CTL = 0;
constexpr size_t WS_MOD = 1 * MiB;
constexpr size_t WS_ROPE = 1 * MiB + 128 * 1024;
constexpr size_t WS_GATES = 2 * MiB;
constexpr size_t WS_GLI = 3 * MiB;
constexpr size_t WS_GCUM = 3 * MiB + 512 * 1024;
constexpr size_t WS_WIN = 4 * MiB;
constexpr size_t WS_WOUT = 12 * MiB;
constexpr size_t WS_W1 = 14 * MiB;
constexpr size_t WS_W2 = 22 * MiB;
constexpr size_t WS_H = 32 * MiB;
constexpr size_t WS_MIX = 56 * MiB;
constexpr size_t WS_RQ = 80 * MiB;
constexpr size_t WS_RK = 92 * MiB;
constexpr size_t WS_RV = 104 * MiB;
constexpr size_t WS_RG = 116 * MiB;
constexpr size_t WS_MQKP = 128 * MiB;
constexpr size_t WS_MV = 152 * MiB;
constexpr size_t WS_MO = 164 * MiB;
constexpr size_t WS_MQ = 176 * MiB;
constexpr size_t WS_MK = 188 * MiB;
constexpr size_t WS_U = 80 * MiB;
constexpr size_t WS_END = 200 * MiB;

constexpr size_t O_Y = 0;
constexpr size_t O_RET = (size_t)M * D;
constexpr size_t O_C = O_RET + (size_t)32 * 2 * 4 * 128 * 128;
constexpr size_t O_N = O_C + (size_t)32 * 2 * 4 * 128 * 128;
constexpr size_t O_M = O_N + (size_t)32 * 2 * 4 * 128;

__device__ __forceinline__ float bf2f(bf16_t v) { return __uint_as_float((unsigned)v << 16); }
__device__ __forceinline__ bf16_t f2bf(float f) { unsigned u = __float_as_uint(f); return (bf16_t)((u + 0x7fffu + ((u >> 16) & 1u)) >> 16); }
__device__ __forceinline__ float siluf(float x) { return x / (1.f + __expf(-x)); }
__device__ __forceinline__ float sigmf(float x) { return 1.f / (1.f + __expf(-x)); }
__device__ __forceinline__ float logsigf(float x) { return fminf(x, 0.f) - log1pf(__expf(-fabsf(x))); }
__device__ __forceinline__ int cond_of(int m) { return m < NP ? 0 : 1 + (m - NP) / TS; }

struct P {
    const float *xp, *xs, *st_ret, *st_C, *st_n, *st_m, *c, *cctx, *w_ada, *b_ada, *n1g, *n2g, *w_in, *conv_w, *decay, *gbias, *rgn, *mgn, *w_out, *w_ff1, *w_ff2, *fg;
    float* out; unsigned char* ws;
};
__device__ __forceinline__ const float* xrow(const P& p, int m) { return m < NP ? p.xp + (size_t)m * D : p.xs + (size_t)(m - NP) * D; }

__global__ void k_wt(const float* W, int ldw, int K, bf16_t* WT) {
    __shared__ float t[32][33];
    const int n0 = blockIdx.x * 32, k0 = blockIdx.y * 32, tx = threadIdx.x, ty = threadIdx.y;
    for (int i = ty; i < 32; i += 8) t[i][tx] = W[(size_t)(k0 + i) * ldw + n0 + tx];
    __syncthreads();
    for (int i = ty; i < 32; i += 8) WT[(size_t)(n0 + i) * K + k0 + tx] = f2bf(t[tx][i]);
}

__global__ void k_mod(P p) {
    const int j = blockIdx.x * 256 + threadIdx.x, cnd = blockIdx.y;
    const float* cv = cnd == 0 ? p.cctx : p.c + (size_t)(cnd - 1) * D;
    float acc = 0.f;
    for (int k = 0; k < D; ++k) acc += siluf(cv[k]) * p.w_ada[(size_t)k * 6144 + j];
    ((float*)(p.ws + WS_MOD))[cnd * 6144 + j] = acc + p.b_ada[j];
}

__global__ void k_rope(P p) {
    const int pos = blockIdx.x, f = threadIdx.x;
    const float inv = (float)exp(-(double)f / 32.0 * log(10000.0));
    const float ang = (float)pos * inv;
    float* rc = (float*)(p.ws + WS_ROPE);
    rc[pos * 32 + f] = (float)cos((double)ang);
    rc[2048 + pos * 32 + f] = (float)sin((double)ang);
}

__device__ __forceinline__ float block_sum256(float v, float* red) {
    for (int o = 32; o > 0; o >>= 1) v += __shfl_xor(v, o);
    __syncthreads();
    if ((threadIdx.x & 63) == 0) red[threadIdx.x >> 6] = v;
    __syncthreads();
    return red[0] + red[1] + red[2] + red[3];
}

__global__ void k_norm(P p, int which) {
    __shared__ float red[4];
    __shared__ float gsum[16][4];
    const int m = blockIdx.x, tid = threadIdx.x, cnd = cond_of(m);
    const float* xr = which == 0 ? xrow(p, m) : p.out + O_Y + (size_t)m * D;
    const float* mod = (const float*)(p.ws + WS_MOD) + cnd * 6144;
    const float* sh = mod + (which == 0 ? 0 : 3072);
    const float* sc = mod + (which == 0 ? 1024 : 4096);
    const float* g = which == 0 ? p.n1g : p.n2g;
    float v[4], ss = 0.f;
    for (int i = 0; i < 4; ++i) { v[i] = xr[tid + 256 * i]; ss += v[i] * v[i]; }
    ss = block_sum256(ss, red);
    const float rstd = rsqrtf(ss * (1.f / D) + EPS);
    bf16_t* H = (bf16_t*)(p.ws + WS_H) + (size_t)m * D;
    float h[4];
    for (int i = 0; i < 4; ++i) { const int k = tid + 256 * i; h[i] = v[i] * rstd * g[k] * (1.f + sc[k]) + sh[k]; H[k] = f2bf(h[i]); }
    if (which == 0) {
        float ga[16];
        for (int j = 0; j < 16; ++j) ga[j] = 0.f;
        for (int i = 0; i < 4; ++i) { const int k = tid + 256 * i; const float* wr = p.w_in + (size_t)k * INC + 4096;
            for (int j = 0; j < 16; ++j) ga[j] += h[i] * wr[j]; }
        for (int j = 0; j < 16; ++j) { float s = ga[j]; for (int o = 32; o > 0; o >>= 1) s += __shfl_xor(s, o); if ((tid & 63) == 0) gsum[j][tid >> 6] = s; }
        __syncthreads();
        if (tid < 16) ((float*)(p.ws + WS_GATES))[(size_t)m * 16 + tid] = gsum[tid][0] + gsum[tid][1] + gsum[tid][2] + gsum[tid][3] + p.gbias[tid];
    }
}

enum { EPI_PROJ = 0, EPI_RES1 = 1, EPI_RELU2 = 2, EPI_RES2 = 3 };
template <int EPI>
__global__ void __launch_bounds__(256) k_gemm(P p, const bf16_t* A, const bf16_t* WT, int K) {
    __shared__ float As[16][68];
    __shared__ float Bs[16][132];
    __shared__ float Cs[64][129];
    const int tid = threadIdx.x, m0 = blockIdx.y * 64, n0 = blockIdx.x * 128;
    const int ty = tid >> 4, tx = tid & 15;
    float acc[4][8];
    for (int i = 0; i < 4; ++i) for (int j = 0; j < 8; ++j) acc[i][j] = 0.f;
    for (int k0 = 0; k0 < K; k0 += 16) {
        { const int r = tid >> 2, kk = (tid & 3) * 4; const bf16_t* a = A + (size_t)(m0 + r) * K + k0 + kk;
          for (int j = 0; j < 4; ++j) As[kk + j][r] = bf2f(a[j]); }
        { const int r = tid >> 1, kk = (tid & 1) * 8; const bf16_t* b = WT + (size_t)(n0 + r) * K + k0 + kk;
          for (int j = 0; j < 8; ++j) Bs[kk + j][r] = bf2f(b[j]); }
        __syncthreads();
        for (int kk = 0; kk < 16; ++kk) {
            float a[4], b[8];
            for (int i = 0; i < 4; ++i) a[i] = As[kk][ty * 4 + i];
            for (int j = 0; j < 8; ++j) b[j] = Bs[kk][tx * 8 + j];
            for (int i = 0; i < 4; ++i) for (int j = 0; j < 8; ++j) acc[i][j] += a[i] * b[j];
        }
        __syncthreads();
    }
    for (int i = 0; i < 4; ++i) for (int j = 0; j < 8; ++j) Cs[ty * 4 + i][tx * 8 + j] = acc[i][j];
    __syncthreads();
    if (EPI == EPI_PROJ) {
        const int sec = n0 / 512, hc = n0 % 512;
        const float* rc = (const float*)(p.ws + WS_ROPE);
        for (int e = tid; e < 64 * 128; e += 256) {
            const int r = e >> 7, d = e & 127, m = m0 + r;
            float v = Cs[r][d];
            if (sec <= 1) {
                if (sec == 1) v *= 0.08838834764831845f;
                if (m >= NP) {
                    const int t = (m - NP) % TS, dd = d & 63, f = dd & 31, pos = dd < 32 ? t / 64 : t % 64;
                    const float cs = rc[pos * 32 + f], sn = rc[2048 + pos * 32 + f];
                    float o = Cs[r][d ^ 64]; if (sec == 1) o *= 0.08838834764831845f;
                    v = d < 64 ? v * cs - o * sn : o * sn + v * cs;
                }
                ((bf16_t*)(p.ws + (sec == 0 ? WS_RQ : WS_RK)))[(size_t)m * W5 + hc + d] = f2bf(v);
            } else if (sec == 2) ((bf16_t*)(p.ws + WS_RV))[(size_t)m * W5 + hc + d] = f2bf(v);
            else if (sec == 3) ((bf16_t*)(p.ws + WS_RG))[(size_t)m * W5 + hc + d] = f2bf(siluf(v));
            else if (sec <= 5) ((bf16_t*)(p.ws + WS_MQKP))[(size_t)m * 1024 + (n0 - 2048) + d] = f2bf(v);
            else if (sec == 6) ((bf16_t*)(p.ws + WS_MV))[(size_t)m * W5 + hc + d] = f2bf(v);
            else ((bf16_t*)(p.ws + WS_MO))[(size_t)m * W5 + hc + d] = f2bf(sigmf(v));
        }
    } else if (EPI == EPI_RES1) {
        for (int e = tid; e < 64 * 128; e += 256) { const int r = e >> 7, n = n0 + (e & 127), m = m0 + r;
            const float g1 = ((const float*)(p.ws + WS_MOD))[cond_of(m) * 6144 + 2048 + n];
            p.out[O_Y + (size_t)m * D + n] = xrow(p, m)[n] + g1 * Cs[r][e & 127]; }
    } else if (EPI == EPI_RELU2) {
        for (int e = tid; e < 64 * 128; e += 256) { const int r = e >> 7, n = n0 + (e & 127), m = m0 + r;
            const float v = fmaxf(Cs[r][e & 127], 0.f);
            ((bf16_t*)(p.ws + WS_U))[(size_t)m * FF + n] = f2bf(v * v); }
    } else {
        for (int e = tid; e < 64 * 128; e += 256) { const int r = e >> 7, n = n0 + (e & 127), m = m0 + r;
            const float g2 = ((const float*)(p.ws + WS_MOD))[cond_of(m) * 6144 + 5120 + n];
            p.out[O_Y + (size_t)m * D + n] += g2 * Cs[r][e & 127]; }
    }
}

__global__ void k_conv(P p) {
    const int m = blockIdx.x, T = m < NP ? TP : TS, t = m < NP ? m % TP : (m - NP) % TS;
    const bf16_t* X = (const bf16_t*)(p.ws + WS_MQKP);
    for (int c = threadIdx.x; c < 1024; c += 256) {
        float v = p.conv_w[1024 + c] * bf2f(X[(size_t)m * 1024 + c]);
        if (t > 0) v += p.conv_w[c] * bf2f(X[(size_t)(m - 1) * 1024 + c]);
        if (t < T - 1) v += p.conv_w[2048 + c] * bf2f(X[(size_t)(m + 1) * 1024 + c]);
        v = siluf(v);
        if (c < 512) ((bf16_t*)(p.ws + WS_MQ))[(size_t)m * W5 + c] = f2bf(v);
        else ((bf16_t*)(p.ws + WS_MK))[(size_t)m * W5 + c - 512] = f2bf(v * 0.08838834764831845f);
    }
}

__global__ void k_gates(P p) {
    const int id = blockIdx.x * 64 + threadIdx.x;
    if (id >= 34 * 8) return;
    const int seq = id / 8, h = id % 4, dir = (id / 4) % 2;
    const int T = seq < 32 ? TP : TS, mbase = seq < 32 ? seq * TP : NP + (seq - 32) * TS;
    const float* G = (const float*)(p.ws + WS_GATES);
    float* LI = (float*)(p.ws + WS_GLI) + (size_t)(dir * 4 + h) * M;
    float* CU = (float*)(p.ws + WS_GCUM) + (size_t)(dir * 4 + h) * M;
    float cum = 0.f;
    for (int i = 0; i < T; ++i) {
        const int m = mbase + (dir == 0 ? i : T - 1 - i);
        cum += logsigf(G[(size_t)m * 16 + dir * 8 + 4 + h]);
        CU[m] = cum; LI[m] = G[(size_t)m * 16 + dir * 8 + h];
    }
}

__global__ void __launch_bounds__(256) k_mix(P p) {
    __shared__ float qs[16][128];
    __shared__ float ks[32][129];
    __shared__ float vs[32][128];
    __shared__ float pf[16][32], pb[16][32];
    __shared__ float os[16][129];
    const int tid = threadIdx.x, m0 = blockIdx.x * 16, h = blockIdx.y, type = blockIdx.z;
    const bool lat = m0 >= NP;
    const int T = lat ? TS : TP, sb = lat ? NP + ((m0 - NP) / TS) * TS : (m0 / TP) * TP, t0 = m0 - sb;
    const bf16_t* Q = (const bf16_t*)(p.ws + (type == 0 ? WS_RQ : WS_MQ));
    const bf16_t* Kp = (const bf16_t*)(p.ws + (type == 0 ? WS_RK : WS_MK));
    const bf16_t* V = (const bf16_t*)(p.ws + (type == 0 ? WS_RV : WS_MV));
    const float lgf = logsigf(p.decay[h]), lgb = logsigf(p.decay[4 + h]);
    const float* LI0 = (const float*)(p.ws + WS_GLI) + (size_t)h * M;
    const float* LI1 = (const float*)(p.ws + WS_GLI) + (size_t)(4 + h) * M;
    const float* CU0 = (const float*)(p.ws + WS_GCUM) + (size_t)h * M;
    const float* CU1 = (const float*)(p.ws + WS_GCUM) + (size_t)(4 + h) * M;
    for (int e = tid; e < 16 * 128; e += 256) qs[e >> 7][e & 127] = bf2f(Q[(size_t)(m0 + (e >> 7)) * W5 + h * HD + (e & 127)]);
    const int e_ = tid & 127, rh = tid >> 7;
    float of[8], ob[8];
    for (int i = 0; i < 8; ++i) { of[i] = 0.f; ob[i] = 0.f; }
    float den = 0.f;
    for (int s0 = 0; s0 < T; s0 += 32) {
        __syncthreads();
        for (int e = tid; e < 32 * 128; e += 256) { const int s = e >> 7, d = e & 127; const size_t a = (size_t)(sb + s0 + s) * W5 + h * HD + d;
            ks[s][d] = bf2f(Kp[a]); vs[s][d] = bf2f(V[a]); }
        __syncthreads();
        for (int e = tid; e < 16 * 32; e += 256) {
            const int r = e >> 5, s = e & 31, t = t0 + r, sg = s0 + s;
            float dot = 0.f;
            for (int d = 0; d < 128; ++d) dot += qs[r][d] * ks[s][d];
            float wf, wb;
            if (type == 0) {
                wf = sg < t ? __expf(lgf * (float)(t - sg)) : (sg > t ? __expf(lgb * (float)(sg - t)) : 2.f);
                wb = 0.f;
            } else {
                wf = sg <= t ? __expf(CU0[sb + t] - CU0[sb + sg] + LI0[sb + sg]) : 0.f;
                wb = sg >= t ? __expf(CU1[sb + t] - CU1[sb + sg] + LI1[sb + sg]) : 0.f;
            }
            pf[r][s] = dot * wf; pb[r][s] = dot * wb;
        }
        __syncthreads();
        if (tid < 32) { const int r = tid & 15; float a = 0.f; for (int s = 0; s < 32; ++s) a += (tid < 16 ? pf[r][s] : pb[r][s]); den += a; }
        for (int s = 0; s < 32; ++s) { const float v = vs[s][e_];
            for (int i = 0; i < 8; ++i) { of[i] += pf[rh * 8 + i][s] * v; ob[i] += pb[rh * 8 + i][s] * v; } }
    }
    __syncthreads();
    float* dens = &pf[0][0];
    if (tid < 32) dens[tid] = den;
    __syncthreads();
    if (lat) {
        const int b = (m0 - NP) / TS;
        const float* S0f = (type == 0 ? p.st_ret : p.st_C) + ((size_t)((b * 2 + 0) * 4 + h)) * 128 * 128;
        const float* S0b = (type == 0 ? p.st_ret : p.st_C) + ((size_t)((b * 2 + 1) * 4 + h)) * 128 * 128;
        for (int i = 0; i < 8; ++i) {
            const int r = rh * 8 + i, t = t0 + r;
            float af = 0.f, ab = 0.f;
            for (int d = 0; d < 128; ++d) { af += qs[r][d] * S0f[d * 128 + e_]; ab += qs[r][d] * S0b[d * 128 + e_]; }
            float cf, cb;
            if (type == 0) { cf = __expf(lgf * (float)(t + 1)); cb = __expf(lgb * (float)(T - t)); }
            else { cf = __expf(CU0[sb + t] + p.st_m[(b * 2 + 0) * 4 + h]); cb = __expf(CU1[sb + t] + p.st_m[(b * 2 + 1) * 4 + h]); }
            of[i] += cf * af; ob[i] += cb * ab;
        }
        if (type == 1 && tid < 32) {
            const int r = tid & 15, dir = tid >> 4, t = t0 + r;
            const float* n0 = p.st_n + (size_t)((b * 2 + dir) * 4 + h) * 128;
            float a = 0.f; for (int d = 0; d < 128; ++d) a += qs[r][d] * n0[d];
            const float cfb = __expf((dir == 0 ? CU0 : CU1)[sb + t] + p.st_m[(b * 2 + dir) * 4 + h]);
            dens[tid] += cfb * a;
        }
        __syncthreads();
    }
    for (int i = 0; i < 8; ++i) {
        const int r = rh * 8 + i;
        float o;
        if (type == 0) o = of[i] + ob[i];
        else o = of[i] / fmaxf(fabsf(dens[r]), 1.f) + ob[i] / fmaxf(fabsf(dens[16 + r]), 1.f);
        os[r][e_] = o;
    }
    __syncthreads();
    for (int i = 0; i < 8; ++i) {
        const int r = rh * 8 + i, m = m0 + r;
        float mu = 0.f; for (int d = 0; d < 128; ++d) mu += os[r][d];
        mu *= (1.f / 128.f);
        float var = 0.f; for (int d = 0; d < 128; ++d) { const float x = os[r][d] - mu; var += x * x; }
        var *= (1.f / 128.f);
        const float y = (os[r][e_] - mu) * rsqrtf(var + EPS);
        const float g = (type == 0 ? p.rgn : p.mgn)[h * HD + e_];
        const float gate = bf2f(((const bf16_t*)(p.ws + (type == 0 ? WS_RG : WS_MO)))[(size_t)m * W5 + h * HD + e_]);
        ((bf16_t*)(p.ws + WS_MIX))[(size_t)m * D + type * 512 + h * HD + e_] = f2bf(y * g * gate);
    }
}

__global__ void __launch_bounds__(256) k_states(P p) {
    __shared__ float ks[32][128], vs[32][128], ws_[256];
    __shared__ float red[4];
    const int tid = threadIdx.x, b = blockIdx.x, h = blockIdx.y, type = blockIdx.z >> 1, dir = blockIdx.z & 1;
    const int sb = b * TP;
    const bf16_t* Kp = (const bf16_t*)(p.ws + (type == 0 ? WS_RK : WS_MK));
    const bf16_t* V = (const bf16_t*)(p.ws + (type == 0 ? WS_RV : WS_MV));
    float mfin = 0.f;
    {
        const int s = tid; float lw;
        if (type == 0) { const float lg = logsigf(p.decay[dir * 4 + h]); lw = lg * (float)(dir == 0 ? TP - 1 - s : s); }
        else {
            const float* LI = (const float*)(p.ws + WS_GLI) + (size_t)(dir * 4 + h) * M;
            const float* CU = (const float*)(p.ws + WS_GCUM) + (size_t)(dir * 4 + h) * M;
            const float tot = CU[sb + (dir == 0 ? TP - 1 : 0)];
            lw = tot - CU[sb + s] + LI[sb + s];
            float mx = lw; for (int o = 32; o > 0; o >>= 1) mx = fmaxf(mx, __shfl_xor(mx, o));
            if ((tid & 63) == 0) red[tid >> 6] = mx;
            __syncthreads();
            mfin = fmaxf(fmaxf(fmaxf(red[0], red[1]), fmaxf(red[2], red[3])), tot);
            lw -= mfin;
        }
        ws_[s] = __expf(lw);
    }
    const int dk0 = (tid >> 4) * 8, dv0 = (tid & 15) * 8;
    float acc[8][8]; float nacc = 0.f;
    for (int i = 0; i < 8; ++i) for (int j = 0; j < 8; ++j) acc[i][j] = 0.f;
    for (int s0 = 0; s0 < TP; s0 += 32) {
        __syncthreads();
        for (int e = tid; e < 32 * 128; e += 256) { const int s = e >> 7, d = e & 127; const size_t a = (size_t)(sb + s0 + s) * W5 + h * HD + d;
            ks[s][d] = bf2f(Kp[a]); vs[s][d] = bf2f(V[a]); }
        __syncthreads();
        for (int s = 0; s < 32; ++s) {
            const float w = ws_[s0 + s];
            float kk[8], vv[8];
            for (int i = 0; i < 8; ++i) { kk[i] = ks[s][dk0 + i] * w; vv[i] = vs[s][dv0 + i]; }
            for (int i = 0; i < 8; ++i) for (int j = 0; j < 8; ++j) acc[i][j] += kk[i] * vv[j];
            if (tid < 128) nacc += w * ks[s][tid];
        }
    }
    float* O = p.out + (type == 0 ? O_RET : O_C) + (size_t)((b * 2 + dir) * 4 + h) * 128 * 128;
    for (int i = 0; i < 8; ++i) for (int j = 0; j < 8; ++j) O[(dk0 + i) * 128 + dv0 + j] = acc[i][j];
    if (type == 1) {
        if (tid < 128) p.out[O_N + (size_t)((b * 2 + dir) * 4 + h) * 128 + tid] = nacc;
        if (tid == 0) p.out[O_M + (b * 2 + dir) * 4 + h] = mfin;
    }
}

__global__ void k_final(P p) {
    __shared__ float red[4];
    const int m = blockIdx.x, tid = threadIdx.x;
    float* xr = p.out + O_Y + (size_t)m * D;
    float v[4], ss = 0.f;
    for (int i = 0; i < 4; ++i) { v[i] = xr[tid + 256 * i]; ss += v[i] * v[i]; }
    ss = block_sum256(ss, red);
    const float rstd = rsqrtf(ss * (1.f / D) + EPS);
    for (int i = 0; i < 4; ++i) xr[tid + 256 * i] = v[i] * rstd * p.fg[tid + 256 * i];
}


namespace pg8 {
#define PG8_LAS __attribute__((address_space(3)))
typedef short bf16x8 __attribute__((ext_vector_type(8)));
typedef float f32x4 __attribute__((ext_vector_type(4)));
typedef unsigned u32x4 __attribute__((ext_vector_type(4)));
constexpr int BM = 256, BK = 64, HALF = 128, HTB = HALF * BK * 2  , STAGE_BYTES = 8 * HTB, NXCD = 8, WGM = 8;

__host__ __device__ __forceinline__ int lds_byte(int r, int c) { const int st = (r >> 4) * 2 + (c >> 5), rr = r & 15, cc = c & 31, ob = rr * 64 + cc * 2; return st * 1024 + (ob ^ (((ob >> 9) & 1) << 5)); }
__host__ __device__ __forceinline__ void stage_rc(int b, int& R, int& C) { const int st = b / 1024, sb = b % 1024, swz = sb ^ (((sb >> 9) & 1) << 5); R = (st >> 1) * 16 + swz / 64; C = (st & 1) * 32 + (swz % 64) / 2; }
__host__ __device__ __forceinline__ int perm32(int rho) { const int n = rho >> 4, i = rho & 15; return 8 * (i >> 2) + 4 * n + (i & 3); }

struct Unit { int pm, pn; };
struct Gemm { const bf16_t* A; const bf16_t* Bt; int M, N, K; };

struct StaticOrder {
    int nM, nN, nwg, G, c;
    __host__ __device__ void init(int M, int N, int G_, int c_) { nM = M / BM; nN = N / BM; nwg = nM * nN; G = G_; c = c_; }
    __host__ __device__ bool next(int i, Unit& u) const {
        const long L = (long)i * G + c; if (L >= nwg) return false;
        int wgid = (int)L; { const int q = nwg / NXCD, r = nwg % NXCD, xcd = wgid % NXCD, off = wgid / NXCD; wgid = (xcd < r ? xcd * (q + 1) : r * (q + 1) + (xcd - r) * q) + off; }
        const int nig = WGM * nN, gid = wgid / nig, fm = gid * WGM, gsz = (nM - fm) < WGM ? (nM - fm) : WGM;
        u.pm = fm + ((wgid % nig) % gsz); u.pn = (wgid % nig) / gsz; return true;
    }
    __device__ __forceinline__ void a_ready(const Unit&) const {}
    __device__ __forceinline__ void done(const Unit&) const {}
};


__device__ __forceinline__ unsigned cvt_pk_bf16(float lo, float hi) { unsigned r; asm volatile("v_cvt_pk_bf16_f32 %0, %1, %2" : "=v"(r) : "v"(lo), "v"(hi)); return r; }
__device__ __forceinline__ u32x4 pack8(const f32x4& a, const f32x4& b) { u32x4 w; w.x = cvt_pk_bf16(a[0], a[1]); w.y = cvt_pk_bf16(a[2], a[3]); w.z = cvt_pk_bf16(b[0], b[1]); w.w = cvt_pk_bf16(b[2], b[3]); return w; }
__device__ __forceinline__ f32x4 silu4(const f32x4& v) { f32x4 o; for (int i = 0; i < 4; ++i) o[i] = v[i] / (1.f + __expf(-v[i])); return o; }
__device__ __forceinline__ f32x4 sigm4(const f32x4& v) { f32x4 o; for (int i = 0; i < 4; ++i) o[i] = 1.f / (1.f + __expf(-v[i])); return o; }

struct EpiProj {
    static constexpr bool PERM = true, PAIR = true, AFTER_DRAIN = false;
    unsigned char* ws; const float* rope;
    __device__ __forceinline__ void operator()(const f32x4 (&acc)[2][2][4][2], const Unit& u, int wr, int wc, int fr, int fq) const {
        const int sec = u.pn >> 1, hh = wc >> 1, dl = 32 * (wc & 1) + 8 * fq;
        bf16_t* dst; int ld, colb;
        if (sec == 4 || sec == 5) { dst = (bf16_t*)(ws + WS_MQKP); ld = 1024; colb = (u.pn - 8) * 256 + hh * 128; }
        else { const size_t off = sec == 0 ? WS_RQ : sec == 1 ? WS_RK : sec == 2 ? WS_RV : sec == 3 ? WS_RG : sec == 6 ? WS_MV : WS_MO;
               dst = (bf16_t*)(ws + off); ld = 512; colb = (u.pn & 1) * 256 + hh * 128; }
        const bool lat = u.pm >= NP / 256;
#pragma unroll
        for (int ai = 0; ai < 2; ++ai)
#pragma unroll
            for (int m = 0; m < 4; ++m) {
                const int row = u.pm * BM + ai * HALF + wr * 64 + m * 16 + fr;
                f32x4 a0 = acc[ai][0][m][0], a1 = acc[ai][0][m][1], b0 = acc[ai][1][m][0], b1 = acc[ai][1][m][1];
                if (sec <= 1) {
                    if (sec == 1) { a0 = a0 * 0.08838834764831845f; a1 = a1 * 0.08838834764831845f; b0 = b0 * 0.08838834764831845f; b1 = b1 * 0.08838834764831845f; }
                    if (lat) {
                        const int t = (row - NP) & (TS - 1), pos = (wc & 1) ? (t & 63) : (t >> 6);
                        const float* rp = rope + pos * 32 + 8 * fq;
                        const f32x4 c0 = *(const f32x4*)rp, c1 = *(const f32x4*)(rp + 4), s0 = *(const f32x4*)(rp + 2048), s1 = *(const f32x4*)(rp + 2052);
                        const f32x4 n0 = a0 * c0 - b0 * s0, n1 = a1 * c1 - b1 * s1, m0 = a0 * s0 + b0 * c0, m1 = a1 * s1 + b1 * c1;
                        a0 = n0; a1 = n1; b0 = m0; b1 = m1;
                    }
                } else if (sec == 3) { a0 = silu4(a0); a1 = silu4(a1); b0 = silu4(b0); b1 = silu4(b1); }
                else if (sec == 7) { a0 = sigm4(a0); a1 = sigm4(a1); b0 = sigm4(b0); b1 = sigm4(b1); }
                bf16_t* rp = dst + (size_t)row * ld + colb + dl;
                *(u32x4*)rp = pack8(a0, a1);
                *(u32x4*)(rp + 64) = pack8(b0, b1);
            }
    }
};
struct EpiRelu2 {
    static constexpr bool PERM = true, PAIR = false, AFTER_DRAIN = false;
    bf16_t* U;
    __device__ __forceinline__ void operator()(const f32x4 (&acc)[2][2][4][2], const Unit& u, int wr, int wc, int fr, int fq) const {
        const int row0 = u.pm * BM + wr * 64 + fr, col0 = u.pn * BM + wc * 32 + 8 * fq;
#pragma unroll
        for (int ai = 0; ai < 2; ++ai)
#pragma unroll
            for (int m = 0; m < 4; ++m) { bf16_t* rowp = U + (size_t)(row0 + ai * HALF + m * 16) * FF + col0;
#pragma unroll
                for (int bj = 0; bj < 2; ++bj) { f32x4 v0 = acc[ai][bj][m][0], v1 = acc[ai][bj][m][1];
                    for (int i = 0; i < 4; ++i) { const float x = fmaxf(v0[i], 0.f), y = fmaxf(v1[i], 0.f); v0[i] = x * x; v1[i] = y * y; }
                    *(u32x4*)(rowp + bj * HALF) = pack8(v0, v1); } }
    }
};
struct EpiRes {
    static constexpr bool PERM = false, PAIR = false, AFTER_DRAIN = false;
    const float* base_p; const float* base_s; float* out; const float* gate;
    __device__ __forceinline__ void operator()(const f32x4 (&acc)[2][2][4][2], const Unit& u, int wr, int wc, int fr, int fq) const {
        const int row0 = u.pm * BM + wr * 64 + fr, col0 = u.pn * BM + wc * 32 + 4 * fq;
        const int cnd = u.pm < NP / 256 ? 0 : 1 + (u.pm - NP / 256) / (TS / 256);
        const float* base = u.pm < NP / 256 ? base_p : base_s - (size_t)NP * D;
        f32x4 gv[2][2];
#pragma unroll
        for (int bj = 0; bj < 2; ++bj)
#pragma unroll
            for (int n = 0; n < 2; ++n) gv[bj][n] = *(const f32x4*)(gate + cnd * 6144 + col0 + bj * HALF + n * 16);
#pragma unroll
        for (int ai = 0; ai < 2; ++ai)
#pragma unroll
            for (int m = 0; m < 4; ++m) { const size_t off = (size_t)(row0 + ai * HALF + m * 16) * D + col0;
#pragma unroll
                for (int bj = 0; bj < 2; ++bj)
#pragma unroll
                    for (int n = 0; n < 2; ++n) { const f32x4 b = *(const f32x4*)(base + off + bj * HALF + n * 16);
                        *(f32x4*)(out + off + bj * HALF + n * 16) = b + gv[bj][n] * acc[ai][bj][m][n]; } }
    }
};
template <class Epi, class Sched, bool ALIGN_EPI = false, bool SP2 = false>
__device__ __forceinline__ void gemm_phase(PG8_LAS unsigned char* lds, const Gemm g, const Sched& S, const Epi& E) {
    const int tid = threadIdx.x, wid = __builtin_amdgcn_readfirstlane(tid >> 6), lane = tid & 63, wr = wid >> 2, wc = wid & 3, fr = lane & 15, fq = lane >> 4;
    const int K = g.K, nt = K / BK;
    unsigned voffA[2], voffB[2];
#pragma unroll
    for (int i = 0; i < 2; ++i) { int R, C; stage_rc(tid * 16 + i * 8192, R, C); int Rb = Epi::PERM ? ((R & ~31) + perm32(R & 31)) : R;
        if (Epi::PAIR) Rb = (Rb >> 6) * 128 + (Rb & 63);
        voffA[i] = (unsigned)(R * K + C) * 2u; voffB[i] = (unsigned)(Rb * K + C) * 2u; }
    const size_t kstep = (size_t)(BK * 2);
    const size_t hstep = (size_t)HALF * K * 2;
    const size_t hstepB = Epi::PAIR ? hstep / 2 : hstep;
    const size_t tstep = 2 * hstep;
    const unsigned ldsw = (unsigned)wid * 1024u;
    const int aoff = lds_byte(wr * 64 + fr, fq * 8), boff = lds_byte(wc * 32 + fr, fq * 8);
#define PG8_SA(b, h) (((b) * 2 + (h)) * HTB)
#define PG8_SB(b, h) ((4 + (b) * 2 + (h)) * HTB)
#define PG8_STAGE(bufoff, gbase, voff) do { _Pragma("unroll") for (int _i = 0; _i < 2; ++_i) \
        __builtin_amdgcn_global_load_lds((const unsigned*)((const char*)(gbase) + (voff)[_i]), (PG8_LAS unsigned*)(lds + (bufoff) + ldsw + _i * 8192), 16, 0, 0); } while (0)
#define PG8_LDA(dst, b, h) do { _Pragma("unroll") for (int m = 0; m < 4; ++m) _Pragma("unroll") for (int k = 0; k < 2; ++k) dst[m][k] = *(const PG8_LAS bf16x8*)(lds + PG8_SA(b, h) + aoff + m * 2048 + k * 1024); } while (0)
#define PG8_LDB(dst, b, h) do { _Pragma("unroll") for (int n = 0; n < 2; ++n) _Pragma("unroll") for (int k = 0; k < 2; ++k) dst[n][k] = *(const PG8_LAS bf16x8*)(lds + PG8_SB(b, h) + boff + n * 2048 + k * 1024); } while (0)
#define PG8_MMA(ai, bj, At, Bt) do { __builtin_amdgcn_s_setprio(1); _Pragma("unroll") for (int m = 0; m < 4; ++m) _Pragma("unroll") for (int n = 0; n < 2; ++n) _Pragma("unroll") for (int k = 0; k < 2; ++k) \
        acc[ai][bj][m][n] = __builtin_amdgcn_mfma_f32_16x16x32_bf16(Bt[n][k], At[m][k], acc[ai][bj][m][n], 0, 0, 0); __builtin_amdgcn_s_setprio(0); } while (0)
#define PG8_WAIT_V(n) asm volatile("s_waitcnt vmcnt(" #n ")" ::: "memory")
#define PG8_WAIT_L(n) asm volatile("s_waitcnt lgkmcnt(" #n ")" ::: "memory")
#define PG8_BAR __builtin_amdgcn_s_barrier()
#define PG8_SCHED __builtin_amdgcn_sched_barrier(0)
    Unit cur, nxt; int ui = 0;
    if (!S.next(0, cur)) return;
    f32x4 acc[2][2][4][2];
#pragma unroll
    for (int a = 0; a < 2; ++a)
#pragma unroll
        for (int b = 0; b < 2; ++b)
#pragma unroll
            for (int m = 0; m < 4; ++m)
#pragma unroll
                for (int n = 0; n < 2; ++n) acc[a][b][m][n] = (f32x4){0.f, 0.f, 0.f, 0.f};
    bf16x8 At[4][2], B0[2][2], B1[2][2];
    const char* cA = (const char*)g.A + (size_t)cur.pm * tstep; const char* cB = (const char*)g.Bt + (size_t)cur.pn * tstep;
    S.a_ready(cur);
    if constexpr (SP2) {
        PG8_STAGE(PG8_SB(0, 0), cB, voffB); PG8_STAGE(PG8_SB(0, 1), cB + hstepB, voffB); PG8_STAGE(PG8_SA(0, 0), cA, voffA); PG8_STAGE(PG8_SA(0, 1), cA + hstep, voffA);
        if (wr == 1) PG8_BAR;
        PG8_WAIT_V(2); PG8_BAR;
        PG8_STAGE(PG8_SB(1, 0), cB + kstep, voffB); PG8_STAGE(PG8_SA(1, 0), cA + kstep, voffA); PG8_STAGE(PG8_SB(1, 1), cB + hstepB + kstep, voffB);
        PG8_WAIT_V(6); PG8_BAR;
    } else {
        PG8_STAGE(PG8_SB(0, 0), cB, voffB); PG8_STAGE(PG8_SA(0, 0), cA, voffA); PG8_STAGE(PG8_SB(0, 1), cB + hstepB, voffB); PG8_STAGE(PG8_SA(0, 1), cA + hstep, voffA);
        if (wr == 1) PG8_BAR;
        PG8_WAIT_V(4); PG8_BAR;
        PG8_STAGE(PG8_SB(1, 0), cB + kstep, voffB); PG8_STAGE(PG8_SA(1, 0), cA + kstep, voffA); PG8_STAGE(PG8_SB(1, 1), cB + hstepB + kstep, voffB);
        PG8_WAIT_V(6); PG8_BAR;
    }
    for (;;) {
        const bool has_next = S.next(ui + 1, nxt);
        const char* nA = has_next ? (const char*)g.A + (size_t)nxt.pm * tstep : cA; const char* nB = has_next ? (const char*)g.Bt + (size_t)nxt.pn * tstep : cB;
        for (int t = 0; t < nt; t += 2) {
            const bool last = (t == nt - 2);
            const char* a1 = cA + (size_t)(t + 1) * kstep;
            const char* a2 = last ? nA : cA + (size_t)(t + 2) * kstep; const char* b2 = last ? nB : cB + (size_t)(t + 2) * kstep;
            const char* a3 = a2 + kstep; const char* b3 = b2 + kstep;
            if (last && has_next) S.a_ready(nxt);
            if constexpr (SP2) {
            PG8_LDB(B0, 0, 0); PG8_LDB(B1, 0, 1); PG8_SCHED; PG8_LDA(At, 0, 0); PG8_STAGE(PG8_SA(1, 1), a1 + hstep, voffA);
            PG8_WAIT_V(8); PG8_WAIT_L(0); PG8_BAR; PG8_MMA(0, 0, At, B0); PG8_MMA(0, 1, At, B1); PG8_BAR; PG8_SCHED;
            PG8_LDA(At, 0, 1); PG8_STAGE(PG8_SB(0, 0), b2, voffB); PG8_STAGE(PG8_SB(0, 1), b2 + hstepB, voffB); PG8_STAGE(PG8_SA(0, 0), a2, voffA);
            PG8_WAIT_V(8); PG8_WAIT_L(0); PG8_BAR; PG8_MMA(1, 0, At, B0); PG8_MMA(1, 1, At, B1); PG8_BAR; PG8_SCHED;
            PG8_LDB(B0, 1, 0); PG8_LDB(B1, 1, 1); PG8_SCHED; PG8_LDA(At, 1, 0); PG8_STAGE(PG8_SA(0, 1), a2 + hstep, voffA);
            PG8_WAIT_V(8); PG8_WAIT_L(0); PG8_BAR; PG8_MMA(0, 0, At, B0); PG8_MMA(0, 1, At, B1); PG8_BAR; PG8_SCHED;
            PG8_LDA(At, 1, 1); PG8_STAGE(PG8_SB(1, 0), b3, voffB); PG8_STAGE(PG8_SB(1, 1), b3 + hstepB, voffB); PG8_STAGE(PG8_SA(1, 0), a3, voffA);
            PG8_WAIT_V(8); PG8_WAIT_L(0); PG8_BAR; PG8_MMA(1, 0, At, B0); PG8_MMA(1, 1, At, B1); PG8_BAR; PG8_SCHED;
            } else {
            PG8_LDB(B0, 0, 0); PG8_SCHED; PG8_LDA(At, 0, 0); PG8_STAGE(PG8_SA(1, 1), a1 + hstep, voffA);
            PG8_WAIT_L(8); PG8_BAR; PG8_WAIT_L(0); PG8_MMA(0, 0, At, B0); PG8_BAR; PG8_SCHED;
            PG8_LDB(B1, 0, 1); PG8_STAGE(PG8_SB(0, 0), b2, voffB);
            PG8_BAR; PG8_WAIT_L(0); PG8_MMA(0, 1, At, B1); PG8_BAR;
            PG8_LDA(At, 0, 1); PG8_STAGE(PG8_SA(0, 0), a2, voffA);
            PG8_BAR; PG8_WAIT_L(0); PG8_MMA(1, 0, At, B0); PG8_BAR; PG8_SCHED;
            PG8_STAGE(PG8_SB(0, 1), b2 + hstepB, voffB);
            PG8_WAIT_V(6); PG8_BAR; PG8_MMA(1, 1, At, B1); PG8_BAR;
            PG8_LDB(B0, 1, 0); PG8_SCHED; PG8_LDA(At, 1, 0); PG8_STAGE(PG8_SA(0, 1), a2 + hstep, voffA);
            PG8_WAIT_L(8); PG8_BAR; PG8_WAIT_L(0); PG8_MMA(0, 0, At, B0); PG8_BAR; PG8_SCHED;
            PG8_LDB(B1, 1, 1); PG8_STAGE(PG8_SB(1, 0), b3, voffB);
            PG8_BAR; PG8_WAIT_L(0); PG8_MMA(0, 1, At, B1); PG8_BAR;
            PG8_LDA(At, 1, 1); PG8_STAGE(PG8_SA(1, 0), a3, voffA);
            PG8_BAR; PG8_WAIT_L(0); PG8_MMA(1, 0, At, B0); PG8_BAR; PG8_SCHED;
            PG8_STAGE(PG8_SB(1, 1), b3 + hstepB, voffB);
            PG8_WAIT_V(6); PG8_BAR; PG8_MMA(1, 1, At, B1); PG8_BAR;
            }
        }
        if constexpr (ALIGN_EPI) { if (wr == 0) PG8_BAR; }
        if constexpr (!Epi::AFTER_DRAIN) { E(acc, cur, wr, wc, fr, fq); S.done(cur); }
        if (!has_next) break;
#pragma unroll
        for (int a = 0; a < 2; ++a)
#pragma unroll
            for (int b = 0; b < 2; ++b)
#pragma unroll
                for (int m = 0; m < 4; ++m)
#pragma unroll
                    for (int n = 0; n < 2; ++n) acc[a][b][m][n] = (f32x4){0.f, 0.f, 0.f, 0.f};
        cur = nxt; cA = nA; cB = nB; ++ui;
        if constexpr (ALIGN_EPI) { if (wr == 1) PG8_BAR; }
    }
    PG8_WAIT_V(0);
    if constexpr (!ALIGN_EPI) { if (wr == 0) PG8_BAR; }
    PG8_BAR;
    if constexpr (Epi::AFTER_DRAIN) { E.fused(acc, cur, wr, wc, fr, fq, lds, wid, lane); S.done(cur); }
#undef PG8_SA
#undef PG8_SB
#undef PG8_STAGE
#undef PG8_LDA
#undef PG8_LDB
#undef PG8_MMA
#undef PG8_WAIT_V
#undef PG8_WAIT_L
#undef PG8_BAR
#undef PG8_SCHED
}
}


constexpr int NWAVES = 8;
constexpr int RING_OFF = 0, RING_BYTES = 131072;
constexpr int LDS_BYTES = 163840;
constexpr int LDSCTL_OFF = LDS_BYTES - 2048, MISC_OFF = LDSCTL_OFF + 320;
#define GAS __attribute__((address_space(1)))
#define LAS __attribute__((address_space(3)))
typedef unsigned v4u __attribute__((ext_vector_type(4)));
typedef float f32x4 __attribute__((ext_vector_type(4)));
typedef GAS unsigned gu32;
#define LDS_WAIT() asm volatile("s_waitcnt lgkmcnt(0)" ::: "memory")
#define VM_WAIT() asm volatile("s_waitcnt vmcnt(0)" ::: "memory")
constexpr int CW_BAR = 4096;
constexpr size_t CTL_ZERO_BYTES = 256 * 1024;

#define XB_TMO      128
#define XB_XCNT(j)  (256  + 64 * (j))
#define XB_XSUB(j)  (1280 + 64 * (j))
#define XB_XGEN(j)  (2304 + 64 * (j))
#define XB_TOP      3328
#define XB_TOPGEN   3392
#define XCD_BAR_WORDS 3456
#define XB_SPIN_CAP (1u << 18)
__device__ __forceinline__ unsigned xb_ld(unsigned* p)              { return __hip_atomic_load(p, __ATOMIC_RELAXED, __HIP_MEMORY_SCOPE_AGENT); }
__device__ __forceinline__ unsigned xb_add(unsigned* p, unsigned v) { return __hip_atomic_fetch_add(p, v, __ATOMIC_RELAXED, __HIP_MEMORY_SCOPE_AGENT); }
__device__ __forceinline__ unsigned xb_xcc_id() { return (unsigned)__builtin_amdgcn_s_getreg((3 << 11) | 20) & 0xFu; }
#define XB_SPIN(cond, bar) do { unsigned _sp = 0; while (cond) { __builtin_amdgcn_s_sleep(1); \
    if ((++_sp & 255u) == 0u) { if (xb_ld(&(bar)[XB_TMO])) break; if (_sp > XB_SPIN_CAP) { atomicAdd(&(bar)[XB_TMO], 1u); break; } } } } while (0)
struct XcdBarrier { unsigned* bar; unsigned x; volatile LAS unsigned* st; };
__device__ __forceinline__ XcdBarrier xcd_barrier_post(unsigned* bar, volatile LAS unsigned* st) {
    XcdBarrier b; b.bar = bar; b.x = xb_xcc_id(); b.st = st;
    if (threadIdx.x == 0) (void)xb_add(&bar[XB_XCNT(b.x)], 1u);
    return b;
}
__device__ __forceinline__ void xcd_barrier_complete(unsigned* bar, unsigned x, unsigned& nloc, unsigned& nx) {
    const unsigned G = gridDim.x * gridDim.y * gridDim.z;
    unsigned sum, cnt, mine, sp = 0u;
    for (;;) {
        sum = 0u; cnt = 0u; mine = 0u;
#pragma unroll
        for (unsigned j = 0; j < 16; ++j) { const unsigned c = xb_ld(&bar[XB_XCNT(j)]); sum += c; cnt += (c > 0u) ? 1u : 0u; mine = (j == x) ? c : mine; }
        if (sum == G) break;
        __builtin_amdgcn_s_sleep(1);
        if ((++sp & 255u) == 0u) { if (xb_ld(&bar[XB_TMO])) break; if (sp > XB_SPIN_CAP) { atomicAdd(&bar[XB_TMO], 1u); break; } }
    }
    nloc = mine > 0u ? mine : 1u; nx = cnt > 0u ? cnt : 1u;
}
__device__ __forceinline__ void xcd_barrier(const XcdBarrier& b) {
    asm volatile("s_waitcnt vmcnt(0)" ::: "memory");
    __syncthreads();
    if (threadIdx.x == 0) {
        unsigned* bar = b.bar;
        __builtin_amdgcn_s_waitcnt(0);
        unsigned nloc = b.st[0], nx = b.st[1];
        if (nloc == 0u) { xcd_barrier_complete(bar, b.x, nloc, nx); b.st[0] = nloc; b.st[1] = nx; }
        const unsigned old = xb_add(&bar[XB_XSUB(b.x)], 1u);
        const unsigned gen = old / nloc;
        if (old + 1u == (gen + 1u) * nloc) {
            __builtin_amdgcn_fence(__ATOMIC_RELEASE, "agent");
            asm volatile("s_waitcnt vmcnt(0)" ::: "memory");
            const unsigned og = xb_add(&bar[XB_TOP], 1u);
            const unsigned tg = og / nx;
            if (og + 1u == (tg + 1u) * nx) xb_add(&bar[XB_TOPGEN], 1u);
            else XB_SPIN(xb_ld(&bar[XB_TOPGEN]) == tg, bar);
            __builtin_amdgcn_fence(__ATOMIC_ACQUIRE, "agent");
            xb_add(&bar[XB_XGEN(b.x)], 1u);
            asm volatile("s_waitcnt vmcnt(0)" ::: "memory");
        } else {
            XB_SPIN(xb_ld(&bar[XB_XGEN(b.x)]) == gen, bar);
            __builtin_amdgcn_fence(__ATOMIC_ACQUIRE, "agent");
            asm volatile("s_waitcnt vmcnt(0)" ::: "memory");
        }
    }
    __syncthreads();
}

struct Frame {
    LAS unsigned char* lds; volatile LAS unsigned* MISC; gu32* ctl;
    int tid, lane, wave, vcu, G;
};
__device__ __forceinline__ float wave_sum(float v) {
#pragma unroll
    for (int o = 1; o < 64; o <<= 1) v += __shfl_xor(v, o);
    return v;
}
__device__ __forceinline__ unsigned pk2(float lo, float hi) { return (unsigned)f2bf(lo) | ((unsigned)f2bf(hi) << 16); }
__device__ __forceinline__ void p0_transpose_item(const float* W, int K, int N, int ldw, bf16_t* WT, LAS float* scr, int item, int lane) {
    const int nblk = N / 32, kb = item / nblk, nb = item % nblk, k0 = 64 * kb, n0 = 32 * nb;
#pragma unroll 8
    for (int i = 0; i < 32; ++i) { const int kk = 2 * i + (lane >> 5); scr[kk * 33 + (lane & 31)] = W[(size_t)(k0 + kk) * ldw + n0 + (lane & 31)]; }
    LDS_WAIT(); asm volatile("" ::: "memory");
    const int c = lane & 7;
#pragma unroll
    for (int j = 0; j < 4; ++j) { const int n = (lane >> 3) + 8 * j; const LAS float* s = scr + (8 * c) * 33 + n;
        v4u o; o.x = pk2(s[0 * 33], s[1 * 33]); o.y = pk2(s[2 * 33], s[3 * 33]); o.z = pk2(s[4 * 33], s[5 * 33]); o.w = pk2(s[6 * 33], s[7 * 33]);
        *(GAS v4u*)(WT + (size_t)(n0 + n) * K + k0 + 8 * c) = o; }
    LDS_WAIT(); asm volatile("" ::: "memory");
}

struct Args { const float* in[22]; float* out; unsigned char* ws; int ph_lo, ph_hi, li, pad; };

__device__ __forceinline__ void p0_prologue(Frame& F, const Args& a) {
    unsigned char* ws = a.ws;
    if (F.vcu < 96) {
        LAS float* sc = (LAS float*)(F.lds + RING_OFF + 8 * 16384);
        LAS float* part = sc + 3 * 1024;
        for (int e = F.tid; e < 3 * D; e += NWAVES * 64) { const int c = e >> 10, k = e & 1023; sc[e] = siluf(c == 0 ? a.in[7][k] : a.in[6][(c - 1) * D + k]); }
        __syncthreads();
        const int j = F.vcu * 64 + F.lane, k0 = F.wave * 128;
        const float* wa = a.in[8] + (size_t)k0 * 6144 + j;
        float a0 = 0.f, a1 = 0.f, a2 = 0.f;
#pragma unroll 16
        for (int k = 0; k < 128; ++k) { const float w = wa[(size_t)k * 6144]; a0 += sc[k0 + k] * w; a1 += sc[1024 + k0 + k] * w; a2 += sc[2048 + k0 + k] * w; }
        part[(F.wave * 3 + 0) * 64 + F.lane] = a0; part[(F.wave * 3 + 1) * 64 + F.lane] = a1; part[(F.wave * 3 + 2) * 64 + F.lane] = a2;
        __syncthreads();
        if (F.tid < 192) { const int c = F.tid >> 6, l = F.tid & 63; float t = 0.f;
#pragma unroll
            for (int w = 0; w < 8; ++w) t += part[(w * 3 + c) * 64 + l];
            ((float*)(ws + WS_MOD))[c * 6144 + F.vcu * 64 + l] = t + a.in[9][F.vcu * 64 + l]; }
        __syncthreads();
    }
    if (F.vcu == 100) {
        for (int e = F.tid; e < 2048; e += NWAVES * 64) { const int pos = e >> 5, f = e & 31;
            const float inv = exp2f(-(float)f * (13.287712379549449f / 32.f)); const float ang = (float)pos * inv;
            float sn, cs; sincosf(ang, &sn, &cs);
            float* rc = (float*)(ws + WS_ROPE); rc[e] = cs; rc[2048 + e] = sn; }
    }
    LAS float* scr = (LAS float*)(F.lds + RING_OFF + F.wave * 16384);
    const int gw = F.vcu * NWAVES + F.wave, NGW = F.G * NWAVES;
    constexpr int I_IN = (D / 64) * (4096 / 32), I_O = (D / 64) * (D / 32), I_1 = (D / 64) * (FF / 32), I_2 = (FF / 64) * (D / 32);
    constexpr int NITEMS = I_IN + I_O + I_1 + I_2;
    for (int it = NITEMS - 1 - gw; it >= 0; it -= NGW) {
        int r = it;
        if (r < I_IN) { p0_transpose_item(a.in[12], D, 4096, INC, (bf16_t*)(ws + WS_WIN), scr, r, F.lane); continue; } r -= I_IN;
        if (r < I_O) { p0_transpose_item(a.in[18], D, D, D, (bf16_t*)(ws + WS_WOUT), scr, r, F.lane); continue; } r -= I_O;
        if (r < I_1) { p0_transpose_item(a.in[19], D, FF, FF, (bf16_t*)(ws + WS_W1), scr, r, F.lane); continue; } r -= I_1;
        p0_transpose_item(a.in[20], FF, D, D, (bf16_t*)(ws + WS_W2), scr, r, F.lane);
    }
}

__device__ __forceinline__ void p1_norm_gates(Frame& F, const Args& a) {
    LAS float* wg = (LAS float*)(F.lds + RING_OFF);
    for (int e = F.tid; e < 1024 * 16; e += NWAVES * 64) { const int k = e >> 4, j = e & 15; wg[k * 20 + j] = a.in[12][(size_t)k * INC + 4096 + j]; }
    __syncthreads();
    const int gw = F.vcu * NWAVES + F.wave, NGW = F.G * NWAVES, lane = F.lane;
    const float* mod = (const float*)(a.ws + WS_MOD);
    float A1[16], S1[16]; int cur = -1;
    for (int m = gw; m < M; m += NGW) {
        const int cnd = cond_of(m);
        if (cnd != cur) { cur = cnd;
#pragma unroll
            for (int i = 0; i < 16; ++i) { const int k = lane + 64 * i; A1[i] = a.in[10][k] * (1.f + mod[cnd * 6144 + 1024 + k]); S1[i] = mod[cnd * 6144 + k]; } }
        const float* xr = m < NP ? a.in[0] + (size_t)m * D : a.in[1] + (size_t)(m - NP) * D;
        float v[16]; float ss = 0.f;
#pragma unroll
        for (int i = 0; i < 16; ++i) { v[i] = xr[lane + 64 * i]; ss += v[i] * v[i]; }
        ss = wave_sum(ss);
        const float rstd = rsqrtf(ss * (1.f / D) + EPS);
        bf16_t* H = (bf16_t*)(a.ws + WS_H) + (size_t)m * D;
        float ga[16];
#pragma unroll
        for (int j = 0; j < 16; ++j) ga[j] = 0.f;
#pragma unroll
        for (int i = 0; i < 16; ++i) {
            const float h = v[i] * rstd * A1[i] + S1[i];
            H[lane + 64 * i] = f2bf(h);
            const LAS f32x4* wr = (const LAS f32x4*)(wg + (lane + 64 * i) * 20);
            const f32x4 w0 = wr[0], w1 = wr[1], w2 = wr[2], w3 = wr[3];
#pragma unroll
            for (int j = 0; j < 4; ++j) { ga[j] += h * w0[j]; ga[4 + j] += h * w1[j]; ga[8 + j] += h * w2[j]; ga[12 + j] += h * w3[j]; }
            if (i & 1) asm volatile("" ::: "memory");
        }
        { const bool hi = lane & 32;
#pragma unroll
          for (int j = 0; j < 8; ++j) { const float keep = hi ? ga[j + 8] : ga[j], give = hi ? ga[j] : ga[j + 8]; ga[j] = keep + __shfl_xor(give, 32); } }
        { const bool hi = lane & 16;
#pragma unroll
          for (int j = 0; j < 4; ++j) { const float keep = hi ? ga[j + 4] : ga[j], give = hi ? ga[j] : ga[j + 4]; ga[j] = keep + __shfl_xor(give, 16); } }
        { const bool hi = lane & 8;
#pragma unroll
          for (int j = 0; j < 2; ++j) { const float keep = hi ? ga[j + 2] : ga[j], give = hi ? ga[j] : ga[j + 2]; ga[j] = keep + __shfl_xor(give, 8); } }
        { const bool hi = lane & 4; const float keep = hi ? ga[1] : ga[0], give = hi ? ga[0] : ga[1]; ga[0] = keep + __shfl_xor(give, 4); }
        ga[0] += __shfl_xor(ga[0], 2); ga[0] += __shfl_xor(ga[0], 1);
        if ((lane & 3) == 0) ((float*)(a.ws + WS_GATES))[(size_t)m * 16 + (lane >> 2)] = ga[0] + a.in[15][lane >> 2];
    }
}


__device__ __forceinline__ void p3_conv_cumsum(Frame& F, const Args& a) {
    unsigned char* ws = a.ws;
    const int gw = F.vcu * NWAVES + F.wave, NGW = F.G * NWAVES, lane = F.lane;
    if (gw < 34 * 8) {
        const int seq = gw >> 3, dir = (gw >> 2) & 1, h = gw & 3;
        const int T = seq < 32 ? TP : TS, mbase = seq < 32 ? seq * TP : NP + (seq - 32) * TS, per = T / 64;
        const float* G = (const float*)(ws + WS_GATES);
        float* LI = (float*)(ws + WS_GLI) + (size_t)(dir * 4 + h) * M;
        float* CU = (float*)(ws + WS_GCUM) + (size_t)(dir * 4 + h) * M;
        float tot = 0.f;
        for (int i = 0; i < per; ++i) { const int p = lane * per + i, m = mbase + (dir == 0 ? p : T - 1 - p); tot += logsigf(G[(size_t)m * 16 + dir * 8 + 4 + h]); }
        float incl = tot;
#pragma unroll
        for (int o = 1; o < 64; o <<= 1) { const float v = __shfl_up(incl, o); if (lane >= o) incl += v; }
        float cum = incl - tot;
        for (int i = 0; i < per; ++i) { const int p = lane * per + i, m = mbase + (dir == 0 ? p : T - 1 - p);
            cum += logsigf(G[(size_t)m * 16 + dir * 8 + 4 + h]); CU[m] = cum; LI[m] = G[(size_t)m * 16 + dir * 8 + h]; }
    }
    const bf16_t* X = (const bf16_t*)(ws + WS_MQKP);
    float cw[2][3][8];
#pragma unroll
    for (int i = 0; i < 2; ++i)
#pragma unroll
        for (int j = 0; j < 3; ++j)
#pragma unroll
            for (int e = 0; e < 8; ++e) cw[i][j][e] = a.in[13][j * 1024 + (lane + 64 * i) * 8 + e];
    for (int m = gw; m < M; m += NGW) {
        const int T = m < NP ? TP : TS, t = m < NP ? (m & (TP - 1)) : ((m - NP) & (TS - 1));
#pragma unroll
        for (int i = 0; i < 2; ++i) {
            const size_t off = (size_t)m * 1024 + (lane + 64 * i) * 8;
            const v4u x1 = *(const v4u*)(X + off);
            v4u x0 = {0u, 0u, 0u, 0u}, x2 = {0u, 0u, 0u, 0u};
            if (t > 0) x0 = *(const v4u*)(X + off - 1024);
            if (t < T - 1) x2 = *(const v4u*)(X + off + 1024);
            float o[8];
#pragma unroll
            for (int e = 0; e < 8; ++e) {
                const unsigned w0 = x0[e >> 1], w1 = x1[e >> 1], w2 = x2[e >> 1];
                const float f0 = __uint_as_float((e & 1) ? (w0 & 0xffff0000u) : (w0 << 16)), f1 = __uint_as_float((e & 1) ? (w1 & 0xffff0000u) : (w1 << 16)), f2 = __uint_as_float((e & 1) ? (w2 & 0xffff0000u) : (w2 << 16));
                float v = cw[i][0][e] * f0 + cw[i][1][e] * f1 + cw[i][2][e] * f2;
                v = siluf(v);
                o[e] = i == 0 ? v : v * 0.08838834764831845f;
            }
            v4u w; w.x = pk2(o[0], o[1]); w.y = pk2(o[2], o[3]); w.z = pk2(o[4], o[5]); w.w = pk2(o[6], o[7]);
            *(v4u*)((bf16_t*)(ws + (i == 0 ? WS_MQ : WS_MK)) + (size_t)m * W5 + lane * 8) = w;
        }
    }
}

typedef short bf16x8 __attribute__((ext_vector_type(8)));
typedef short s16x4 __attribute__((ext_vector_type(4)));
typedef short v4i16_t __attribute__((ext_vector_type(4)));
typedef float f32x16 __attribute__((ext_vector_type(16)));
typedef float f32x2_t __attribute__((ext_vector_type(2)));
typedef __bf16 bf16x2_t __attribute__((ext_vector_type(2)));
#define MFMA32(a_, b_, c_) __builtin_amdgcn_mfma_f32_32x32x16_bf16((a_), (b_), (c_), 0, 0, 0)
constexpr int RS = 272, TRS = 320;
constexpr int MX_QS = 0, MX_KS = 34816, MX_VS = 75776, MX_PX = 116736, MX_SM = 149504;
constexpr int MX_CF = MX_SM, MX_CB = MX_SM + 512, MX_DEN = MX_SM + 1024, MX_ST = MX_SM + 3072, MX_W = MX_SM + 5120, MX_RED = MX_SM + 7168;
static_assert(MX_RED + 64 <= LDSCTL_OFF && MX_KS + 128 * TRS <= MX_VS && MX_VS + 128 * TRS <= MX_PX && MX_PX + 32768 <= MX_SM, "mixer LDS map");
__device__ __forceinline__ unsigned cvtpk(float lo, float hi) { f32x2_t v = {lo, hi}; bf16x2_t b = __builtin_convertvector(v, bf16x2_t); return __builtin_bit_cast(unsigned, b); }
__device__ __forceinline__ s16x4 vtr(const LAS unsigned char* p) { return __builtin_bit_cast(s16x4, __builtin_amdgcn_ds_read_tr16_b64_v4i16((LAS v4i16_t*)p)); }
#define ROW_FRAG(base_r, row0, ks) (*(const LAS bf16x8*)((base_r) + (row0) * RS + (ks) * 32))
__device__ __forceinline__ bf16x8 tr_frag2(const LAS unsigned char* base_t, int off0, int off1) {
    const s16x4 lo = vtr(base_t + off0), hi = vtr(base_t + off1);
    return __builtin_shufflevector(lo, hi, 0, 1, 2, 3, 4, 5, 6, 7);
}
#define TR_FRAG(base_t, r0, r1, c) tr_frag2((base_t), (r0) * TRS + (c) * 64, (r1) * TRS + (c) * 64)
__device__ __forceinline__ void stage_tile(LAS unsigned char* dst, int rs, const bf16_t* src, int ld, int tid) {
#pragma unroll
    for (int i = 0; i < 4; ++i) { const int n = tid + 512 * i, row = n >> 4, ch = n & 15;
        const v4u v = *(const v4u*)(src + (size_t)row * ld + ch * 8);
        *(LAS v4u*)(dst + row * rs + ch * 16) = v; }
}
__device__ __forceinline__ void stage_tile_f32(LAS unsigned char* dst, const float* src, int tid) {
#pragma unroll
    for (int i = 0; i < 4; ++i) { const int n = tid + 512 * i, row = n >> 4, ch = n & 15;
        const f32x4 x = *(const f32x4*)(src + row * 128 + ch * 8), y = *(const f32x4*)(src + row * 128 + ch * 8 + 4);
        v4u v; v.x = cvtpk(x[0], x[1]); v.y = cvtpk(x[2], x[3]); v.z = cvtpk(y[0], y[1]); v.w = cvtpk(y[2], y[3]);
        *(LAS v4u*)(dst + row * TRS + ch * 16) = v; }
}

struct MixSrc { const bf16_t *Q, *K, *V, *GT; const float *cumF, *liF, *cumB, *liB, *gain; float lgf, lgb; };

__device__ __forceinline__ void mix_pv(f32x16 (&O)[2], const LAS unsigned char* vbase, const LAS unsigned char* pxbase) {
#pragma unroll
    for (int khp = 0; khp < 2; ++khp)
#pragma unroll
        for (int f = 0; f < 4; ++f) {
            const bf16x8 pb = *(const LAS bf16x8*)(pxbase + (khp * 4 + f) * 1024);
            const int kb0 = 64 * khp + 32 * (f >> 1) + 16 * (f & 1);
#pragma unroll
            for (int eb = 0; eb < 2; ++eb) O[eb] = MFMA32(TR_FRAG(vbase, kb0, kb0 + 8, eb), pb, O[eb]);
            if (f & 1) asm volatile("" ::: "memory");
        }
}

__device__ __forceinline__ void mix_attn_item(Frame& F, const Args& a, const MixSrc& X, int type, int seq, int h, int qt) {
    LAS unsigned char* lds = F.lds;
    int tid = F.tid; asm volatile("" : "+v"(tid));
    const int lane = tid & 63, wave = F.wave, rg = wave >> 1, kh = wave & 1, c31 = lane & 31, hh = lane >> 5;
    const int T = seq < 32 ? TP : TS, sb = seq < 32 ? seq * TP : NP + (seq - 32) * TS, nk = T / 128;
    const int t_rel = 32 * rg + c31, t_seq = 128 * qt + t_rel, m_t = sb + t_seq;
    LAS float* CF = (LAS float*)(lds + MX_CF); LAS float* CB = (LAS float*)(lds + MX_CB);
    const LAS unsigned char* qbase = lds + MX_QS + (32 * rg + c31) * RS + hh * 16;
    const LAS unsigned char* kbase = lds + MX_KS + (64 * kh + c31) * RS + hh * 16;
    const int trl = ((lane & 15) >> 2) * TRS + ((lane >> 4) & 1) * 32 + (lane & 3) * 8;
    const LAS unsigned char* vbase = lds + MX_VS + trl + hh * 4 * TRS + kh * 128;
    const LAS unsigned char* vnat = lds + MX_VS + trl + hh * 8 * TRS + kh * 128;
    LAS unsigned char* pxw = lds + MX_PX + wave * 4096 + lane * 16;
    const LAS unsigned char* pxr = lds + MX_PX + (wave & ~1) * 4096 + lane * 16;
    float cumF_t, cumB_t, refF, refB;
    if (type == 1) { cumF_t = X.cumF[m_t]; cumB_t = X.cumB[m_t]; refF = qt == 0 ? 0.f : X.cumF[sb + 128 * qt - 1]; refB = qt == nk - 1 ? 0.f : X.cumB[sb + 128 * (qt + 1)]; }
    else { cumF_t = X.lgf * (float)(t_seq + 1); cumB_t = X.lgb * (float)(T - t_seq); refF = X.lgf * (float)(128 * qt); refB = X.lgb * (float)(T - 128 * (qt + 1)); }
    f32x16 Of[2], Ob[2];
#pragma unroll
    for (int e = 0; e < 2; ++e)
#pragma unroll
        for (int r = 0; r < 16; ++r) { Of[e][r] = 0.f; Ob[e][r] = 0.f; }
    float denf = 0.f, denb = 0.f;
    __syncthreads();
    stage_tile(lds + MX_QS, RS, X.Q + (size_t)(sb + 128 * qt) * W5 + h * HD, W5, tid);
    if (seq >= 32) {
        const int b = seq - 32;
        const float* S0 = (type == 0 ? a.in[2] : a.in[3]) + (size_t)((b * 2) * 4 + h) * 16384;
        stage_tile_f32(lds + MX_VS, S0, tid);
        { const int row = tid >> 4, ch = tid & 15; v4u v = {0u, 0u, 0u, 0u};
          if (type == 1 && row < 2) { const float* n0 = a.in[4] + (size_t)((b * 2 + row) * 4 + h) * 128 + ch * 8; v.x = cvtpk(n0[0], n0[1]); v.y = cvtpk(n0[2], n0[3]); v.z = cvtpk(n0[4], n0[5]); v.w = cvtpk(n0[6], n0[7]); }
          *(LAS v4u*)(lds + MX_KS + row * RS + ch * 16) = v; }
        const float m0f = type == 1 ? a.in[5][(b * 2 + 0) * 4 + h] : 0.f, m0b = type == 1 ? a.in[5][(b * 2 + 1) * 4 + h] : 0.f;
        const float scF = __expf(refF + m0f), scB = __expf(refB + m0b);
        __syncthreads();
        f32x16 Sx;
#pragma unroll
        for (int r = 0; r < 16; ++r) Sx[r] = 0.f;
        const LAS unsigned char* nbase = lds + MX_KS + c31 * RS + hh * 16;
#pragma unroll
        for (int ks = 0; ks < 8; ++ks) {
            const bf16x8 qf = ROW_FRAG(qbase, 0, ks);
            Sx = MFMA32(ROW_FRAG(nbase, 0, ks), qf, Sx);
#pragma unroll
            for (int eb = 0; eb < 2; ++eb) Of[eb] = MFMA32(TR_FRAG(vnat, 16 * ks, 16 * ks + 4, eb), qf, Of[eb]);
            if (ks & 1) asm volatile("" ::: "memory");
        }
        if (kh == 0 && hh == 0) { denf = scF * Sx[0]; denb = scB * Sx[1]; }
#pragma unroll
        for (int eb = 0; eb < 2; ++eb) Of[eb] = Of[eb] * scF;
        __syncthreads();
        stage_tile_f32(lds + MX_VS, S0 + 4 * 16384, tid);
        __syncthreads();
#pragma unroll
        for (int ks = 0; ks < 8; ++ks) {
            const bf16x8 qf = ROW_FRAG(qbase, 0, ks);
#pragma unroll
            for (int eb = 0; eb < 2; ++eb) Ob[eb] = MFMA32(TR_FRAG(vnat, 16 * ks, 16 * ks + 4, eb), qf, Ob[eb]);
            if (ks & 1) asm volatile("" ::: "memory");
        }
#pragma unroll
        for (int eb = 0; eb < 2; ++eb) Ob[eb] = Ob[eb] * scB;
        __syncthreads();
    }
    f32x16 S[2];
#define MIX_STAGE_SCORES(j_, mode_) do { \
        stage_tile(lds + MX_KS, RS, X.K + (size_t)(sb + 128 * (j_)) * W5 + h * HD, W5, tid); \
        stage_tile(lds + MX_VS, TRS, X.V + (size_t)(sb + 128 * (j_)) * W5 + h * HD, W5, tid); \
        if (tid < 128) { \
            const int ts = 128 * (j_) + tid, ms = sb + ts; \
            float aF, aB; \
            if (type == 1) { aF = X.liF[ms] - X.cumF[ms]; aB = X.liB[ms] - X.cumB[ms]; } \
            else { aF = -X.lgf * (float)(ts + 1); aB = -X.lgb * (float)(T - ts); } \
            if ((mode_) == 0) CF[tid] = __expf(refF + aF); \
            else if ((mode_) == 1) CF[tid] = __expf(refB + aB); \
            else { CF[tid] = aF; CB[tid] = aB; } \
        } \
        __syncthreads(); \
        _Pragma("unroll") for (int kb = 0; kb < 2; ++kb) _Pragma("unroll") for (int r = 0; r < 16; ++r) S[kb][r] = 0.f; \
        _Pragma("unroll") for (int ks = 0; ks < 8; ++ks) { \
            const bf16x8 qf = ROW_FRAG(qbase, 0, ks); \
            _Pragma("unroll") for (int kb = 0; kb < 2; ++kb) S[kb] = MFMA32(ROW_FRAG(kbase, 32 * kb, ks), qf, S[kb]); \
            if (ks & 1) asm volatile("" ::: "memory"); \
        } } while (0)
    const LAS float* cfl = CF + 64 * kh + 4 * hh; const LAS float* cbl = CB + 64 * kh + 4 * hh;
    for (int step = 0; step < nk - 1; ++step) {
        const int j = step < qt ? step : nk - 1 - (step - qt);
        const int mode = j < qt ? 0 : 1;
        MIX_STAGE_SCORES(j, mode);
        float dsum = 0.f;
#pragma unroll
        for (int f = 0; f < 4; ++f) {
            v4u w;
#pragma unroll
            for (int g2 = 0; g2 < 2; ++g2) { const int g = 2 * (f & 1) + g2; const f32x4 c = *(const LAS f32x4*)(cfl + 32 * (f >> 1) + 8 * g);
                const float p0 = S[f >> 1][4 * g + 0] * c[0], p1 = S[f >> 1][4 * g + 1] * c[1], p2 = S[f >> 1][4 * g + 2] * c[2], p3 = S[f >> 1][4 * g + 3] * c[3];
                dsum += (p0 + p1) + (p2 + p3);
                if (g2 == 0) { w.x = cvtpk(p0, p1); w.y = cvtpk(p2, p3); } else { w.z = cvtpk(p0, p1); w.w = cvtpk(p2, p3); } }
            *(LAS v4u*)(pxw + f * 1024) = w;
        }
        __syncthreads();
        if (mode == 0) { denf += dsum; mix_pv(Of, vbase, pxr); } else { denb += dsum; mix_pv(Ob, vbase, pxr); }
        __syncthreads();
    }
    {
        const float rf = __expf(cumF_t - refF), rb = __expf(cumB_t - refB);
#pragma unroll
        for (int eb = 0; eb < 2; ++eb) { Of[eb] = Of[eb] * rf; Ob[eb] = Ob[eb] * rb; }
        denf *= rf; denb *= rb;
        MIX_STAGE_SCORES(qt, 2);
        int t_loc = t_rel; asm volatile("" : "+v"(t_loc));
#pragma unroll
        for (int dirp = 0; dirp < 2; ++dirp) {
            float dsum = 0.f;
#pragma unroll
            for (int f = 0; f < 4; ++f) {
                v4u w;
#pragma unroll
                for (int g2 = 0; g2 < 2; ++g2) { const int g = 2 * (f & 1) + g2, s0 = 64 * kh + 32 * (f >> 1) + 8 * g + 4 * hh;
                    const f32x4 c = *(const LAS f32x4*)((dirp == 0 ? cfl : cbl) + 32 * (f >> 1) + 8 * g);
                    float pv[4];
#pragma unroll
                    for (int i = 0; i < 4; ++i) { const bool on = dirp == 0 ? (s0 + i) <= t_loc : (s0 + i) >= t_loc;
                        const float wgt = on ? __expf((dirp == 0 ? cumF_t : cumB_t) + c[i]) : 0.f; pv[i] = S[f >> 1][4 * g + i] * wgt; dsum += pv[i]; }
                    if (g2 == 0) { w.x = cvtpk(pv[0], pv[1]); w.y = cvtpk(pv[2], pv[3]); } else { w.z = cvtpk(pv[0], pv[1]); w.w = cvtpk(pv[2], pv[3]); } }
                *(LAS v4u*)(pxw + f * 1024) = w;
            }
            __syncthreads();
            if (dirp == 0) { denf += dsum; mix_pv(Of, vbase, pxr); } else { denb += dsum; mix_pv(Ob, vbase, pxr); }
            __syncthreads();
        }
    }
#undef MIX_STAGE_SCORES
    LAS float* DEN = (LAS float*)(lds + MX_DEN); LAS float* ST = (LAS float*)(lds + MX_ST);
    float hv[2][16];
    if (type == 1) {
        denf += __shfl_xor(denf, 32); denb += __shfl_xor(denb, 32);
        if (hh == 0) { DEN[(wave * 2 + 0) * 32 + c31] = denf; DEN[(wave * 2 + 1) * 32 + c31] = denb; }
        __syncthreads();
        denf += DEN[((wave ^ 1) * 2 + 0) * 32 + c31]; denb += DEN[((wave ^ 1) * 2 + 1) * 32 + c31];
        const float inf_ = 1.f / fmaxf(fabsf(denf), 1.f), inb_ = 1.f / fmaxf(fabsf(denb), 1.f);
#pragma unroll
        for (int eb = 0; eb < 2; ++eb)
#pragma unroll
            for (int r = 0; r < 16; ++r) hv[eb][r] = Of[eb][r] * inf_ + Ob[eb][r] * inb_;
    } else {
#pragma unroll
        for (int eb = 0; eb < 2; ++eb)
#pragma unroll
            for (int r = 0; r < 16; ++r) hv[eb][r] = Of[eb][r] + Ob[eb][r];
    }
    float s1 = 0.f;
#pragma unroll
    for (int eb = 0; eb < 2; ++eb)
#pragma unroll
        for (int r = 0; r < 16; ++r) s1 += hv[eb][r];
    s1 += __shfl_xor(s1, 32);
    if (hh == 0) ST[(wave * 2 + 0) * 32 + c31] = s1;
    __syncthreads();
    const float mean = (s1 + ST[((wave ^ 1) * 2 + 0) * 32 + c31]) * (1.f / 128.f);
    float s2 = 0.f;
#pragma unroll
    for (int eb = 0; eb < 2; ++eb)
#pragma unroll
        for (int r = 0; r < 16; ++r) { hv[eb][r] -= mean; s2 += hv[eb][r] * hv[eb][r]; }
    s2 += __shfl_xor(s2, 32);
    if (hh == 0) ST[(wave * 2 + 1) * 32 + c31] = s2;
    __syncthreads();
    const float rstd = rsqrtf((s2 + ST[((wave ^ 1) * 2 + 1) * 32 + c31]) * (1.f / 128.f) + EPS);
    bf16_t* outp = (bf16_t*)(a.ws + WS_MIX) + (size_t)m_t * D + type * 512 + h * HD;
    const bf16_t* gtp = X.GT + (size_t)m_t * W5 + h * HD;
#pragma unroll
    for (int eb = 0; eb < 2; ++eb)
#pragma unroll
        for (int g = 0; g < 4; ++g) {
            const int e0 = 64 * kh + 32 * eb + 8 * g + 4 * hh;
            const f32x4 gn = *(const f32x4*)(X.gain + h * HD + e0);
            const unsigned long long gw_ = *(const unsigned long long*)(gtp + e0);
            const unsigned g01 = (unsigned)gw_, g23 = (unsigned)(gw_ >> 32);
            const float y0 = hv[eb][4 * g + 0] * rstd * gn[0] * __uint_as_float(g01 << 16), y1 = hv[eb][4 * g + 1] * rstd * gn[1] * __uint_as_float(g01 & 0xffff0000u);
            const float y2 = hv[eb][4 * g + 2] * rstd * gn[2] * __uint_as_float(g23 << 16), y3 = hv[eb][4 * g + 3] * rstd * gn[3] * __uint_as_float(g23 & 0xffff0000u);
            *(unsigned long long*)(outp + e0) = (unsigned long long)cvtpk(y0, y1) | ((unsigned long long)cvtpk(y2, y3) << 32);
        }
}

__device__ __forceinline__ void mix_state_item(Frame& F, const Args& a, const MixSrc& X, int type, int b, int h) {
    LAS unsigned char* lds = F.lds;
    int tid = F.tid; asm volatile("" : "+v"(tid));
    const int lane = tid & 63, wave = F.wave, c31 = lane & 31, hh = lane >> 5, sb = b * TP;
    LAS float* WSM = (LAS float*)(lds + MX_W); LAS float* RED = (LAS float*)(lds + MX_RED);
    __syncthreads();
    {
        const int dir = tid >> 8, s = tid & 255; float lw, mfin = 0.f;
        if (type == 1) {
            const float* cu = dir == 0 ? X.cumF : X.cumB; const float* li = dir == 0 ? X.liF : X.liB;
            const float tot = cu[sb + (dir == 0 ? TP - 1 : 0)];
            lw = tot - cu[sb + s] + li[sb + s];
            float mx = lw;
#pragma unroll
            for (int o = 32; o > 0; o >>= 1) mx = fmaxf(mx, __shfl_xor(mx, o));
            if (lane == 0) RED[wave] = mx;
            __syncthreads();
            mfin = fmaxf(fmaxf(fmaxf(RED[dir * 4 + 0], RED[dir * 4 + 1]), fmaxf(RED[dir * 4 + 2], RED[dir * 4 + 3])), tot);
            lw -= mfin;
            if (s == 0) a.out[O_M + (b * 2 + dir) * 4 + h] = mfin;
        } else lw = (dir == 0 ? X.lgf : X.lgb) * (float)(dir == 0 ? TP - 1 - s : s);
        WSM[dir * 256 + s] = __expf(lw);
    }
    const int dir = wave >> 2, dkb = wave & 3;
    const int trl = ((lane & 15) >> 2) * TRS + ((lane >> 4) & 1) * 32 + (lane & 3) * 8 + hh * 8 * TRS;
    const LAS unsigned char* kt = lds + MX_KS + trl + dkb * 64;
    const LAS unsigned char* vt = lds + MX_VS + trl;
    const LAS float* wl = WSM + dir * 256 + 8 * hh;
    f32x16 acc[4], accn;
#pragma unroll
    for (int r = 0; r < 16; ++r) { accn[r] = 0.f;
#pragma unroll
        for (int v = 0; v < 4; ++v) acc[v][r] = 0.f; }
    bf16x8 ones;
#pragma unroll
    for (int j = 0; j < 8; ++j) ones[j] = (short)0x3F80;
    for (int jt = 0; jt < 2; ++jt) {
        __syncthreads();
        stage_tile(lds + MX_KS, TRS, X.K + (size_t)(sb + 128 * jt) * W5 + h * HD, W5, tid);
        stage_tile(lds + MX_VS, TRS, X.V + (size_t)(sb + 128 * jt) * W5 + h * HD, W5, tid);
        __syncthreads();
#pragma unroll
        for (int ks = 0; ks < 8; ++ks) {
            const bf16x8 kr = TR_FRAG(kt, 16 * ks, 16 * ks + 4, 0);
            const f32x4 w0 = *(const LAS f32x4*)(wl + 128 * jt + 16 * ks), w1 = *(const LAS f32x4*)(wl + 128 * jt + 16 * ks + 4);
            const v4u ku = __builtin_bit_cast(v4u, kr);
            v4u kw;
            kw.x = cvtpk(__uint_as_float(ku.x << 16) * w0[0], __uint_as_float(ku.x & 0xffff0000u) * w0[1]);
            kw.y = cvtpk(__uint_as_float(ku.y << 16) * w0[2], __uint_as_float(ku.y & 0xffff0000u) * w0[3]);
            kw.z = cvtpk(__uint_as_float(ku.z << 16) * w1[0], __uint_as_float(ku.z & 0xffff0000u) * w1[1]);
            kw.w = cvtpk(__uint_as_float(ku.w << 16) * w1[2], __uint_as_float(ku.w & 0xffff0000u) * w1[3]);
            const bf16x8 ka = __builtin_bit_cast(bf16x8, kw);
#pragma unroll
            for (int v = 0; v < 4; ++v) acc[v] = MFMA32(ka, TR_FRAG(vt, 16 * ks, 16 * ks + 4, v), acc[v]);
            if (type == 1) accn = MFMA32(ka, ones, accn);
        }
    }
    float* O = a.out + (type == 0 ? O_RET : O_C) + (size_t)((b * 2 + dir) * 4 + h) * 16384;
#pragma unroll
    for (int v = 0; v < 4; ++v)
#pragma unroll
        for (int r = 0; r < 16; ++r) O[(32 * dkb + (r & 3) + 8 * (r >> 2) + 4 * hh) * 128 + 32 * v + c31] = acc[v][r];
    if (type == 1 && c31 == 0) {
#pragma unroll
        for (int r = 0; r < 16; ++r) a.out[O_N + (size_t)((b * 2 + dir) * 4 + h) * 128 + 32 * dkb + (r & 3) + 8 * (r >> 2) + 4 * hh] = accn[r];
    }
}

__device__ __forceinline__ void p4_mixer(Frame& F, const Args& a) {
    unsigned char* ws = a.ws;
    for (int item = F.vcu; item < 768; item += F.G) {
        const int kind = item >> 8, idx = item & 255, type = idx >> 7, r = idx & 127;
        MixSrc X;
        X.Q = (const bf16_t*)(ws + (type == 0 ? WS_RQ : WS_MQ)); X.K = (const bf16_t*)(ws + (type == 0 ? WS_RK : WS_MK)); X.V = (const bf16_t*)(ws + (type == 0 ? WS_RV : WS_MV));
        X.GT = (const bf16_t*)(ws + (type == 0 ? WS_RG : WS_MO)); X.gain = type == 0 ? a.in[16] : a.in[17];
        int h, seq, qt0 = 0, nq = 1;
        if (kind == 0) { seq = 32 + (r >> 6); h = (r >> 4) & 3; qt0 = r & 15; } else { seq = r >> 2; h = r & 3; nq = 2; }
        X.cumF = (const float*)(ws + WS_GCUM) + (size_t)h * M; X.cumB = (const float*)(ws + WS_GCUM) + (size_t)(4 + h) * M;
        X.liF = (const float*)(ws + WS_GLI) + (size_t)h * M; X.liB = (const float*)(ws + WS_GLI) + (size_t)(4 + h) * M;
        X.lgf = logsigf(a.in[14][h]); X.lgb = logsigf(a.in[14][4 + h]);
        if (kind < 2) { for (int q = 0; q < nq; ++q) mix_attn_item(F, a, X, type, seq, h, qt0 + q); }
        else mix_state_item(F, a, X, type, seq, h);
    }
    __syncthreads();
}

__device__ __forceinline__ void p6_norm2(Frame& F, const Args& a) {
    const int gw = F.vcu * NWAVES + F.wave, NGW = F.G * NWAVES, lane = F.lane;
    const float* mod = (const float*)(a.ws + WS_MOD);
    for (int m = gw; m < M; m += NGW) {
        const int cnd = cond_of(m);
        const f32x4* xr = (const f32x4*)(a.out + O_Y + (size_t)m * D) + lane;
        f32x4 v[4]; float ss = 0.f;
#pragma unroll
        for (int j = 0; j < 4; ++j) { v[j] = xr[64 * j]; ss += (v[j].x * v[j].x + v[j].y * v[j].y) + (v[j].z * v[j].z + v[j].w * v[j].w); }
        const float rstd = rsqrtf(wave_sum(ss) * (1.f / D) + EPS);
        unsigned long long* o8 = (unsigned long long*)((bf16_t*)(a.ws + WS_H) + (size_t)m * D) + lane;
#pragma unroll
        for (int j = 0; j < 4; ++j) { const int k = 4 * (lane + 64 * j);
            const f32x4 g = *(const f32x4*)(a.in[11] + k), sc = *(const f32x4*)(mod + cnd * 6144 + 4096 + k), sh = *(const f32x4*)(mod + cnd * 6144 + 3072 + k);
            const f32x4 hh_ = v[j] * rstd * g * (sc + 1.f) + sh;
            o8[64 * j] = (unsigned long long)cvtpk(hh_.x, hh_.y) | ((unsigned long long)cvtpk(hh_.z, hh_.w) << 32); }
    }
}
__device__ __forceinline__ void p9_final(Frame& F, const Args& a) {
    const int gw = F.vcu * NWAVES + F.wave, NGW = F.G * NWAVES, lane = F.lane;
    for (int m = gw; m < M; m += NGW) {
        f32x4* xr = (f32x4*)(a.out + O_Y + (size_t)m * D) + lane;
        f32x4 v[4]; float ss = 0.f;
#pragma unroll
        for (int j = 0; j < 4; ++j) { v[j] = xr[64 * j]; ss += (v[j].x * v[j].x + v[j].y * v[j].y) + (v[j].z * v[j].z + v[j].w * v[j].w); }
        const float rstd = rsqrtf(wave_sum(ss) * (1.f / D) + EPS);
#pragma unroll
        for (int j = 0; j < 4; ++j) xr[64 * j] = v[j] * rstd * *(const f32x4*)(a.in[21] + 4 * (lane + 64 * j));
    }
}

__global__ void __launch_bounds__(NWAVES * 64, 2) mega(Args args) {
    extern __shared__ __attribute__((aligned(16))) unsigned char lds[];
    Frame F;
    F.lds = (LAS unsigned char*)lds;
    F.MISC = (volatile LAS unsigned*)(F.lds + MISC_OFF);
    F.tid = threadIdx.x; F.lane = F.tid & 63; F.wave = __builtin_amdgcn_readfirstlane(F.tid >> 6);
    F.G = gridDim.x; { const int bx = blockIdx.x; F.vcu = (F.G % 8 == 0) ? (bx % 8) * (F.G / 8) + bx / 8 : bx; }
    unsigned char* ws = args.ws;
    F.ctl = (gu32*)(ws + WS_CTL);
    for (int u = F.tid; u < (LDS_BYTES - LDSCTL_OFF) / 4; u += NWAVES * 64) ((LAS unsigned*)(F.lds + LDSCTL_OFF))[u] = 0u;
    __syncthreads();
    XcdBarrier bar = xcd_barrier_post((unsigned*)(F.ctl + CW_BAR) + args.li * XCD_BAR_WORDS, F.MISC + 8);
    const int lo = args.ph_lo, hi = args.ph_hi;
#ifndef REP_PHASE
#define REP_PHASE -1
#endif
#define IN(k) (lo <= (k) && (k) < hi)
#define REPS(k) ((k) == REP_PHASE ? 2 : 1)
#define BOTH(k) (IN(k) && IN((k) + 1))
    if (IN(0)) for (int rep_ = 0; rep_ < REPS(0); ++rep_) { p0_prologue(F, args); if (BOTH(0)) xcd_barrier(bar); }
    if (IN(1)) for (int rep_ = 0; rep_ < REPS(1); ++rep_) { p1_norm_gates(F, args); if (BOTH(1)) xcd_barrier(bar); }
    if (IN(2)) for (int rep_ = 0; rep_ < REPS(2); ++rep_) {
        pg8::Gemm g{(const bf16_t*)(ws + WS_H), (const bf16_t*)(ws + WS_WIN), M, 4096, D}; pg8::StaticOrder S; S.init(M, 4096, F.G, (int)blockIdx.x);
        pg8::EpiProj E{ws, (const float*)(ws + WS_ROPE)};
        pg8::gemm_phase<pg8::EpiProj, pg8::StaticOrder, true, true>(F.lds + RING_OFF, g, S, E);
        if (BOTH(2)) xcd_barrier(bar);
    }
    if (IN(3)) for (int rep_ = 0; rep_ < REPS(3); ++rep_) { p3_conv_cumsum(F, args); if (BOTH(3)) xcd_barrier(bar); }
    if (IN(4)) for (int rep_ = 0; rep_ < REPS(4); ++rep_) { p4_mixer(F, args); if (BOTH(4)) xcd_barrier(bar); }
    if (IN(5)) for (int rep_ = 0; rep_ < REPS(5); ++rep_) {
        pg8::Gemm g{(const bf16_t*)(ws + WS_MIX), (const bf16_t*)(ws + WS_WOUT), M, D, D}; pg8::StaticOrder S; S.init(M, D, F.G, (int)blockIdx.x);
        pg8::EpiRes E{args.in[0], args.in[1], args.out + O_Y, (const float*)(ws + WS_MOD) + 2048};
        pg8::gemm_phase<pg8::EpiRes, pg8::StaticOrder, true, true>(F.lds + RING_OFF, g, S, E);
        if (BOTH(5)) xcd_barrier(bar);
    }
    if (IN(6)) for (int rep_ = 0; rep_ < REPS(6); ++rep_) { p6_norm2(F, args); if (BOTH(6)) xcd_barrier(bar); }
    if (IN(7)) for (int rep_ = 0; rep_ < REPS(7); ++rep_) {
        pg8::Gemm g{(const bf16_t*)(ws + WS_H), (const bf16_t*)(ws + WS_W1), M, FF, D}; pg8::StaticOrder S; S.init(M, FF, F.G, (int)blockIdx.x);
        pg8::EpiRelu2 E{(bf16_t*)(ws + WS_U)};
        pg8::gemm_phase<pg8::EpiRelu2, pg8::StaticOrder, true, true>(F.lds + RING_OFF, g, S, E);
        if (BOTH(7)) xcd_barrier(bar);
    }
    if (IN(8)) for (int rep_ = 0; rep_ < REPS(8); ++rep_) {
        pg8::Gemm g{(const bf16_t*)(ws + WS_U), (const bf16_t*)(ws + WS_W2), M, D, FF}; pg8::StaticOrder S; S.init(M, D, F.G, (int)blockIdx.x);
        pg8::EpiRes E{args.out + O_Y, args.out + O_Y + (size_t)NP * D, args.out + O_Y, (const float*)(ws + WS_MOD) + 5120};
        pg8::gemm_phase<pg8::EpiRes, pg8::StaticOrder, true, true>(F.lds + RING_OFF, g, S, E);
        if (BOTH(8)) xcd_barrier(bar);
    }
    if (IN(9)) for (int rep_ = 0; rep_ < REPS(9); ++rep_) { p9_final(F, args); }
#undef IN
#undef BOTH
}

extern "C" void kernel_launch(void* const* d_in, const int* in_sizes, int n_in, void* d_out, int out_size, void* d_ws, size_t ws_size, hipStream_t stream) {
    static int grid = 0;
    if (grid == 0) {
        if (n_in != 22 || ws_size < WS_END) { fprintf(stderr, "kernel_launch: unexpected n_in %d / ws_size %zu\n", n_in, ws_size); grid = -1; return; }
        int dev = 0, cus = 0, per_cu = 0;
        if (hipGetDevice(&dev) != hipSuccess || hipDeviceGetAttribute(&cus, hipDeviceAttributeMultiprocessorCount, dev) != hipSuccess) { grid = -1; return; }
        if (hipFuncSetAttribute((const void*)mega, hipFuncAttributeMaxDynamicSharedMemorySize, LDS_BYTES) != hipSuccess) { fprintf(stderr, "kernel_launch: hipFuncSetAttribute failed\n"); grid = -1; return; }
        if (hipOccupancyMaxActiveBlocksPerMultiprocessor(&per_cu, (const void*)mega, NWAVES * 64, LDS_BYTES) != hipSuccess || per_cu < 1) fprintf(stderr, "kernel_launch: occupancy query says %d\n", per_cu);
        (void)hipGetLastError();
        grid = cus;
    }
    if (grid < 0) return;
    P p{};
    p.xp = (const float*)d_in[0]; p.xs = (const float*)d_in[1]; p.st_ret = (const float*)d_in[2]; p.st_C = (const float*)d_in[3];
    p.st_n = (const float*)d_in[4]; p.st_m = (const float*)d_in[5]; p.c = (const float*)d_in[6]; p.cctx = (const float*)d_in[7];
    p.w_ada = (const float*)d_in[8]; p.b_ada = (const float*)d_in[9]; p.n1g = (const float*)d_in[10]; p.n2g = (const float*)d_in[11];
    p.w_in = (const float*)d_in[12]; p.conv_w = (const float*)d_in[13]; p.decay = (const float*)d_in[14]; p.gbias = (const float*)d_in[15];
    p.rgn = (const float*)d_in[16]; p.mgn = (const float*)d_in[17]; p.w_out = (const float*)d_in[18]; p.w_ff1 = (const float*)d_in[19];
    p.w_ff2 = (const float*)d_in[20]; p.fg = (const float*)d_in[21];
    p.out = (float*)d_out; p.ws = (unsigned char*)d_ws;
    (void)hipMemsetAsync((char*)d_ws + WS_CTL, 0, CTL_ZERO_BYTES, stream);
    Args a{};
    for (int i = 0; i < 22; ++i) a.in[i] = (const float*)d_in[i];
    a.out = (float*)d_out; a.ws = (unsigned char*)d_ws;
    int li = 0;
#define MEGA(lo_, hi_) do { a.ph_lo = (lo_); a.ph_hi = (hi_); a.li = li++; hipLaunchKernelGGL(mega, dim3(grid), dim3(NWAVES * 64), LDS_BYTES, stream, a); } while (0)
#ifndef MIX_NAIVE
#define MIX_NAIVE 0
#endif
#if MIX_NAIVE
    MEGA(0, 4);
    k_mix<<<dim3(M / 16, 4, 2), 256, 0, stream>>>(p);
    k_states<<<dim3(32, 4, 4), 256, 0, stream>>>(p);
    MEGA(5, 10);
#else
    MEGA(0, 10);
#endif
}
```

```cpp
#include <hip/hip_runtime.h>
#include <cstdint>
#include <cstdio>

typedef unsigned short bf16_t;

constexpr int D = 1024, NP = 32 * 256, NS = 2 * 2048, M = NP + NS;
constexpr int TP = 256, TS = 2048;
constexpr int INC = 4112, FF = 4096, NH = 4, HD = 128, W5 = 512;
constexpr float EPS = 1e-6f;

constexpr size_t MiB = 1u << 20;
constexpr size_t WS_CTL = 0;
constexpr size_t WS_MOD = 1 * MiB;
constexpr size_t WS_ROPE = 1 * MiB + 128 * 1024;
constexpr size_t WS_GATES = 2 * MiB;
constexpr size_t WS_GLI = 3 * MiB;
constexpr size_t WS_GCUM = 3 * MiB + 512 * 1024;
constexpr size_t WS_WIN = 4 * MiB;
constexpr size_t WS_WOUT = 12 * MiB;
constexpr size_t WS_W1 = 14 * MiB;
constexpr size_t WS_W2 = 22 * MiB;
constexpr size_t WS_H = 32 * MiB;
constexpr size_t WS_MIX = 56 * MiB;
constexpr size_t WS_RQ = 80 * MiB;
constexpr size_t WS_RK = 92 * MiB;
constexpr size_t WS_RV = 104 * MiB;
constexpr size_t WS_RG = 116 * MiB;
constexpr size_t WS_MQKP = 128 * MiB;
constexpr size_t WS_MV = 152 * MiB;
constexpr size_t WS_MO = 164 * MiB;
constexpr size_t WS_MQ = 176 * MiB;
constexpr size_t WS_MK = 188 * MiB;
constexpr size_t WS_U = 80 * MiB;
constexpr size_t WS_END = 200 * MiB;

constexpr size_t O_Y = 0;
constexpr size_t O_RET = (size_t)M * D;
constexpr size_t O_C = O_RET + (size_t)32 * 2 * 4 * 128 * 128;
constexpr size_t O_N = O_C + (size_t)32 * 2 * 4 * 128 * 128;
constexpr size_t O_M = O_N + (size_t)32 * 2 * 4 * 128;

__device__ __forceinline__ float bf2f(bf16_t v) { return __uint_as_float((unsigned)v << 16); }
__device__ __forceinline__ bf16_t f2bf(float f) { unsigned u = __float_as_uint(f); return (bf16_t)((u + 0x7fffu + ((u >> 16) & 1u)) >> 16); }
__device__ __forceinline__ float siluf(float x) { return x / (1.f + __expf(-x)); }
__device__ __forceinline__ float sigmf(float x) { return 1.f / (1.f + __expf(-x)); }
__device__ __forceinline__ float logsigf(float x) { return fminf(x, 0.f) - log1pf(__expf(-fabsf(x))); }
__device__ __forceinline__ int cond_of(int m) { return m < NP ? 0 : 1 + (m - NP) / TS; }

struct P {
    const float *xp, *xs, *st_ret, *st_C, *st_n, *st_m, *c, *cctx, *w_ada, *b_ada, *n1g, *n2g, *w_in, *conv_w, *decay, *gbias, *rgn, *mgn, *w_out, *w_ff1, *w_ff2, *fg;
    float* out; unsigned char* ws;
};
__device__ __forceinline__ const float* xrow(const P& p, int m) { return m < NP ? p.xp + (size_t)m * D : p.xs + (size_t)(m - NP) * D; }

__global__ void k_wt(const float* W, int ldw, int K, bf16_t* WT) {
    __shared__ float t[32][33];
    const int n0 = blockIdx.x * 32, k0 = blockIdx.y * 32, tx = threadIdx.x, ty = threadIdx.y;
    for (int i = ty; i < 32; i += 8) t[i][tx] = W[(size_t)(k0 + i) * ldw + n0 + tx];
    __syncthreads();
    for (int i = ty; i < 32; i += 8) WT[(size_t)(n0 + i) * K + k0 + tx] = f2bf(t[tx][i]);
}

__global__ void k_mod(P p) {
    const int j = blockIdx.x * 256 + threadIdx.x, cnd = blockIdx.y;
    const float* cv = cnd == 0 ? p.cctx : p.c + (size_t)(cnd - 1) * D;
    float acc = 0.f;
    for (int k = 0; k < D; ++k) acc += siluf(cv[k]) * p.w_ada[(size_t)k * 6144 + j];
    ((float*)(p.ws + WS_MOD))[cnd * 6144 + j] = acc + p.b_ada[j];
}

__global__ void k_rope(P p) {
    const int pos = blockIdx.x, f = threadIdx.x;
    const float inv = (float)exp(-(double)f / 32.0 * log(10000.0));
    const float ang = (float)pos * inv;
    float* rc = (float*)(p.ws + WS_ROPE);
    rc[pos * 32 + f] = (float)cos((double)ang);
    rc[2048 + pos * 32 + f] = (float)sin((double)ang);
}

__device__ __forceinline__ float block_sum256(float v, float* red) {
    for (int o = 32; o > 0; o >>= 1) v += __shfl_xor(v, o);
    __syncthreads();
    if ((threadIdx.x & 63) == 0) red[threadIdx.x >> 6] = v;
    __syncthreads();
    return red[0] + red[1] + red[2] + red[3];
}

__global__ void k_norm(P p, int which) {
    __shared__ float red[4];
    __shared__ float gsum[16][4];
    const int m = blockIdx.x, tid = threadIdx.x, cnd = cond_of(m);
    const float* xr = which == 0 ? xrow(p, m) : p.out + O_Y + (size_t)m * D;
    const float* mod = (const float*)(p.ws + WS_MOD) + cnd * 6144;
    const float* sh = mod + (which == 0 ? 0 : 3072);
    const float* sc = mod + (which == 0 ? 1024 : 4096);
    const float* g = which == 0 ? p.n1g : p.n2g;
    float v[4], ss = 0.f;
    for (int i = 0; i < 4; ++i) { v[i] = xr[tid + 256 * i]; ss += v[i] * v[i]; }
    ss = block_sum256(ss, red);
    const float rstd = rsqrtf(ss * (1.f / D) + EPS);
    bf16_t* H = (bf16_t*)(p.ws + WS_H) + (size_t)m * D;
    float h[4];
    for (int i = 0; i < 4; ++i) { const int k = tid + 256 * i; h[i] = v[i] * rstd * g[k] * (1.f + sc[k]) + sh[k]; H[k] = f2bf(h[i]); }
    if (which == 0) {
        float ga[16];
        for (int j = 0; j < 16; ++j) ga[j] = 0.f;
        for (int i = 0; i < 4; ++i) { const int k = tid + 256 * i; const float* wr = p.w_in + (size_t)k * INC + 4096;
            for (int j = 0; j < 16; ++j) ga[j] += h[i] * wr[j]; }
        for (int j = 0; j < 16; ++j) { float s = ga[j]; for (int o = 32; o > 0; o >>= 1) s += __shfl_xor(s, o); if ((tid & 63) == 0) gsum[j][tid >> 6] = s; }
        __syncthreads();
        if (tid < 16) ((float*)(p.ws + WS_GATES))[(size_t)m * 16 + tid] = gsum[tid][0] + gsum[tid][1] + gsum[tid][2] + gsum[tid][3] + p.gbias[tid];
    }
}

enum { EPI_PROJ = 0, EPI_RES1 = 1, EPI_RELU2 = 2, EPI_RES2 = 3 };
template <int EPI>
__global__ void __launch_bounds__(256) k_gemm(P p, const bf16_t* A, const bf16_t* WT, int K) {
    __shared__ float As[16][68];
    __shared__ float Bs[16][132];
    __shared__ float Cs[64][129];
    const int tid = threadIdx.x, m0 = blockIdx.y * 64, n0 = blockIdx.x * 128;
    const int ty = tid >> 4, tx = tid & 15;
    float acc[4][8];
    for (int i = 0; i < 4; ++i) for (int j = 0; j < 8; ++j) acc[i][j] = 0.f;
    for (int k0 = 0; k0 < K; k0 += 16) {
        { const int r = tid >> 2, kk = (tid & 3) * 4; const bf16_t* a = A + (size_t)(m0 + r) * K + k0 + kk;
          for (int j = 0; j < 4; ++j) As[kk + j][r] = bf2f(a[j]); }
        { const int r = tid >> 1, kk = (tid & 1) * 8; const bf16_t* b = WT + (size_t)(n0 + r) * K + k0 + kk;
          for (int j = 0; j < 8; ++j) Bs[kk + j][r] = bf2f(b[j]); }
        __syncthreads();
        for (int kk = 0; kk < 16; ++kk) {
            float a[4], b[8];
            for (int i = 0; i < 4; ++i) a[i] = As[kk][ty * 4 + i];
            for (int j = 0; j < 8; ++j) b[j] = Bs[kk][tx * 8 + j];
            for (int i = 0; i < 4; ++i) for (int j = 0; j < 8; ++j) acc[i][j] += a[i] * b[j];
        }
        __syncthreads();
    }
    for (int i = 0; i < 4; ++i) for (int j = 0; j < 8; ++j) Cs[ty * 4 + i][tx * 8 + j] = acc[i][j];
    __syncthreads();
    if (EPI == EPI_PROJ) {
        const int sec = n0 / 512, hc = n0 % 512;
        const float* rc = (const float*)(p.ws + WS_ROPE);
        for (int e = tid; e < 64 * 128; e += 256) {
            const int r = e >> 7, d = e & 127, m = m0 + r;
            float v = Cs[r][d];
            if (sec <= 1) {
                if (sec == 1) v *= 0.08838834764831845f;
                if (m >= NP) {
                    const int t = (m - NP) % TS, dd = d & 63, f = dd & 31, pos = dd < 32 ? t / 64 : t % 64;
                    const float cs = rc[pos * 32 + f], sn = rc[2048 + pos * 32 + f];
                    float o = Cs[r][d ^ 64]; if (sec == 1) o *= 0.08838834764831845f;
                    v = d < 64 ? v * cs - o * sn : o * sn + v * cs;
                }
                ((bf16_t*)(p.ws + (sec == 0 ? WS_RQ : WS_RK)))[(size_t)m * W5 + hc + d] = f2bf(v);
            } else if (sec == 2) ((bf16_t*)(p.ws + WS_RV))[(size_t)m * W5 + hc + d] = f2bf(v);
            else if (sec == 3) ((bf16_t*)(p.ws + WS_RG))[(size_t)m * W5 + hc + d] = f2bf(siluf(v));
            else if (sec <= 5) ((bf16_t*)(p.ws + WS_MQKP))[(size_t)m * 1024 + (n0 - 2048) + d] = f2bf(v);
            else if (sec == 6) ((bf16_t*)(p.ws + WS_MV))[(size_t)m * W5 + hc + d] = f2bf(v);
            else ((bf16_t*)(p.ws + WS_MO))[(size_t)m * W5 + hc + d] = f2bf(sigmf(v));
        }
    } else if (EPI == EPI_RES1) {
        for (int e = tid; e < 64 * 128; e += 256) { const int r = e >> 7, n = n0 + (e & 127), m = m0 + r;
            const float g1 = ((const float*)(p.ws + WS_MOD))[cond_of(m) * 6144 + 2048 + n];
            p.out[O_Y + (size_t)m * D + n] = xrow(p, m)[n] + g1 * Cs[r][e & 127]; }
    } else if (EPI == EPI_RELU2) {
        for (int e = tid; e < 64 * 128; e += 256) { const int r = e >> 7, n = n0 + (e & 127), m = m0 + r;
            const float v = fmaxf(Cs[r][e & 127], 0.f);
            ((bf16_t*)(p.ws + WS_U))[(size_t)m * FF + n] = f2bf(v * v); }
    } else {
        for (int e = tid; e < 64 * 128; e += 256) { const int r = e >> 7, n = n0 + (e & 127), m = m0 + r;
            const float g2 = ((const float*)(p.ws + WS_MOD))[cond_of(m) * 6144 + 5120 + n];
            p.out[O_Y + (size_t)m * D + n] += g2 * Cs[r][e & 127]; }
    }
}

__global__ void k_conv(P p) {
    const int m = blockIdx.x, T = m < NP ? TP : TS, t = m < NP ? m % TP : (m - NP) % TS;
    const bf16_t* X = (const bf16_t*)(p.ws + WS_MQKP);
    for (int c = threadIdx.x; c < 1024; c += 256) {
        float v = p.conv_w[1024 + c] * bf2f(X[(size_t)m * 1024 + c]);
        if (t > 0) v += p.conv_w[c] * bf2f(X[(size_t)(m - 1) * 1024 + c]);
        if (t < T - 1) v += p.conv_w[2048 + c] * bf2f(X[(size_t)(m + 1) * 1024 + c]);
        v = siluf(v);
        if (c < 512) ((bf16_t*)(p.ws + WS_MQ))[(size_t)m * W5 + c] = f2bf(v);
        else ((bf16_t*)(p.ws + WS_MK))[(size_t)m * W5 + c - 512] = f2bf(v * 0.08838834764831845f);
    }
}

__global__ void k_gates(P p) {
    const int id = blockIdx.x * 64 + threadIdx.x;
    if (id >= 34 * 8) return;
    const int seq = id / 8, h = id % 4, dir = (id / 4) % 2;
    const int T = seq < 32 ? TP : TS, mbase = seq < 32 ? seq * TP : NP + (seq - 32) * TS;
    const float* G = (const float*)(p.ws + WS_GATES);
    float* LI = (float*)(p.ws + WS_GLI) + (size_t)(dir * 4 + h) * M;
    float* CU = (float*)(p.ws + WS_GCUM) + (size_t)(dir * 4 + h) * M;
    float cum = 0.f;
    for (int i = 0; i < T; ++i) {
        const int m = mbase + (dir == 0 ? i : T - 1 - i);
        cum += logsigf(G[(size_t)m * 16 + dir * 8 + 4 + h]);
        CU[m] = cum; LI[m] = G[(size_t)m * 16 + dir * 8 + h];
    }
}

__global__ void __launch_bounds__(256) k_mix(P p) {
    __shared__ float qs[16][128];
    __shared__ float ks[32][129];
    __shared__ float vs[32][128];
    __shared__ float pf[16][32], pb[16][32];
    __shared__ float os[16][129];
    const int tid = threadIdx.x, m0 = blockIdx.x * 16, h = blockIdx.y, type = blockIdx.z;
    const bool lat = m0 >= NP;
    const int T = lat ? TS : TP, sb = lat ? NP + ((m0 - NP) / TS) * TS : (m0 / TP) * TP, t0 = m0 - sb;
    const bf16_t* Q = (const bf16_t*)(p.ws + (type == 0 ? WS_RQ : WS_MQ));
    const bf16_t* Kp = (const bf16_t*)(p.ws + (type == 0 ? WS_RK : WS_MK));
    const bf16_t* V = (const bf16_t*)(p.ws + (type == 0 ? WS_RV : WS_MV));
    const float lgf = logsigf(p.decay[h]), lgb = logsigf(p.decay[4 + h]);
    const float* LI0 = (const float*)(p.ws + WS_GLI) + (size_t)h * M;
    const float* LI1 = (const float*)(p.ws + WS_GLI) + (size_t)(4 + h) * M;
    const float* CU0 = (const float*)(p.ws + WS_GCUM) + (size_t)h * M;
    const float* CU1 = (const float*)(p.ws + WS_GCUM) + (size_t)(4 + h) * M;
    for (int e = tid; e < 16 * 128; e += 256) qs[e >> 7][e & 127] = bf2f(Q[(size_t)(m0 + (e >> 7)) * W5 + h * HD + (e & 127)]);
    const int e_ = tid & 127, rh = tid >> 7;
    float of[8], ob[8];
    for (int i = 0; i < 8; ++i) { of[i] = 0.f; ob[i] = 0.f; }
    float den = 0.f;
    for (int s0 = 0; s0 < T; s0 += 32) {
        __syncthreads();
        for (int e = tid; e < 32 * 128; e += 256) { const int s = e >> 7, d = e & 127; const size_t a = (size_t)(sb + s0 + s) * W5 + h * HD + d;
            ks[s][d] = bf2f(Kp[a]); vs[s][d] = bf2f(V[a]); }
        __syncthreads();
        for (int e = tid; e < 16 * 32; e += 256) {
            const int r = e >> 5, s = e & 31, t = t0 + r, sg = s0 + s;
            float dot = 0.f;
            for (int d = 0; d < 128; ++d) dot += qs[r][d] * ks[s][d];
            float wf, wb;
            if (type == 0) {
                wf = sg < t ? __expf(lgf * (float)(t - sg)) : (sg > t ? __expf(lgb * (float)(sg - t)) : 2.f);
                wb = 0.f;
            } else {
                wf = sg <= t ? __expf(CU0[sb + t] - CU0[sb + sg] + LI0[sb + sg]) : 0.f;
                wb = sg >= t ? __expf(CU1[sb + t] - CU1[sb + sg] + LI1[sb + sg]) : 0.f;
            }
            pf[r][s] = dot * wf; pb[r][s] = dot * wb;
        }
        __syncthreads();
        if (tid < 32) { const int r = tid & 15; float a = 0.f; for (int s = 0; s < 32; ++s) a += (tid < 16 ? pf[r][s] : pb[r][s]); den += a; }
        for (int s = 0; s < 32; ++s) { const float v = vs[s][e_];
            for (int i = 0; i < 8; ++i) { of[i] += pf[rh * 8 + i][s] * v; ob[i] += pb[rh * 8 + i][s] * v; } }
    }
    __syncthreads();
    float* dens = &pf[0][0];
    if (tid < 32) dens[tid] = den;
    __syncthreads();
    if (lat) {
        const int b = (m0 - NP) / TS;
        const float* S0f = (type == 0 ? p.st_ret : p.st_C) + ((size_t)((b * 2 + 0) * 4 + h)) * 128 * 128;
        const float* S0b = (type == 0 ? p.st_ret : p.st_C) + ((size_t)((b * 2 + 1) * 4 + h)) * 128 * 128;
        for (int i = 0; i < 8; ++i) {
            const int r = rh * 8 + i, t = t0 + r;
            float af = 0.f, ab = 0.f;
            for (int d = 0; d < 128; ++d) { af += qs[r][d] * S0f[d * 128 + e_]; ab += qs[r][d] * S0b[d * 128 + e_]; }
            float cf, cb;
            if (type == 0) { cf = __expf(lgf * (float)(t + 1)); cb = __expf(lgb * (float)(T - t)); }
            else { cf = __expf(CU0[sb + t] + p.st_m[(b * 2 + 0) * 4 + h]); cb = __expf(CU1[sb + t] + p.st_m[(b * 2 + 1) * 4 + h]); }
            of[i] += cf * af; ob[i] += cb * ab;
        }
        if (type == 1 && tid < 32) {
            const int r = tid & 15, dir = tid >> 4, t = t0 + r;
            const float* n0 = p.st_n + (size_t)((b * 2 + dir) * 4 + h) * 128;
            float a = 0.f; for (int d = 0; d < 128; ++d) a += qs[r][d] * n0[d];
            const float cfb = __expf((dir == 0 ? CU0 : CU1)[sb + t] + p.st_m[(b * 2 + dir) * 4 + h]);
            dens[tid] += cfb * a;
        }
        __syncthreads();
    }
    for (int i = 0; i < 8; ++i) {
        const int r = rh * 8 + i;
        float o;
        if (type == 0) o = of[i] + ob[i];
        else o = of[i] / fmaxf(fabsf(dens[r]), 1.f) + ob[i] / fmaxf(fabsf(dens[16 + r]), 1.f);
        os[r][e_] = o;
    }
    __syncthreads();
    for (int i = 0; i < 8; ++i) {
        const int r = rh * 8 + i, m = m0 + r;
        float mu = 0.f; for (int d = 0; d < 128; ++d) mu += os[r][d];
        mu *= (1.f / 128.f);
        float var = 0.f; for (int d = 0; d < 128; ++d) { const float x = os[r][d] - mu; var += x * x; }
        var *= (1.f / 128.f);
        const float y = (os[r][e_] - mu) * rsqrtf(var + EPS);
        const float g = (type == 0 ? p.rgn : p.mgn)[h * HD + e_];
        const float gate = bf2f(((const bf16_t*)(p.ws + (type == 0 ? WS_RG : WS_MO)))[(size_t)m * W5 + h * HD + e_]);
        ((bf16_t*)(p.ws + WS_MIX))[(size_t)m * D + type * 512 + h * HD + e_] = f2bf(y * g * gate);
    }
}

__global__ void __launch_bounds__(256) k_states(P p) {
    __shared__ float ks[32][128], vs[32][128], ws_[256];
    __shared__ float red[4];
    const int tid = threadIdx.x, b = blockIdx.x, h = blockIdx.y, type = blockIdx.z >> 1, dir = blockIdx.z & 1;
    const int sb = b * TP;
    const bf16_t* Kp = (const bf16_t*)(p.ws + (type == 0 ? WS_RK : WS_MK));
    const bf16_t* V = (const bf16_t*)(p.ws + (type == 0 ? WS_RV : WS_MV));
    float mfin = 0.f;
    {
        const int s = tid; float lw;
        if (type == 0) { const float lg = logsigf(p.decay[dir * 4 + h]); lw = lg * (float)(dir == 0 ? TP - 1 - s : s); }
        else {
            const float* LI = (const float*)(p.ws + WS_GLI) + (size_t)(dir * 4 + h) * M;
            const float* CU = (const float*)(p.ws + WS_GCUM) + (size_t)(dir * 4 + h) * M;
            const float tot = CU[sb + (dir == 0 ? TP - 1 : 0)];
            lw = tot - CU[sb + s] + LI[sb + s];
            float mx = lw; for (int o = 32; o > 0; o >>= 1) mx = fmaxf(mx, __shfl_xor(mx, o));
            if ((tid & 63) == 0) red[tid >> 6] = mx;
            __syncthreads();
            mfin = fmaxf(fmaxf(fmaxf(red[0], red[1]), fmaxf(red[2], red[3])), tot);
            lw -= mfin;
        }
        ws_[s] = __expf(lw);
    }
    const int dk0 = (tid >> 4) * 8, dv0 = (tid & 15) * 8;
    float acc[8][8]; float nacc = 0.f;
    for (int i = 0; i < 8; ++i) for (int j = 0; j < 8; ++j) acc[i][j] = 0.f;
    for (int s0 = 0; s0 < TP; s0 += 32) {
        __syncthreads();
        for (int e = tid; e < 32 * 128; e += 256) { const int s = e >> 7, d = e & 127; const size_t a = (size_t)(sb + s0 + s) * W5 + h * HD + d;
            ks[s][d] = bf2f(Kp[a]); vs[s][d] = bf2f(V[a]); }
        __syncthreads();
        for (int s = 0; s < 32; ++s) {
            const float w = ws_[s0 + s];
            float kk[8], vv[8];
            for (int i = 0; i < 8; ++i) { kk[i] = ks[s][dk0 + i] * w; vv[i] = vs[s][dv0 + i]; }
            for (int i = 0; i < 8; ++i) for (int j = 0; j < 8; ++j) acc[i][j] += kk[i] * vv[j];
            if (tid < 128) nacc += w * ks[s][tid];
        }
    }
    float* O = p.out + (type == 0 ? O_RET : O_C) + (size_t)((b * 2 + dir) * 4 + h) * 128 * 128;
    for (int i = 0; i < 8; ++i) for (int j = 0; j < 8; ++j) O[(dk0 + i) * 128 + dv0 + j] = acc[i][j];
    if (type == 1) {
        if (tid < 128) p.out[O_N + (size_t)((b * 2 + dir) * 4 + h) * 128 + tid] = nacc;
        if (tid == 0) p.out[O_M + (b * 2 + dir) * 4 + h] = mfin;
    }
}

__global__ void k_final(P p) {
    __shared__ float red[4];
    const int m = blockIdx.x, tid = threadIdx.x;
    float* xr = p.out + O_Y + (size_t)m * D;
    float v[4], ss = 0.f;
    for (int i = 0; i < 4; ++i) { v[i] = xr[tid + 256 * i]; ss += v[i] * v[i]; }
    ss = block_sum256(ss, red);
    const float rstd = rsqrtf(ss * (1.f / D) + EPS);
    for (int i = 0; i < 4; ++i) xr[tid + 256 * i] = v[i] * rstd * p.fg[tid + 256 * i];
}


namespace pg8 {
#define PG8_LAS __attribute__((address_space(3)))
typedef short bf16x8 __attribute__((ext_vector_type(8)));
typedef float f32x4 __attribute__((ext_vector_type(4)));
typedef unsigned u32x4 __attribute__((ext_vector_type(4)));
constexpr int BM = 256, BK = 64, HALF = 128, HTB = HALF * BK * 2  , STAGE_BYTES = 8 * HTB, NXCD = 8, WGM = 8;

__host__ __device__ __forceinline__ int lds_byte(int r, int c) { const int st = (r >> 4) * 2 + (c >> 5), rr = r & 15, cc = c & 31, ob = rr * 64 + cc * 2; return st * 1024 + (ob ^ (((ob >> 9) & 1) << 5)); }
__host__ __device__ __forceinline__ void stage_rc(int b, int& R, int& C) { const int st = b / 1024, sb = b % 1024, swz = sb ^ (((sb >> 9) & 1) << 5); R = (st >> 1) * 16 + swz / 64; C = (st & 1) * 32 + (swz % 64) / 2; }
__host__ __device__ __forceinline__ int perm32(int rho) { const int n = rho >> 4, i = rho & 15; return 8 * (i >> 2) + 4 * n + (i & 3); }

struct Unit { int pm, pn; };
struct Gemm { const bf16_t* A; const bf16_t* Bt; int M, N, K; };

struct StaticOrder {
    int nM, nN, nwg, G, c;
    __host__ __device__ void init(int M, int N, int G_, int c_) { nM = M / BM; nN = N / BM; nwg = nM * nN; G = G_; c = c_; }
    __host__ __device__ bool next(int i, Unit& u) const {
        const long L = (long)i * G + c; if (L >= nwg) return false;
        int wgid = (int)L; { const int q = nwg / NXCD, r = nwg % NXCD, xcd = wgid % NXCD, off = wgid / NXCD; wgid = (xcd < r ? xcd * (q + 1) : r * (q + 1) + (xcd - r) * q) + off; }
        const int nig = WGM * nN, gid = wgid / nig, fm = gid * WGM, gsz = (nM - fm) < WGM ? (nM - fm) : WGM;
        u.pm = fm + ((wgid % nig) % gsz); u.pn = (wgid % nig) / gsz; return true;
    }
    __device__ __forceinline__ void a_ready(const Unit&) const {}
    __device__ __forceinline__ void done(const Unit&) const {}
};


__device__ __forceinline__ unsigned cvt_pk_bf16(float lo, float hi) { unsigned r; asm volatile("v_cvt_pk_bf16_f32 %0, %1, %2" : "=v"(r) : "v"(lo), "v"(hi)); return r; }
__device__ __forceinline__ u32x4 pack8(const f32x4& a, const f32x4& b) { u32x4 w; w.x = cvt_pk_bf16(a[0], a[1]); w.y = cvt_pk_bf16(a[2], a[3]); w.z = cvt_pk_bf16(b[0], b[1]); w.w = cvt_pk_bf16(b[2], b[3]); return w; }
__device__ __forceinline__ f32x4 silu4(const f32x4& v) { f32x4 o; for (int i = 0; i < 4; ++i) o[i] = v[i] / (1.f + __expf(-v[i])); return o; }
__device__ __forceinline__ f32x4 sigm4(const f32x4& v) { f32x4 o; for (int i = 0; i < 4; ++i) o[i] = 1.f / (1.f + __expf(-v[i])); return o; }

struct EpiProj {
    static constexpr bool PERM = true, PAIR = true, AFTER_DRAIN = false;
    unsigned char* ws; const float* rope;
    __device__ __forceinline__ void operator()(const f32x4 (&acc)[2][2][4][2], const Unit& u, int wr, int wc, int fr, int fq) const {
        const int sec = u.pn >> 1, hh = wc >> 1, dl = 32 * (wc & 1) + 8 * fq;
        bf16_t* dst; int ld, colb;
        if (sec == 4 || sec == 5) { dst = (bf16_t*)(ws + WS_MQKP); ld = 1024; colb = (u.pn - 8) * 256 + hh * 128; }
        else { const size_t off = sec == 0 ? WS_RQ : sec == 1 ? WS_RK : sec == 2 ? WS_RV : sec == 3 ? WS_RG : sec == 6 ? WS_MV : WS_MO;
               dst = (bf16_t*)(ws + off); ld = 512; colb = (u.pn & 1) * 256 + hh * 128; }
        const bool lat = u.pm >= NP / 256;
#pragma unroll
        for (int ai = 0; ai < 2; ++ai)
#pragma unroll
            for (int m = 0; m < 4; ++m) {
                const int row = u.pm * BM + ai * HALF + wr * 64 + m * 16 + fr;
                f32x4 a0 = acc[ai][0][m][0], a1 = acc[ai][0][m][1], b0 = acc[ai][1][m][0], b1 = acc[ai][1][m][1];
                if (sec <= 1) {
                    if (sec == 1) { a0 = a0 * 0.08838834764831845f; a1 = a1 * 0.08838834764831845f; b0 = b0 * 0.08838834764831845f; b1 = b1 * 0.08838834764831845f; }
                    if (lat) {
                        const int t = (row - NP) & (TS - 1), pos = (wc & 1) ? (t & 63) : (t >> 6);
                        const float* rp = rope + pos * 32 + 8 * fq;
                        const f32x4 c0 = *(const f32x4*)rp, c1 = *(const f32x4*)(rp + 4), s0 = *(const f32x4*)(rp + 2048), s1 = *(const f32x4*)(rp + 2052);
                        const f32x4 n0 = a0 * c0 - b0 * s0, n1 = a1 * c1 - b1 * s1, m0 = a0 * s0 + b0 * c0, m1 = a1 * s1 + b1 * c1;
                        a0 = n0; a1 = n1; b0 = m0; b1 = m1;
                    }
                } else if (sec == 3) { a0 = silu4(a0); a1 = silu4(a1); b0 = silu4(b0); b1 = silu4(b1); }
                else if (sec == 7) { a0 = sigm4(a0); a1 = sigm4(a1); b0 = sigm4(b0); b1 = sigm4(b1); }
                bf16_t* rp = dst + (size_t)row * ld + colb + dl;
                *(u32x4*)rp = pack8(a0, a1);
                *(u32x4*)(rp + 64) = pack8(b0, b1);
            }
    }
};
struct EpiRelu2 {
    static constexpr bool PERM = true, PAIR = false, AFTER_DRAIN = false;
    bf16_t* U;
    __device__ __forceinline__ void operator()(const f32x4 (&acc)[2][2][4][2], const Unit& u, int wr, int wc, int fr, int fq) const {
        const int row0 = u.pm * BM + wr * 64 + fr, col0 = u.pn * BM + wc * 32 + 8 * fq;
#pragma unroll
        for (int ai = 0; ai < 2; ++ai)
#pragma unroll
            for (int m = 0; m < 4; ++m) { bf16_t* rowp = U + (size_t)(row0 + ai * HALF + m * 16) * FF + col0;
#pragma unroll
                for (int bj = 0; bj < 2; ++bj) { f32x4 v0 = acc[ai][bj][m][0], v1 = acc[ai][bj][m][1];
                    for (int i = 0; i < 4; ++i) { const float x = fmaxf(v0[i], 0.f), y = fmaxf(v1[i], 0.f); v0[i] = x * x; v1[i] = y * y; }
                    *(u32x4*)(rowp + bj * HALF) = pack8(v0, v1); } }
    }
};
struct EpiRes {
    static constexpr bool PERM = false, PAIR = false, AFTER_DRAIN = false;
    const float* base_p; const float* base_s; float* out; const float* gate;
    __device__ __forceinline__ void operator()(const f32x4 (&acc)[2][2][4][2], const Unit& u, int wr, int wc, int fr, int fq) const {
        const int row0 = u.pm * BM + wr * 64 + fr, col0 = u.pn * BM + wc * 32 + 4 * fq;
        const int cnd = u.pm < NP / 256 ? 0 : 1 + (u.pm - NP / 256) / (TS / 256);
        const float* base = u.pm < NP / 256 ? base_p : base_s - (size_t)NP * D;
        f32x4 gv[2][2];
#pragma unroll
        for (int bj = 0; bj < 2; ++bj)
#pragma unroll
            for (int n = 0; n < 2; ++n) gv[bj][n] = *(const f32x4*)(gate + cnd * 6144 + col0 + bj * HALF + n * 16);
#pragma unroll
        for (int ai = 0; ai < 2; ++ai)
#pragma unroll
            for (int m = 0; m < 4; ++m) { const size_t off = (size_t)(row0 + ai * HALF + m * 16) * D + col0;
#pragma unroll
                for (int bj = 0; bj < 2; ++bj)
#pragma unroll
                    for (int n = 0; n < 2; ++n) { const f32x4 b = *(const f32x4*)(base + off + bj * HALF + n * 16);
                        *(f32x4*)(out + off + bj * HALF + n * 16) = b + gv[bj][n] * acc[ai][bj][m][n]; } }
    }
};
template <class Epi, class Sched, bool ALIGN_EPI = false, bool SP2 = false>
__device__ __forceinline__ void gemm_phase(PG8_LAS unsigned char* lds, const Gemm g, const Sched& S, const Epi& E) {
    const int tid = threadIdx.x, wid = __builtin_amdgcn_readfirstlane(tid >> 6), lane = tid & 63, wr = wid >> 2, wc = wid & 3, fr = lane & 15, fq = lane >> 4;
    const int K = g.K, nt = K / BK;
    unsigned voffA[2], voffB[2];
#pragma unroll
    for (int i = 0; i < 2; ++i) { int R, C; stage_rc(tid * 16 + i * 8192, R, C); int Rb = Epi::PERM ? ((R & ~31) + perm32(R & 31)) : R;
        if (Epi::PAIR) Rb = (Rb >> 6) * 128 + (Rb & 63);
        voffA[i] = (unsigned)(R * K + C) * 2u; voffB[i] = (unsigned)(Rb * K + C) * 2u; }
    const size_t kstep = (size_t)(BK * 2);
    const size_t hstep = (size_t)HALF * K * 2;
    const size_t hstepB = Epi::PAIR ? hstep / 2 : hstep;
    const size_t tstep = 2 * hstep;
    const unsigned ldsw = (unsigned)wid * 1024u;
    const int aoff = lds_byte(wr * 64 + fr, fq * 8), boff = lds_byte(wc * 32 + fr, fq * 8);
#define PG8_SA(b, h) (((b) * 2 + (h)) * HTB)
#define PG8_SB(b, h) ((4 + (b) * 2 + (h)) * HTB)
#define PG8_STAGE(bufoff, gbase, voff) do { _Pragma("unroll") for (int _i = 0; _i < 2; ++_i) \
        __builtin_amdgcn_global_load_lds((const unsigned*)((const char*)(gbase) + (voff)[_i]), (PG8_LAS unsigned*)(lds + (bufoff) + ldsw + _i * 8192), 16, 0, 0); } while (0)
#define PG8_LDA(dst, b, h) do { _Pragma("unroll") for (int m = 0; m < 4; ++m) _Pragma("unroll") for (int k = 0; k < 2; ++k) dst[m][k] = *(const PG8_LAS bf16x8*)(lds + PG8_SA(b, h) + aoff + m * 2048 + k * 1024); } while (0)
#define PG8_LDB(dst, b, h) do { _Pragma("unroll") for (int n = 0; n < 2; ++n) _Pragma("unroll") for (int k = 0; k < 2; ++k) dst[n][k] = *(const PG8_LAS bf16x8*)(lds + PG8_SB(b, h) + boff + n * 2048 + k * 1024); } while (0)
#define PG8_MMA(ai, bj, At, Bt) do { __builtin_amdgcn_s_setprio(1); _Pragma("unroll") for (int m = 0; m < 4; ++m) _Pragma("unroll") for (int n = 0; n < 2; ++n) _Pragma("unroll") for (int k = 0; k < 2; ++k) \
        acc[ai][bj][m][n] = __builtin_amdgcn_mfma_f32_16x16x32_bf16(Bt[n][k], At[m][k], acc[ai][bj][m][n], 0, 0, 0); __builtin_amdgcn_s_setprio(0); } while (0)
#define PG8_WAIT_V(n) asm volatile("s_waitcnt vmcnt(" #n ")" ::: "memory")
#define PG8_WAIT_L(n) asm volatile("s_waitcnt lgkmcnt(" #n ")" ::: "memory")
#define PG8_BAR __builtin_amdgcn_s_barrier()
#define PG8_SCHED __builtin_amdgcn_sched_barrier(0)
    Unit cur, nxt; int ui = 0;
    if (!S.next(0, cur)) return;
    f32x4 acc[2][2][4][2];
#pragma unroll
    for (int a = 0; a < 2; ++a)
#pragma unroll
        for (int b = 0; b < 2; ++b)
#pragma unroll
            for (int m = 0; m < 4; ++m)
#pragma unroll
                for (int n = 0; n < 2; ++n) acc[a][b][m][n] = (f32x4){0.f, 0.f, 0.f, 0.f};
    bf16x8 At[4][2], B0[2][2], B1[2][2];
    const char* cA = (const char*)g.A + (size_t)cur.pm * tstep; const char* cB = (const char*)g.Bt + (size_t)cur.pn * tstep;
    S.a_ready(cur);
    if constexpr (SP2) {
        PG8_STAGE(PG8_SB(0, 0), cB, voffB); PG8_STAGE(PG8_SB(0, 1), cB + hstepB, voffB); PG8_STAGE(PG8_SA(0, 0), cA, voffA); PG8_STAGE(PG8_SA(0, 1), cA + hstep, voffA);
        if (wr == 1) PG8_BAR;
        PG8_WAIT_V(2); PG8_BAR;
        PG8_STAGE(PG8_SB(1, 0), cB + kstep, voffB); PG8_STAGE(PG8_SA(1, 0), cA + kstep, voffA); PG8_STAGE(PG8_SB(1, 1), cB + hstepB + kstep, voffB);
        PG8_WAIT_V(6); PG8_BAR;
    } else {
        PG8_STAGE(PG8_SB(0, 0), cB, voffB); PG8_STAGE(PG8_SA(0, 0), cA, voffA); PG8_STAGE(PG8_SB(0, 1), cB + hstepB, voffB); PG8_STAGE(PG8_SA(0, 1), cA + hstep, voffA);
        if (wr == 1) PG8_BAR;
        PG8_WAIT_V(4); PG8_BAR;
        PG8_STAGE(PG8_SB(1, 0), cB + kstep, voffB); PG8_STAGE(PG8_SA(1, 0), cA + kstep, voffA); PG8_STAGE(PG8_SB(1, 1), cB + hstepB + kstep, voffB);
        PG8_WAIT_V(6); PG8_BAR;
    }
    for (;;) {
        const bool has_next = S.next(ui + 1, nxt);
        const char* nA = has_next ? (const char*)g.A + (size_t)nxt.pm * tstep : cA; const char* nB = has_next ? (const char*)g.Bt + (size_t)nxt.pn * tstep : cB;
        for (int t = 0; t < nt; t += 2) {
            const bool last = (t == nt - 2);
            const char* a1 = cA + (size_t)(t + 1) * kstep;
            const char* a2 = last ? nA : cA + (size_t)(t + 2) * kstep; const char* b2 = last ? nB : cB + (size_t)(t + 2) * kstep;
            const char* a3 = a2 + kstep; const char* b3 = b2 + kstep;
            if (last && has_next) S.a_ready(nxt);
            if constexpr (SP2) {
            PG8_LDB(B0, 0, 0); PG8_LDB(B1, 0, 1); PG8_SCHED; PG8_LDA(At, 0, 0); PG8_STAGE(PG8_SA(1, 1), a1 + hstep, voffA);
            PG8_WAIT_V(8); PG8_WAIT_L(0); PG8_BAR; PG8_MMA(0, 0, At, B0); PG8_MMA(0, 1, At, B1); PG8_BAR; PG8_SCHED;
            PG8_LDA(At, 0, 1); PG8_STAGE(PG8_SB(0, 0), b2, voffB); PG8_STAGE(PG8_SB(0, 1), b2 + hstepB, voffB); PG8_STAGE(PG8_SA(0, 0), a2, voffA);
            PG8_WAIT_V(8); PG8_WAIT_L(0); PG8_BAR; PG8_MMA(1, 0, At, B0); PG8_MMA(1, 1, At, B1); PG8_BAR; PG8_SCHED;
            PG8_LDB(B0, 1, 0); PG8_LDB(B1, 1, 1); PG8_SCHED; PG8_LDA(At, 1, 0); PG8_STAGE(PG8_SA(0, 1), a2 + hstep, voffA);
            PG8_WAIT_V(8); PG8_WAIT_L(0); PG8_BAR; PG8_MMA(0, 0, At, B0); PG8_MMA(0, 1, At, B1); PG8_BAR; PG8_SCHED;
            PG8_LDA(At, 1, 1); PG8_STAGE(PG8_SB(1, 0), b3, voffB); PG8_STAGE(PG8_SB(1, 1), b3 + hstepB, voffB); PG8_STAGE(PG8_SA(1, 0), a3, voffA);
            PG8_WAIT_V(8); PG8_WAIT_L(0); PG8_BAR; PG8_MMA(1, 0, At, B0); PG8_MMA(1, 1, At, B1); PG8_BAR; PG8_SCHED;
            } else {
            PG8_LDB(B0, 0, 0); PG8_SCHED; PG8_LDA(At, 0, 0); PG8_STAGE(PG8_SA(1, 1), a1 + hstep, voffA);
            PG8_WAIT_L(8); PG8_BAR; PG8_WAIT_L(0); PG8_MMA(0, 0, At, B0); PG8_BAR; PG8_SCHED;
            PG8_LDB(B1, 0, 1); PG8_STAGE(PG8_SB(0, 0), b2, voffB);
            PG8_BAR; PG8_WAIT_L(0); PG8_MMA(0, 1, At, B1); PG8_BAR;
            PG8_LDA(At, 0, 1); PG8_STAGE(PG8_SA(0, 0), a2, voffA);
            PG8_BAR; PG8_WAIT_L(0); PG8_MMA(1, 0, At, B0); PG8_BAR; PG8_SCHED;
            PG8_STAGE(PG8_SB(0, 1), b2 + hstepB, voffB);
            PG8_WAIT_V(6); PG8_BAR; PG8_MMA(1, 1, At, B1); PG8_BAR;
            PG8_LDB(B0, 1, 0); PG8_SCHED; PG8_LDA(At, 1, 0); PG8_STAGE(PG8_SA(0, 1), a2 + hstep, voffA);
            PG8_WAIT_L(8); PG8_BAR; PG8_WAIT_L(0); PG8_MMA(0, 0, At, B0); PG8_BAR; PG8_SCHED;
            PG8_LDB(B1, 1, 1); PG8_STAGE(PG8_SB(1, 0), b3, voffB);
            PG8_BAR; PG8_WAIT_L(0); PG8_MMA(0, 1, At, B1); PG8_BAR;
            PG8_LDA(At, 1, 1); PG8_STAGE(PG8_SA(1, 0), a3, voffA);
            PG8_BAR; PG8_WAIT_L(0); PG8_MMA(1, 0, At, B0); PG8_BAR; PG8_SCHED;
            PG8_STAGE(PG8_SB(1, 1), b3 + hstepB, voffB);
            PG8_WAIT_V(6); PG8_BAR; PG8_MMA(1, 1, At, B1); PG8_BAR;
            }
        }
        if constexpr (ALIGN_EPI) { if (wr == 0) PG8_BAR; }
        if constexpr (!Epi::AFTER_DRAIN) { E(acc, cur, wr, wc, fr, fq); S.done(cur); }
        if (!has_next) break;
#pragma unroll
        for (int a = 0; a < 2; ++a)
#pragma unroll
            for (int b = 0; b < 2; ++b)
#pragma unroll
                for (int m = 0; m < 4; ++m)
#pragma unroll
                    for (int n = 0; n < 2; ++n) acc[a][b][m][n] = (f32x4){0.f, 0.f, 0.f, 0.f};
        cur = nxt; cA = nA; cB = nB; ++ui;
        if constexpr (ALIGN_EPI) { if (wr == 1) PG8_BAR; }
    }
    PG8_WAIT_V(0);
    if constexpr (!ALIGN_EPI) { if (wr == 0) PG8_BAR; }
    PG8_BAR;
    if constexpr (Epi::AFTER_DRAIN) { E.fused(acc, cur, wr, wc, fr, fq, lds, wid, lane); S.done(cur); }
#undef PG8_SA
#undef PG8_SB
#undef PG8_STAGE
#undef PG8_LDA
#undef PG8_LDB
#undef PG8_MMA
#undef PG8_WAIT_V
#undef PG8_WAIT_L
#undef PG8_BAR
#undef PG8_SCHED
}
}


constexpr int NWAVES = 8;
constexpr int RING_OFF = 0, RING_BYTES = 131072;
constexpr int LDS_BYTES = 163840;
constexpr int LDSCTL_OFF = LDS_BYTES - 2048, MISC_OFF = LDSCTL_OFF + 320;
#define GAS __attribute__((address_space(1)))
#define LAS __attribute__((address_space(3)))
typedef unsigned v4u __attribute__((ext_vector_type(4)));
typedef float f32x4 __attribute__((ext_vector_type(4)));
typedef GAS unsigned gu32;
#define LDS_WAIT() asm volatile("s_waitcnt lgkmcnt(0)" ::: "memory")
#define VM_WAIT() asm volatile("s_waitcnt vmcnt(0)" ::: "memory")
constexpr int CW_BAR = 4096;
constexpr size_t CTL_ZERO_BYTES = 256 * 1024;

#define XB_TMO      128
#define XB_XCNT(j)  (256  + 64 * (j))
#define XB_XSUB(j)  (1280 + 64 * (j))
#define XB_XGEN(j)  (2304 + 64 * (j))
#define XB_TOP      3328
#define XB_TOPGEN   3392
#define XCD_BAR_WORDS 3456
#define XB_SPIN_CAP (1u << 18)
__device__ __forceinline__ unsigned xb_ld(unsigned* p)              { return __hip_atomic_load(p, __ATOMIC_RELAXED, __HIP_MEMORY_SCOPE_AGENT); }
__device__ __forceinline__ unsigned xb_add(unsigned* p, unsigned v) { return __hip_atomic_fetch_add(p, v, __ATOMIC_RELAXED, __HIP_MEMORY_SCOPE_AGENT); }
__device__ __forceinline__ unsigned xb_xcc_id() { return (unsigned)__builtin_amdgcn_s_getreg((3 << 11) | 20) & 0xFu; }
#define XB_SPIN(cond, bar) do { unsigned _sp = 0; while (cond) { __builtin_amdgcn_s_sleep(1); \
    if ((++_sp & 255u) == 0u) { if (xb_ld(&(bar)[XB_TMO])) break; if (_sp > XB_SPIN_CAP) { atomicAdd(&(bar)[XB_TMO], 1u); break; } } } } while (0)
struct XcdBarrier { unsigned* bar; unsigned x; volatile LAS unsigned* st; };
__device__ __forceinline__ XcdBarrier xcd_barrier_post(unsigned* bar, volatile LAS unsigned* st) {
    XcdBarrier b; b.bar = bar; b.x = xb_xcc_id(); b.st = st;
    if (threadIdx.x == 0) (void)xb_add(&bar[XB_XCNT(b.x)], 1u);
    return b;
}
__device__ __forceinline__ void xcd_barrier_complete(unsigned* bar, unsigned x, unsigned& nloc, unsigned& nx) {
    const unsigned G = gridDim.x * gridDim.y * gridDim.z;
    unsigned sum, cnt, mine, sp = 0u;
    for (;;) {
        sum = 0u; cnt = 0u; mine = 0u;
#pragma unroll
        for (unsigned j = 0; j < 16; ++j) { const unsigned c = xb_ld(&bar[XB_XCNT(j)]); sum += c; cnt += (c > 0u) ? 1u : 0u; mine = (j == x) ? c : mine; }
        if (sum == G) break;
        __builtin_amdgcn_s_sleep(1);
        if ((++sp & 255u) == 0u) { if (xb_ld(&bar[XB_TMO])) break; if (sp > XB_SPIN_CAP) { atomicAdd(&bar[XB_TMO], 1u); break; } }
    }
    nloc = mine > 0u ? mine : 1u; nx = cnt > 0u ? cnt : 1u;
}
__device__ __forceinline__ void xcd_barrier(const XcdBarrier& b) {
    asm volatile("s_waitcnt vmcnt(0)" ::: "memory");
    __syncthreads();
    if (threadIdx.x == 0) {
        unsigned* bar = b.bar;
        __builtin_amdgcn_s_waitcnt(0);
        unsigned nloc = b.st[0], nx = b.st[1];
        if (nloc == 0u) { xcd_barrier_complete(bar, b.x, nloc, nx); b.st[0] = nloc; b.st[1] = nx; }
        const unsigned old = xb_add(&bar[XB_XSUB(b.x)], 1u);
        const unsigned gen = old / nloc;
        if (old + 1u == (gen + 1u) * nloc) {
            __builtin_amdgcn_fence(__ATOMIC_RELEASE, "agent");
            asm volatile("s_waitcnt vmcnt(0)" ::: "memory");
            const unsigned og = xb_add(&bar[XB_TOP], 1u);
            const unsigned tg = og / nx;
            if (og + 1u == (tg + 1u) * nx) xb_add(&bar[XB_TOPGEN], 1u);
            else XB_SPIN(xb_ld(&bar[XB_TOPGEN]) == tg, bar);
            __builtin_amdgcn_fence(__ATOMIC_ACQUIRE, "agent");
            xb_add(&bar[XB_XGEN(b.x)], 1u);
            asm volatile("s_waitcnt vmcnt(0)" ::: "memory");
        } else {
            XB_SPIN(xb_ld(&bar[XB_XGEN(b.x)]) == gen, bar);
            __builtin_amdgcn_fence(__ATOMIC_ACQUIRE, "agent");
            asm volatile("s_waitcnt vmcnt(0)" ::: "memory");
        }
    }
    __syncthreads();
}

struct Frame {
    LAS unsigned char* lds; volatile LAS unsigned* MISC; gu32* ctl;
    int tid, lane, wave, vcu, G;
};
__device__ __forceinline__ float wave_sum(float v) {
#pragma unroll
    for (int o = 1; o < 64; o <<= 1) v += __shfl_xor(v, o);
    return v;
}
__device__ __forceinline__ unsigned pk2(float lo, float hi) { return (unsigned)f2bf(lo) | ((unsigned)f2bf(hi) << 16); }
__device__ __forceinline__ void p0_transpose_item(const float* W, int K, int N, int ldw, bf16_t* WT, LAS float* scr, int item, int lane) {
    const int nblk = N / 32, kb = item / nblk, nb = item % nblk, k0 = 64 * kb, n0 = 32 * nb;
#pragma unroll 8
    for (int i = 0; i < 32; ++i) { const int kk = 2 * i + (lane >> 5); scr[kk * 33 + (lane & 31)] = W[(size_t)(k0 + kk) * ldw + n0 + (lane & 31)]; }
    LDS_WAIT(); asm volatile("" ::: "memory");
    const int c = lane & 7;
#pragma unroll
    for (int j = 0; j < 4; ++j) { const int n = (lane >> 3) + 8 * j; const LAS float* s = scr + (8 * c) * 33 + n;
        v4u o; o.x = pk2(s[0 * 33], s[1 * 33]); o.y = pk2(s[2 * 33], s[3 * 33]); o.z = pk2(s[4 * 33], s[5 * 33]); o.w = pk2(s[6 * 33], s[7 * 33]);
        *(GAS v4u*)(WT + (size_t)(n0 + n) * K + k0 + 8 * c) = o; }
    LDS_WAIT(); asm volatile("" ::: "memory");
}

struct Args { const float* in[22]; float* out; unsigned char* ws; int ph_lo, ph_hi, li, pad; };

__device__ __forceinline__ void p0_prologue(Frame& F, const Args& a) {
    unsigned char* ws = a.ws;
    if (F.vcu < 96) {
        LAS float* sc = (LAS float*)(F.lds + RING_OFF + 8 * 16384);
        LAS float* part = sc + 3 * 1024;
        for (int e = F.tid; e < 3 * D; e += NWAVES * 64) { const int c = e >> 10, k = e & 1023; sc[e] = siluf(c == 0 ? a.in[7][k] : a.in[6][(c - 1) * D + k]); }
        __syncthreads();
        const int j = F.vcu * 64 + F.lane, k0 = F.wave * 128;
        const float* wa = a.in[8] + (size_t)k0 * 6144 + j;
        float a0 = 0.f, a1 = 0.f, a2 = 0.f;
#pragma unroll 16
        for (int k = 0; k < 128; ++k) { const float w = wa[(size_t)k * 6144]; a0 += sc[k0 + k] * w; a1 += sc[1024 + k0 + k] * w; a2 += sc[2048 + k0 + k] * w; }
        part[(F.wave * 3 + 0) * 64 + F.lane] = a0; part[(F.wave * 3 + 1) * 64 + F.lane] = a1; part[(F.wave * 3 + 2) * 64 + F.lane] = a2;
        __syncthreads();
        if (F.tid < 192) { const int c = F.tid >> 6, l = F.tid & 63; float t = 0.f;
#pragma unroll
            for (int w = 0; w < 8; ++w) t += part[(w * 3 + c) * 64 + l];
            ((float*)(ws + WS_MOD))[c * 6144 + F.vcu * 64 + l] = t + a.in[9][F.vcu * 64 + l]; }
        __syncthreads();
    }
    if (F.vcu == 100) {
        for (int e = F.tid; e < 2048; e += NWAVES * 64) { const int pos = e >> 5, f = e & 31;
            const float inv = exp2f(-(float)f * (13.287712379549449f / 32.f)); const float ang = (float)pos * inv;
            float sn, cs; sincosf(ang, &sn, &cs);
            float* rc = (float*)(ws + WS_ROPE); rc[e] = cs; rc[2048 + e] = sn; }
    }
    LAS float* scr = (LAS float*)(F.lds + RING_OFF + F.wave * 16384);
    const int gw = F.vcu * NWAVES + F.wave, NGW = F.G * NWAVES;
    constexpr int I_IN = (D / 64) * (4096 / 32), I_O = (D / 64) * (D / 32), I_1 = (D / 64) * (FF / 32), I_2 = (FF / 64) * (D / 32);
    constexpr int NITEMS = I_IN + I_O + I_1 + I_2;
    for (int it = NITEMS - 1 - gw; it >= 0; it -= NGW) {
        int r = it;
        if (r < I_IN) { p0_transpose_item(a.in[12], D, 4096, INC, (bf16_t*)(ws + WS_WIN), scr, r, F.lane); continue; } r -= I_IN;
        if (r < I_O) { p0_transpose_item(a.in[18], D, D, D, (bf16_t*)(ws + WS_WOUT), scr, r, F.lane); continue; } r -= I_O;
        if (r < I_1) { p0_transpose_item(a.in[19], D, FF, FF, (bf16_t*)(ws + WS_W1), scr, r, F.lane); continue; } r -= I_1;
        p0_transpose_item(a.in[20], FF, D, D, (bf16_t*)(ws + WS_W2), scr, r, F.lane);
    }
}

__device__ __forceinline__ void p1_norm_gates(Frame& F, const Args& a) {
    LAS float* wg = (LAS float*)(F.lds + RING_OFF);
    for (int e = F.tid; e < 1024 * 16; e += NWAVES * 64) { const int k = e >> 4, j = e & 15; wg[k * 20 + j] = a.in[12][(size_t)k * INC + 4096 + j]; }
    __syncthreads();
    const int gw = F.vcu * NWAVES + F.wave, NGW = F.G * NWAVES, lane = F.lane;
    const float* mod = (const float*)(a.ws + WS_MOD);
    float A1[16], S1[16]; int cur = -1;
    for (int m = gw; m < M; m += NGW) {
        const int cnd = cond_of(m);
        if (cnd != cur) { cur = cnd;
#pragma unroll
            for (int i = 0; i < 16; ++i) { const int k = lane + 64 * i; A1[i] = a.in[10][k] * (1.f + mod[cnd * 6144 + 1024 + k]); S1[i] = mod[cnd * 6144 + k]; } }
        const float* xr = m < NP ? a.in[0] + (size_t)m * D : a.in[1] + (size_t)(m - NP) * D;
        float v[16]; float ss = 0.f;
#pragma unroll
        for (int i = 0; i < 16; ++i) { v[i] = xr[lane + 64 * i]; ss += v[i] * v[i]; }
        ss = wave_sum(ss);
        const float rstd = rsqrtf(ss * (1.f / D) + EPS);
        bf16_t* H = (bf16_t*)(a.ws + WS_H) + (size_t)m * D;
        float ga[16];
#pragma unroll
        for (int j = 0; j < 16; ++j) ga[j] = 0.f;
#pragma unroll
        for (int i = 0; i < 16; ++i) {
            const float h = v[i] * rstd * A1[i] + S1[i];
            H[lane + 64 * i] = f2bf(h);
            const LAS f32x4* wr = (const LAS f32x4*)(wg + (lane + 64 * i) * 20);
            const f32x4 w0 = wr[0], w1 = wr[1], w2 = wr[2], w3 = wr[3];
#pragma unroll
            for (int j = 0; j < 4; ++j) { ga[j] += h * w0[j]; ga[4 + j] += h * w1[j]; ga[8 + j] += h * w2[j]; ga[12 + j] += h * w3[j]; }
            if (i & 1) asm volatile("" ::: "memory");
        }
        { const bool hi = lane & 32;
#pragma unroll
          for (int j = 0; j < 8; ++j) { const float keep = hi ? ga[j + 8] : ga[j], give = hi ? ga[j] : ga[j + 8]; ga[j] = keep + __shfl_xor(give, 32); } }
        { const bool hi = lane & 16;
#pragma unroll
          for (int j = 0; j < 4; ++j) { const float keep = hi ? ga[j + 4] : ga[j], give = hi ? ga[j] : ga[j + 4]; ga[j] = keep + __shfl_xor(give, 16); } }
        { const bool hi = lane & 8;
#pragma unroll
          for (int j = 0; j < 2; ++j) { const float keep = hi ? ga[j + 2] : ga[j], give = hi ? ga[j] : ga[j + 2]; ga[j] = keep + __shfl_xor(give, 8); } }
        { const bool hi = lane & 4; const float keep = hi ? ga[1] : ga[0], give = hi ? ga[0] : ga[1]; ga[0] = keep + __shfl_xor(give, 4); }
        ga[0] += __shfl_xor(ga[0], 2); ga[0] += __shfl_xor(ga[0], 1);
        if ((lane & 3) == 0) ((float*)(a.ws + WS_GATES))[(size_t)m * 16 + (lane >> 2)] = ga[0] + a.in[15][lane >> 2];
    }
}


__device__ __forceinline__ void p3_conv_cumsum(Frame& F, const Args& a) {
    unsigned char* ws = a.ws;
    const int gw = F.vcu * NWAVES + F.wave, NGW = F.G * NWAVES, lane = F.lane;
    if (gw < 34 * 8) {
        const int seq = gw >> 3, dir = (gw >> 2) & 1, h = gw & 3;
        const int T = seq < 32 ? TP : TS, mbase = seq < 32 ? seq * TP : NP + (seq - 32) * TS;
        const float* G = (const float*)(ws + WS_GATES);
        float* LI = (float*)(ws + WS_GLI) + (size_t)(dir * 4 + h) * M;
        float* CU = (float*)(ws + WS_GCUM) + (size_t)(dir * 4 + h) * M;
        float carry = 0.f;
        for (int c0 = 0; c0 < T; c0 += 256) {
            float lf[4], li[4]; int mm[4];
#pragma unroll
            for (int i = 0; i < 4; ++i) { const int p = c0 + 4 * lane + i; mm[i] = mbase + (dir == 0 ? p : T - 1 - p);
                lf[i] = G[(size_t)mm[i] * 16 + dir * 8 + 4 + h]; li[i] = G[(size_t)mm[i] * 16 + dir * 8 + h]; }
#pragma unroll
            for (int i = 0; i < 4; ++i) lf[i] = logsigf(lf[i]);
            lf[1] += lf[0]; lf[2] += lf[1]; lf[3] += lf[2];
            float incl = lf[3];
#pragma unroll
            for (int o = 1; o < 64; o <<= 1) { const float v = __shfl_up(incl, o); if (lane >= o) incl += v; }
            const float excl = carry + incl - lf[3];
#pragma unroll
            for (int i = 0; i < 4; ++i) { CU[mm[i]] = excl + lf[i]; LI[mm[i]] = li[i]; }
            carry += __shfl(incl, 63);
        }
    }
    const bf16_t* X = (const bf16_t*)(ws + WS_MQKP);
    float cw[2][3][8];
#pragma unroll
    for (int i = 0; i < 2; ++i)
#pragma unroll
        for (int j = 0; j < 3; ++j)
#pragma unroll
            for (int e = 0; e < 8; ++e) cw[i][j][e] = a.in[13][j * 1024 + (lane + 64 * i) * 8 + e];
    for (int m = gw; m < M; m += NGW) {
        const int T = m < NP ? TP : TS, t = m < NP ? (m & (TP - 1)) : ((m - NP) & (TS - 1));
#pragma unroll
        for (int i = 0; i < 2; ++i) {
            const size_t off = (size_t)m * 1024 + (lane + 64 * i) * 8;
            const v4u x1 = *(const v4u*)(X + off);
            v4u x0 = {0u, 0u, 0u, 0u}, x2 = {0u, 0u, 0u, 0u};
            if (t > 0) x0 = *(const v4u*)(X + off - 1024);
            if (t < T - 1) x2 = *(const v4u*)(X + off + 1024);
            float o[8];
#pragma unroll
            for (int e = 0; e < 8; ++e) {
                const unsigned w0 = x0[e >> 1], w1 = x1[e >> 1], w2 = x2[e >> 1];
                const float f0 = __uint_as_float((e & 1) ? (w0 & 0xffff0000u) : (w0 << 16)), f1 = __uint_as_float((e & 1) ? (w1 & 0xffff0000u) : (w1 << 16)), f2 = __uint_as_float((e & 1) ? (w2 & 0xffff0000u) : (w2 << 16));
                float v = cw[i][0][e] * f0 + cw[i][1][e] * f1 + cw[i][2][e] * f2;
                v = siluf(v);
                o[e] = i == 0 ? v : v * 0.08838834764831845f;
            }
            v4u w; w.x = pk2(o[0], o[1]); w.y = pk2(o[2], o[3]); w.z = pk2(o[4], o[5]); w.w = pk2(o[6], o[7]);
            *(v4u*)((bf16_t*)(ws + (i == 0 ? WS_MQ : WS_MK)) + (size_t)m * W5 + lane * 8) = w;
        }
    }
}

typedef short bf16x8 __attribute__((ext_vector_type(8)));
typedef short s16x4 __attribute__((ext_vector_type(4)));
typedef short v4i16_t __attribute__((ext_vector_type(4)));
typedef float f32x16 __attribute__((ext_vector_type(16)));
typedef float f32x2_t __attribute__((ext_vector_type(2)));
typedef __bf16 bf16x2_t __attribute__((ext_vector_type(2)));
#define MFMA32(a_, b_, c_) __builtin_amdgcn_mfma_f32_32x32x16_bf16((a_), (b_), (c_), 0, 0, 0)
constexpr int RS = 272, TRS = 320;
constexpr int MX_QS = 0, MX_KS = 34816, MX_VS = 75776, MX_PX = 116736, MX_SM = 149504;
constexpr int MX_CF = MX_SM, MX_CB = MX_SM + 512, MX_DEN = MX_SM + 1024, MX_ST = MX_SM + 3072, MX_W = MX_SM + 5120, MX_RED = MX_SM + 7168;
static_assert(MX_RED + 64 <= LDSCTL_OFF && MX_KS + 128 * TRS <= MX_VS && MX_VS + 128 * TRS <= MX_PX && MX_PX + 32768 <= MX_SM, "mixer LDS map");
__device__ __forceinline__ unsigned cvtpk(float lo, float hi) { f32x2_t v = {lo, hi}; bf16x2_t b = __builtin_convertvector(v, bf16x2_t); return __builtin_bit_cast(unsigned, b); }
__device__ __forceinline__ s16x4 vtr(const LAS unsigned char* p) { return __builtin_bit_cast(s16x4, __builtin_amdgcn_ds_read_tr16_b64_v4i16((LAS v4i16_t*)p)); }
#define ROW_FRAG(base_r, row0, ks) (*(const LAS bf16x8*)((base_r) + (row0) * RS + (ks) * 32))
__device__ __forceinline__ bf16x8 tr_frag2(const LAS unsigned char* base_t, int off0, int off1) {
    const s16x4 lo = vtr(base_t + off0), hi = vtr(base_t + off1);
    return __builtin_shufflevector(lo, hi, 0, 1, 2, 3, 4, 5, 6, 7);
}
#define TR_FRAG(base_t, r0, r1, c) tr_frag2((base_t), (r0) * TRS + (c) * 64, (r1) * TRS + (c) * 64)
__device__ __forceinline__ void stage_tile(LAS unsigned char* dst, int rs, const bf16_t* src, int ld, int tid) {
#pragma unroll
    for (int i = 0; i < 4; ++i) { const int n = tid + 512 * i, row = n >> 4, ch = n & 15;
        const v4u v = *(const v4u*)(src + (size_t)row * ld + ch * 8);
        *(LAS v4u*)(dst + row * rs + ch * 16) = v; }
}
__device__ __forceinline__ void stage_tile_f32(LAS unsigned char* dst, const float* src, int tid) {
#pragma unroll
    for (int i = 0; i < 4; ++i) { const int n = tid + 512 * i, row = n >> 4, ch = n & 15;
        const f32x4 x = *(const f32x4*)(src + row * 128 + ch * 8), y = *(const f32x4*)(src + row * 128 + ch * 8 + 4);
        v4u v; v.x = cvtpk(x[0], x[1]); v.y = cvtpk(x[2], x[3]); v.z = cvtpk(y[0], y[1]); v.w = cvtpk(y[2], y[3]);
        *(LAS v4u*)(dst + row * TRS + ch * 16) = v; }
}

struct MixSrc { const bf16_t *Q, *K, *V, *GT; const float *cumF, *liF, *cumB, *liB, *gain; float lgf, lgb; };

__device__ __forceinline__ void mix_pv(f32x16 (&O)[2], const LAS unsigned char* vbase, const LAS unsigned char* pxbase) {
#pragma unroll
    for (int khp = 0; khp < 2; ++khp)
#pragma unroll
        for (int f = 0; f < 4; ++f) {
            const bf16x8 pb = *(const LAS bf16x8*)(pxbase + (khp * 4 + f) * 1024);
            const int kb0 = 64 * khp + 32 * (f >> 1) + 16 * (f & 1);
#pragma unroll
            for (int eb = 0; eb < 2; ++eb) O[eb] = MFMA32(TR_FRAG(vbase, kb0, kb0 + 8, eb), pb, O[eb]);
            if (f & 1) asm volatile("" ::: "memory");
        }
}

__device__ __forceinline__ void mix_attn_item(Frame& F, const Args& a, const MixSrc& X, int type, int seq, int h, int qt) {
    LAS unsigned char* lds = F.lds;
    int tid = F.tid; asm volatile("" : "+v"(tid));
    const int lane = tid & 63, wave = F.wave, rg = wave >> 1, kh = wave & 1, c31 = lane & 31, hh = lane >> 5;
    const int T = seq < 32 ? TP : TS, sb = seq < 32 ? seq * TP : NP + (seq - 32) * TS, nk = T / 128;
    const int t_rel = 32 * rg + c31, t_seq = 128 * qt + t_rel, m_t = sb + t_seq;
    LAS float* CF = (LAS float*)(lds + MX_CF); LAS float* CB = (LAS float*)(lds + MX_CB);
    const LAS unsigned char* qbase = lds + MX_QS + (32 * rg + c31) * RS + hh * 16;
    const LAS unsigned char* kbase = lds + MX_KS + (64 * kh + c31) * RS + hh * 16;
    const int trl = ((lane & 15) >> 2) * TRS + ((lane >> 4) & 1) * 32 + (lane & 3) * 8;
    const LAS unsigned char* vbase = lds + MX_VS + trl + hh * 4 * TRS + kh * 128;
    const LAS unsigned char* vnat = lds + MX_VS + trl + hh * 8 * TRS + kh * 128;
    LAS unsigned char* pxw = lds + MX_PX + wave * 4096 + lane * 16;
    const LAS unsigned char* pxr = lds + MX_PX + (wave & ~1) * 4096 + lane * 16;
    float cumF_t, cumB_t, refF, refB;
    if (type == 1) { cumF_t = X.cumF[m_t]; cumB_t = X.cumB[m_t]; refF = qt == 0 ? 0.f : X.cumF[sb + 128 * qt - 1]; refB = qt == nk - 1 ? 0.f : X.cumB[sb + 128 * (qt + 1)]; }
    else { cumF_t = X.lgf * (float)(t_seq + 1); cumB_t = X.lgb * (float)(T - t_seq); refF = X.lgf * (float)(128 * qt); refB = X.lgb * (float)(T - 128 * (qt + 1)); }
    f32x16 Of[2], Ob[2];
#pragma unroll
    for (int e = 0; e < 2; ++e)
#pragma unroll
        for (int r = 0; r < 16; ++r) { Of[e][r] = 0.f; Ob[e][r] = 0.f; }
    float denf = 0.f, denb = 0.f;
    __syncthreads();
    stage_tile(lds + MX_QS, RS, X.Q + (size_t)(sb + 128 * qt) * W5 + h * HD, W5, tid);
    if (seq >= 32) {
        const int b = seq - 32;
        const float* S0 = (type == 0 ? a.in[2] : a.in[3]) + (size_t)((b * 2) * 4 + h) * 16384;
        stage_tile_f32(lds + MX_VS, S0, tid);
        { const int row = tid >> 4, ch = tid & 15; v4u v = {0u, 0u, 0u, 0u};
          if (type == 1 && row < 2) { const float* n0 = a.in[4] + (size_t)((b * 2 + row) * 4 + h) * 128 + ch * 8; v.x = cvtpk(n0[0], n0[1]); v.y = cvtpk(n0[2], n0[3]); v.z = cvtpk(n0[4], n0[5]); v.w = cvtpk(n0[6], n0[7]); }
          *(LAS v4u*)(lds + MX_KS + row * RS + ch * 16) = v; }
        const float m0f = type == 1 ? a.in[5][(b * 2 + 0) * 4 + h] : 0.f, m0b = type == 1 ? a.in[5][(b * 2 + 1) * 4 + h] : 0.f;
        const float scF = __expf(refF + m0f), scB = __expf(refB + m0b);
        __syncthreads();
        f32x16 Sx;
#pragma unroll
        for (int r = 0; r < 16; ++r) Sx[r] = 0.f;
        const LAS unsigned char* nbase = lds + MX_KS + c31 * RS + hh * 16;
#pragma unroll
        for (int ks = 0; ks < 8; ++ks) {
            const bf16x8 qf = ROW_FRAG(qbase, 0, ks);
            Sx = MFMA32(ROW_FRAG(nbase, 0, ks), qf, Sx);
#pragma unroll
            for (int eb = 0; eb < 2; ++eb) Of[eb] = MFMA32(TR_FRAG(vnat, 16 * ks, 16 * ks + 4, eb), qf, Of[eb]);
            if (ks & 1) asm volatile("" ::: "memory");
        }
        if (kh == 0 && hh == 0) { denf = scF * Sx[0]; denb = scB * Sx[1]; }
#pragma unroll
        for (int eb = 0; eb < 2; ++eb) Of[eb] = Of[eb] * scF;
        __syncthreads();
        stage_tile_f32(lds + MX_VS, S0 + 4 * 16384, tid);
        __syncthreads();
#pragma unroll
        for (int ks = 0; ks < 8; ++ks) {
            const bf16x8 qf = ROW_FRAG(qbase, 0, ks);
#pragma unroll
            for (int eb = 0; eb < 2; ++eb) Ob[eb] = MFMA32(TR_FRAG(vnat, 16 * ks, 16 * ks + 4, eb), qf, Ob[eb]);
            if (ks & 1) asm volatile("" ::: "memory");
        }
#pragma unroll
        for (int eb = 0; eb < 2; ++eb) Ob[eb] = Ob[eb] * scB;
        __syncthreads();
    }
    f32x16 S[2];
#define MIX_STAGE_SCORES(j_, mode_) do { \
        stage_tile(lds + MX_KS, RS, X.K + (size_t)(sb + 128 * (j_)) * W5 + h * HD, W5, tid); \
        stage_tile(lds + MX_VS, TRS, X.V + (size_t)(sb + 128 * (j_)) * W5 + h * HD, W5, tid); \
        if (tid < 128) { \
            const int ts = 128 * (j_) + tid, ms = sb + ts; \
            float aF, aB; \
            if (type == 1) { aF = X.liF[ms] - X.cumF[ms]; aB = X.liB[ms] - X.cumB[ms]; } \
            else { aF = -X.lgf * (float)(ts + 1); aB = -X.lgb * (float)(T - ts); } \
            if ((mode_) == 0) CF[tid] = __expf(refF + aF); \
            else if ((mode_) == 1) CF[tid] = __expf(refB + aB); \
            else { CF[tid] = aF; CB[tid] = aB; } \
        } \
        __syncthreads(); \
        _Pragma("unroll") for (int kb = 0; kb < 2; ++kb) _Pragma("unroll") for (int r = 0; r < 16; ++r) S[kb][r] = 0.f; \
        _Pragma("unroll") for (int ks = 0; ks < 8; ++ks) { \
            const bf16x8 qf = ROW_FRAG(qbase, 0, ks); \
            _Pragma("unroll") for (int kb = 0; kb < 2; ++kb) S[kb] = MFMA32(ROW_FRAG(kbase, 32 * kb, ks), qf, S[kb]); \
            if (ks & 1) asm volatile("" ::: "memory"); \
        } } while (0)
    const LAS float* cfl = CF + 64 * kh + 4 * hh; const LAS float* cbl = CB + 64 * kh + 4 * hh;
    for (int step = 0; step < nk - 1; ++step) {
        const int j = step < qt ? step : nk - 1 - (step - qt);
        const int mode = j < qt ? 0 : 1;
        MIX_STAGE_SCORES(j, mode);
        float dsum = 0.f;
#pragma unroll
        for (int f = 0; f < 4; ++f) {
            v4u w;
#pragma unroll
            for (int g2 = 0; g2 < 2; ++g2) { const int g = 2 * (f & 1) + g2; const f32x4 c = *(const LAS f32x4*)(cfl + 32 * (f >> 1) + 8 * g);
                const float p0 = S[f >> 1][4 * g + 0] * c[0], p1 = S[f >> 1][4 * g + 1] * c[1], p2 = S[f >> 1][4 * g + 2] * c[2], p3 = S[f >> 1][4 * g + 3] * c[3];
                dsum += (p0 + p1) + (p2 + p3);
                if (g2 == 0) { w.x = cvtpk(p0, p1); w.y = cvtpk(p2, p3); } else { w.z = cvtpk(p0, p1); w.w = cvtpk(p2, p3); } }
            *(LAS v4u*)(pxw + f * 1024) = w;
        }
        __syncthreads();
        if (mode == 0) { denf += dsum; mix_pv(Of, vbase, pxr); } else { denb += dsum; mix_pv(Ob, vbase, pxr); }
        __syncthreads();
    }
    {
        const float rf = __expf(cumF_t - refF), rb = __expf(cumB_t - refB);
#pragma unroll
        for (int eb = 0; eb < 2; ++eb) { Of[eb] = Of[eb] * rf; Ob[eb] = Ob[eb] * rb; }
        denf *= rf; denb *= rb;
        MIX_STAGE_SCORES(qt, 2);
        int t_loc = t_rel; asm volatile("" : "+v"(t_loc));
#pragma unroll
        for (int dirp = 0; dirp < 2; ++dirp) {
            float dsum = 0.f;
#pragma unroll
            for (int f = 0; f < 4; ++f) {
                v4u w;
#pragma unroll
                for (int g2 = 0; g2 < 2; ++g2) { const int g = 2 * (f & 1) + g2, s0 = 64 * kh + 32 * (f >> 1) + 8 * g + 4 * hh;
                    const f32x4 c = *(const LAS f32x4*)((dirp == 0 ? cfl : cbl) + 32 * (f >> 1) + 8 * g);
                    float pv[4];
#pragma unroll
                    for (int i = 0; i < 4; ++i) { const bool on = dirp == 0 ? (s0 + i) <= t_loc : (s0 + i) >= t_loc;
                        const float wgt = on ? __expf((dirp == 0 ? cumF_t : cumB_t) + c[i]) : 0.f; pv[i] = S[f >> 1][4 * g + i] * wgt; dsum += pv[i]; }
                    if (g2 == 0) { w.x = cvtpk(pv[0], pv[1]); w.y = cvtpk(pv[2], pv[3]); } else { w.z = cvtpk(pv[0], pv[1]); w.w = cvtpk(pv[2], pv[3]); } }
                *(LAS v4u*)(pxw + f * 1024) = w;
            }
            __syncthreads();
            if (dirp == 0) { denf += dsum; mix_pv(Of, vbase, pxr); } else { denb += dsum; mix_pv(Ob, vbase, pxr); }
            __syncthreads();
        }
    }
#undef MIX_STAGE_SCORES
    LAS float* DEN = (LAS float*)(lds + MX_DEN); LAS float* ST = (LAS float*)(lds + MX_ST);
    float hv[2][16];
    if (type == 1) {
        denf += __shfl_xor(denf, 32); denb += __shfl_xor(denb, 32);
        if (hh == 0) { DEN[(wave * 2 + 0) * 32 + c31] = denf; DEN[(wave * 2 + 1) * 32 + c31] = denb; }
        __syncthreads();
        denf += DEN[((wave ^ 1) * 2 + 0) * 32 + c31]; denb += DEN[((wave ^ 1) * 2 + 1) * 32 + c31];
        const float inf_ = 1.f / fmaxf(fabsf(denf), 1.f), inb_ = 1.f / fmaxf(fabsf(denb), 1.f);
#pragma unroll
        for (int eb = 0; eb < 2; ++eb)
#pragma unroll
            for (int r = 0; r < 16; ++r) hv[eb][r] = Of[eb][r] * inf_ + Ob[eb][r] * inb_;
    } else {
#pragma unroll
        for (int eb = 0; eb < 2; ++eb)
#pragma unroll
            for (int r = 0; r < 16; ++r) hv[eb][r] = Of[eb][r] + Ob[eb][r];
    }
    float s1 = 0.f;
#pragma unroll
    for (int eb = 0; eb < 2; ++eb)
#pragma unroll
        for (int r = 0; r < 16; ++r) s1 += hv[eb][r];
    s1 += __shfl_xor(s1, 32);
    if (hh == 0) ST[(wave * 2 + 0) * 32 + c31] = s1;
    __syncthreads();
    const float mean = (s1 + ST[((wave ^ 1) * 2 + 0) * 32 + c31]) * (1.f / 128.f);
    float s2 = 0.f;
#pragma unroll
    for (int eb = 0; eb < 2; ++eb)
#pragma unroll
        for (int r = 0; r < 16; ++r) { hv[eb][r] -= mean; s2 += hv[eb][r] * hv[eb][r]; }
    s2 += __shfl_xor(s2, 32);
    if (hh == 0) ST[(wave * 2 + 1) * 32 + c31] = s2;
    __syncthreads();
    const float rstd = rsqrtf((s2 + ST[((wave ^ 1) * 2 + 1) * 32 + c31]) * (1.f / 128.f) + EPS);
    bf16_t* outp = (bf16_t*)(a.ws + WS_MIX) + (size_t)m_t * D + type * 512 + h * HD;
    const bf16_t* gtp = X.GT + (size_t)m_t * W5 + h * HD;
#pragma unroll
    for (int eb = 0; eb < 2; ++eb)
#pragma unroll
        for (int g = 0; g < 4; ++g) {
            const int e0 = 64 * kh + 32 * eb + 8 * g + 4 * hh;
            const f32x4 gn = *(const f32x4*)(X.gain + h * HD + e0);
            const unsigned long long gw_ = *(const unsigned long long*)(gtp + e0);
            const unsigned g01 = (unsigned)gw_, g23 = (unsigned)(gw_ >> 32);
            const float y0 = hv[eb][4 * g + 0] * rstd * gn[0] * __uint_as_float(g01 << 16), y1 = hv[eb][4 * g + 1] * rstd * gn[1] * __uint_as_float(g01 & 0xffff0000u);
            const float y2 = hv[eb][4 * g + 2] * rstd * gn[2] * __uint_as_float(g23 << 16), y3 = hv[eb][4 * g + 3] * rstd * gn[3] * __uint_as_float(g23 & 0xffff0000u);
            *(unsigned long long*)(outp + e0) = (unsigned long long)cvtpk(y0, y1) | ((unsigned long long)cvtpk(y2, y3) << 32);
        }
}

__device__ __forceinline__ void mix_state_item(Frame& F, const Args& a, const MixSrc& X, int type, int b, int h) {
    LAS unsigned char* lds = F.lds;
    int tid = F.tid; asm volatile("" : "+v"(tid));
    const int lane = tid & 63, wave = F.wave, c31 = lane & 31, hh = lane >> 5, sb = b * TP;
    LAS float* WSM = (LAS float*)(lds + MX_W); LAS float* RED = (LAS float*)(lds + MX_RED);
    __syncthreads();
    {
        const int dir = tid >> 8, s = tid & 255; float lw, mfin = 0.f;
        if (type == 1) {
            const float* cu = dir == 0 ? X.cumF : X.cumB; const float* li = dir == 0 ? X.liF : X.liB;
            const float tot = cu[sb + (dir == 0 ? TP - 1 : 0)];
            lw = tot - cu[sb + s] + li[sb + s];
            float mx = lw;
#pragma unroll
            for (int o = 32; o > 0; o >>= 1) mx = fmaxf(mx, __shfl_xor(mx, o));
            if (lane == 0) RED[wave] = mx;
            __syncthreads();
            mfin = fmaxf(fmaxf(fmaxf(RED[dir * 4 + 0], RED[dir * 4 + 1]), fmaxf(RED[dir * 4 + 2], RED[dir * 4 + 3])), tot);
            lw -= mfin;
            if (s == 0) a.out[O_M + (b * 2 + dir) * 4 + h] = mfin;
        } else lw = (dir == 0 ? X.lgf : X.lgb) * (float)(dir == 0 ? TP - 1 - s : s);
        WSM[dir * 256 + s] = __expf(lw);
    }
    const int dir = wave >> 2, dkb = wave & 3;
    const int trl = ((lane & 15) >> 2) * TRS + ((lane >> 4) & 1) * 32 + (lane & 3) * 8 + hh * 8 * TRS;
    const LAS unsigned char* kt = lds + MX_KS + trl + dkb * 64;
    const LAS unsigned char* vt = lds + MX_VS + trl;
    const LAS float* wl = WSM + dir * 256 + 8 * hh;
    f32x16 acc[4], accn;
#pragma unroll
    for (int r = 0; r < 16; ++r) { accn[r] = 0.f;
#pragma unroll
        for (int v = 0; v < 4; ++v) acc[v][r] = 0.f; }
    bf16x8 ones;
#pragma unroll
    for (int j = 0; j < 8; ++j) ones[j] = (short)0x3F80;
    for (int jt = 0; jt < 2; ++jt) {
        __syncthreads();
        stage_tile(lds + MX_KS, TRS, X.K + (size_t)(sb + 128 * jt) * W5 + h * HD, W5, tid);
        stage_tile(lds + MX_VS, TRS, X.V + (size_t)(sb + 128 * jt) * W5 + h * HD, W5, tid);
        __syncthreads();
#pragma unroll
        for (int ks = 0; ks < 8; ++ks) {
            const bf16x8 kr = TR_FRAG(kt, 16 * ks, 16 * ks + 4, 0);
            const f32x4 w0 = *(const LAS f32x4*)(wl + 128 * jt + 16 * ks), w1 = *(const LAS f32x4*)(wl + 128 * jt + 16 * ks + 4);
            const v4u ku = __builtin_bit_cast(v4u, kr);
            v4u kw;
            kw.x = cvtpk(__uint_as_float(ku.x << 16) * w0[0], __uint_as_float(ku.x & 0xffff0000u) * w0[1]);
            kw.y = cvtpk(__uint_as_float(ku.y << 16) * w0[2], __uint_as_float(ku.y & 0xffff0000u) * w0[3]);
            kw.z = cvtpk(__uint_as_float(ku.z << 16) * w1[0], __uint_as_float(ku.z & 0xffff0000u) * w1[1]);
            kw.w = cvtpk(__uint_as_float(ku.w << 16) * w1[2], __uint_as_float(ku.w & 0xffff0000u) * w1[3]);
            const bf16x8 ka = __builtin_bit_cast(bf16x8, kw);
#pragma unroll
            for (int v = 0; v < 4; ++v) acc[v] = MFMA32(ka, TR_FRAG(vt, 16 * ks, 16 * ks + 4, v), acc[v]);
            if (type == 1) accn = MFMA32(ka, ones, accn);
        }
    }
    float* O = a.out + (type == 0 ? O_RET : O_C) + (size_t)((b * 2 + dir) * 4 + h) * 16384;
#pragma unroll
    for (int v = 0; v < 4; ++v)
#pragma unroll
        for (int r = 0; r < 16; ++r) O[(32 * dkb + (r & 3) + 8 * (r >> 2) + 4 * hh) * 128 + 32 * v + c31] = acc[v][r];
    if (type == 1 && c31 == 0) {
#pragma unroll
        for (int r = 0; r < 16; ++r) a.out[O_N + (size_t)((b * 2 + dir) * 4 + h) * 128 + 32 * dkb + (r & 3) + 8 * (r >> 2) + 4 * hh] = accn[r];
    }
}

__device__ __forceinline__ void p4_mixer(Frame& F, const Args& a) {
    unsigned char* ws = a.ws;
    for (int item = F.vcu; item < 768; item += F.G) {
        const int kind = item >> 8, idx = item & 255, type = idx >> 7, r = idx & 127;
        MixSrc X;
        X.Q = (const bf16_t*)(ws + (type == 0 ? WS_RQ : WS_MQ)); X.K = (const bf16_t*)(ws + (type == 0 ? WS_RK : WS_MK)); X.V = (const bf16_t*)(ws + (type == 0 ? WS_RV : WS_MV));
        X.GT = (const bf16_t*)(ws + (type == 0 ? WS_RG : WS_MO)); X.gain = type == 0 ? a.in[16] : a.in[17];
        int h, seq, qt0 = 0, nq = 1;
        if (kind == 0) { seq = 32 + (r >> 6); h = (r >> 4) & 3; qt0 = r & 15; } else { seq = r >> 2; h = r & 3; nq = 2; }
        X.cumF = (const float*)(ws + WS_GCUM) + (size_t)h * M; X.cumB = (const float*)(ws + WS_GCUM) + (size_t)(4 + h) * M;
        X.liF = (const float*)(ws + WS_GLI) + (size_t)h * M; X.liB = (const float*)(ws + WS_GLI) + (size_t)(4 + h) * M;
        X.lgf = logsigf(a.in[14][h]); X.lgb = logsigf(a.in[14][4 + h]);
        if (kind < 2) { for (int q = 0; q < nq; ++q) mix_attn_item(F, a, X, type, seq, h, qt0 + q); }
        else mix_state_item(F, a, X, type, seq, h);
    }
    __syncthreads();
}

__device__ __forceinline__ void p6_norm2(Frame& F, const Args& a) {
    const int gw = F.vcu * NWAVES + F.wave, NGW = F.G * NWAVES, lane = F.lane;
    const float* mod = (const float*)(a.ws + WS_MOD);
    for (int m = gw; m < M; m += NGW) {
        const int cnd = cond_of(m);
        const f32x4* xr = (const f32x4*)(a.out + O_Y + (size_t)m * D) + lane;
        f32x4 v[4]; float ss = 0.f;
#pragma unroll
        for (int j = 0; j < 4; ++j) { v[j] = xr[64 * j]; ss += (v[j].x * v[j].x + v[j].y * v[j].y) + (v[j].z * v[j].z + v[j].w * v[j].w); }
        const float rstd = rsqrtf(wave_sum(ss) * (1.f / D) + EPS);
        unsigned long long* o8 = (unsigned long long*)((bf16_t*)(a.ws + WS_H) + (size_t)m * D) + lane;
#pragma unroll
        for (int j = 0; j < 4; ++j) { const int k = 4 * (lane + 64 * j);
            const f32x4 g = *(const f32x4*)(a.in[11] + k), sc = *(const f32x4*)(mod + cnd * 6144 + 4096 + k), sh = *(const f32x4*)(mod + cnd * 6144 + 3072 + k);
            const f32x4 hh_ = v[j] * rstd * g * (sc + 1.f) + sh;
            o8[64 * j] = (unsigned long long)cvtpk(hh_.x, hh_.y) | ((unsigned long long)cvtpk(hh_.z, hh_.w) << 32); }
    }
}
__device__ __forceinline__ void p9_final(Frame& F, const Args& a) {
    const int gw = F.vcu * NWAVES + F.wave, NGW = F.G * NWAVES, lane = F.lane;
    for (int m = gw; m < M; m += NGW) {
        f32x4* xr = (f32x4*)(a.out + O_Y + (size_t)m * D) + lane;
        f32x4 v[4]; float ss = 0.f;
#pragma unroll
        for (int j = 0; j < 4; ++j) { v[j] = xr[64 * j]; ss += (v[j].x * v[j].x + v[j].y * v[j].y) + (v[j].z * v[j].z + v[j].w * v[j].w); }
        const float rstd = rsqrtf(wave_sum(ss) * (1.f / D) + EPS);
#pragma unroll
        for (int j = 0; j < 4; ++j) xr[64 * j] = v[j] * rstd * *(const f32x4*)(a.in[21] + 4 * (lane + 64 * j));
    }
}

__global__ void __launch_bounds__(NWAVES * 64, 2) mega(Args args) {
    extern __shared__ __attribute__((aligned(16))) unsigned char lds[];
    Frame F;
    F.lds = (LAS unsigned char*)lds;
    F.MISC = (volatile LAS unsigned*)(F.lds + MISC_OFF);
    F.tid = threadIdx.x; F.lane = F.tid & 63; F.wave = __builtin_amdgcn_readfirstlane(F.tid >> 6);
    F.G = gridDim.x; { const int bx = blockIdx.x; F.vcu = (F.G % 8 == 0) ? (bx % 8) * (F.G / 8) + bx / 8 : bx; }
    unsigned char* ws = args.ws;
    F.ctl = (gu32*)(ws + WS_CTL);
    for (int u = F.tid; u < (LDS_BYTES - LDSCTL_OFF) / 4; u += NWAVES * 64) ((LAS unsigned*)(F.lds + LDSCTL_OFF))[u] = 0u;
    __syncthreads();
    XcdBarrier bar = xcd_barrier_post((unsigned*)(F.ctl + CW_BAR) + args.li * XCD_BAR_WORDS, F.MISC + 8);
    const int lo = args.ph_lo, hi = args.ph_hi;
#ifndef REP_PHASE
#define REP_PHASE -1
#endif
#define IN(k) (lo <= (k) && (k) < hi)
#define REPS(k) ((k) == REP_PHASE ? 2 : 1)
#define BOTH(k) (IN(k) && IN((k) + 1))
    if (IN(0)) for (int rep_ = 0; rep_ < REPS(0); ++rep_) { p0_prologue(F, args); if (BOTH(0)) xcd_barrier(bar); }
    if (IN(1)) for (int rep_ = 0; rep_ < REPS(1); ++rep_) { p1_norm_gates(F, args); if (BOTH(1)) xcd_barrier(bar); }
    if (IN(2)) for (int rep_ = 0; rep_ < REPS(2); ++rep_) {
        pg8::Gemm g{(const bf16_t*)(ws + WS_H), (const bf16_t*)(ws + WS_WIN), M, 4096, D}; pg8::StaticOrder S; S.init(M, 4096, F.G, (int)blockIdx.x);
        pg8::EpiProj E{ws, (const float*)(ws + WS_ROPE)};
        pg8::gemm_phase<pg8::EpiProj, pg8::StaticOrder, true, true>(F.lds + RING_OFF, g, S, E);
        if (BOTH(2)) xcd_barrier(bar);
    }
    if (IN(3)) for (int rep_ = 0; rep_ < REPS(3); ++rep_) { p3_conv_cumsum(F, args); if (BOTH(3)) xcd_barrier(bar); }
    if (IN(4)) for (int rep_ = 0; rep_ < REPS(4); ++rep_) { p4_mixer(F, args); if (BOTH(4)) xcd_barrier(bar); }
    if (IN(5)) for (int rep_ = 0; rep_ < REPS(5); ++rep_) {
        pg8::Gemm g{(const bf16_t*)(ws + WS_MIX), (const bf16_t*)(ws + WS_WOUT), M, D, D}; pg8::StaticOrder S; S.init(M, D, F.G, (int)blockIdx.x);
        pg8::EpiRes E{args.in[0], args.in[1], args.out + O_Y, (const float*)(ws + WS_MOD) + 2048};
        pg8::gemm_phase<pg8::EpiRes, pg8::StaticOrder, true, true>(F.lds + RING_OFF, g, S, E);
        if (BOTH(5)) xcd_barrier(bar);
    }
    if (IN(6)) for (int rep_ = 0; rep_ < REPS(6); ++rep_) { p6_norm2(F, args); if (BOTH(6)) xcd_barrier(bar); }
    if (IN(7)) for (int rep_ = 0; rep_ < REPS(7); ++rep_) {
        pg8::Gemm g{(const bf16_t*)(ws + WS_H), (const bf16_t*)(ws + WS_W1), M, FF, D}; pg8::StaticOrder S; S.init(M, FF, F.G, (int)blockIdx.x);
        pg8::EpiRelu2 E{(bf16_t*)(ws + WS_U)};
        pg8::gemm_phase<pg8::EpiRelu2, pg8::StaticOrder, true, true>(F.lds + RING_OFF, g, S, E);
        if (BOTH(7)) xcd_barrier(bar);
    }
    if (IN(8)) for (int rep_ = 0; rep_ < REPS(8); ++rep_) {
        pg8::Gemm g{(const bf16_t*)(ws + WS_U), (const bf16_t*)(ws + WS_W2), M, D, FF}; pg8::StaticOrder S; S.init(M, D, F.G, (int)blockIdx.x);
        pg8::EpiRes E{args.out + O_Y, args.out + O_Y + (size_t)NP * D, args.out + O_Y, (const float*)(ws + WS_MOD) + 5120};
        pg8::gemm_phase<pg8::EpiRes, pg8::StaticOrder, true, true>(F.lds + RING_OFF, g, S, E);
        if (BOTH(8)) xcd_barrier(bar);
    }
    if (IN(9)) for (int rep_ = 0; rep_ < REPS(9); ++rep_) { p9_final(F, args); }
#undef IN
#undef BOTH
}

extern "C" void kernel_launch(void* const* d_in, const int* in_sizes, int n_in, void* d_out, int out_size, void* d_ws, size_t ws_size, hipStream_t stream) {
    static int grid = 0;
    if (grid == 0) {
        if (n_in != 22 || ws_size < WS_END) { fprintf(stderr, "kernel_launch: unexpected n_in %d / ws_size %zu\n", n_in, ws_size); grid = -1; return; }
        int dev = 0, cus = 0, per_cu = 0;
        if (hipGetDevice(&dev) != hipSuccess || hipDeviceGetAttribute(&cus, hipDeviceAttributeMultiprocessorCount, dev) != hipSuccess) { grid = -1; return; }
        if (hipFuncSetAttribute((const void*)mega, hipFuncAttributeMaxDynamicSharedMemorySize, LDS_BYTES) != hipSuccess) { fprintf(stderr, "kernel_launch: hipFuncSetAttribute failed\n"); grid = -1; return; }
        if (hipOccupancyMaxActiveBlocksPerMultiprocessor(&per_cu, (const void*)mega, NWAVES * 64, LDS_BYTES) != hipSuccess || per_cu < 1) fprintf(stderr, "kernel_launch: occupancy query says %d\n", per_cu);
        (void)hipGetLastError();
        grid = cus;
    }
    if (grid < 0) return;
    P p{};
    p.xp = (const float*)d_in[0]; p.xs = (const float*)d_in[1]; p.st_ret = (const float*)d_in[2]; p.st_C = (const float*)d_in[3];
    p.st_n = (const float*)d_in[4]; p.st_m = (const float*)d_in[5]; p.c = (const float*)d_in[6]; p.cctx = (const float*)d_in[7];
    p.w_ada = (const float*)d_in[8]; p.b_ada = (const float*)d_in[9]; p.n1g = (const float*)d_in[10]; p.n2g = (const float*)d_in[11];
    p.w_in = (const float*)d_in[12]; p.conv_w = (const float*)d_in[13]; p.decay = (const float*)d_in[14]; p.gbias = (const float*)d_in[15];
    p.rgn = (const float*)d_in[16]; p.mgn = (const float*)d_in[17]; p.w_out = (const float*)d_in[18]; p.w_ff1 = (const float*)d_in[19];
    p.w_ff2 = (const float*)d_in[20]; p.fg = (const float*)d_in[21];
    p.out = (float*)d_out; p.ws = (unsigned char*)d_ws;
    (void)hipMemsetAsync((char*)d_ws + WS_CTL, 0, CTL_ZERO_BYTES, stream);
    Args a{};
    for (int i = 0; i < 22; ++i) a.in[i] = (const float*)d_in[i];
    a.out = (float*)d_out; a.ws = (unsigned char*)d_ws;
    int li = 0;
#define MEGA(lo_, hi_) do { a.ph_lo = (lo_); a.ph_hi = (hi_); a.li = li++; hipLaunchKernelGGL(mega, dim3(grid), dim3(NWAVES * 64), LDS_BYTES, stream, a); } while (0)
#ifndef MIX_NAIVE
#define MIX_NAIVE 0
#endif
#if MIX_NAIVE
    MEGA(0, 4);
    k_mix<<<dim3(M / 16, 4, 2), 256, 0, stream>>>(p);
    k_states<<<dim3(32, 4, 4), 256, 0, stream>>>(p);
    MEGA(5, 10);
#else
    MEGA(0, 10);
#endif
}
```

```cpp
#include <hip/hip_runtime.h>
#include <cstdint>
#include <cstdio>

typedef unsigned short bf16_t;
#ifndef SPIN_PHASE
#define SPIN_PHASE -1
#endif
#ifndef SPIN_BLOCK
#define SPIN_BLOCK 0
#endif

constexpr int D = 1024, NP = 32 * 256, NS = 2 * 2048, M = NP + NS;
constexpr int TP = 256, TS = 2048;
constexpr int INC = 4112, FF = 4096, NH = 4, HD = 128, W5 = 512;
constexpr float EPS = 1e-6f;

constexpr size_t MiB = 1u << 20;
constexpr size_t WS_CTL = 0;
constexpr size_t WS_MOD = 1 * MiB;
constexpr size_t WS_ROPE = 1 * MiB + 128 * 1024;
constexpr size_t WS_GATES = 2 * MiB;
constexpr size_t WS_GLI = 3 * MiB;
constexpr size_t WS_GCUM = 3 * MiB + 512 * 1024;
constexpr size_t WS_WIN = 4 * MiB;
constexpr size_t WS_WOUT = 12 * MiB;
constexpr size_t WS_W1 = 14 * MiB;
constexpr size_t WS_W2 = 22 * MiB;
constexpr size_t WS_H = 32 * MiB;
constexpr size_t WS_MIX = 56 * MiB;
constexpr size_t WS_X2 = 32 * MiB;
constexpr size_t WS_RQ = 80 * MiB;
constexpr size_t WS_RK = 92 * MiB;
constexpr size_t WS_RV = 104 * MiB;
constexpr size_t WS_RG = 116 * MiB;
constexpr size_t WS_MQKP = 128 * MiB;
constexpr size_t WS_MV = 152 * MiB;
constexpr size_t WS_MO = 164 * MiB;
constexpr size_t WS_MQ = 176 * MiB;
constexpr size_t WS_MK = 188 * MiB;
constexpr size_t WS_U = 80 * MiB;
constexpr size_t WS_LOC = 200 * MiB;
constexpr size_t WS_SST = 236 * MiB;
constexpr int ST_ELEMS = 129 * 128;
constexpr size_t WS_END = 256 * MiB;

constexpr size_t O_Y = 0;
constexpr size_t O_RET = (size_t)M * D;
constexpr size_t O_C = O_RET + (size_t)32 * 2 * 4 * 128 * 128;
constexpr size_t O_N = O_C + (size_t)32 * 2 * 4 * 128 * 128;
constexpr size_t O_M = O_N + (size_t)32 * 2 * 4 * 128;

__device__ __forceinline__ float bf2f(bf16_t v) { return __uint_as_float((unsigned)v << 16); }
__device__ __forceinline__ bf16_t f2bf(float f) { unsigned u = __float_as_uint(f); return (bf16_t)((u + 0x7fffu + ((u >> 16) & 1u)) >> 16); }
__device__ __forceinline__ float siluf(float x) { return x / (1.f + __expf(-x)); }
__device__ __forceinline__ float sigmf(float x) { return 1.f / (1.f + __expf(-x)); }
__device__ __forceinline__ float logsigf(float x) { return fminf(x, 0.f) - log1pf(__expf(-fabsf(x))); }
__device__ __forceinline__ int cond_of(int m) { return m < NP ? 0 : 1 + (m - NP) / TS; }

struct P {
    const float *xp, *xs, *st_ret, *st_C, *st_n, *st_m, *c, *cctx, *w_ada, *b_ada, *n1g, *n2g, *w_in, *conv_w, *decay, *gbias, *rgn, *mgn, *w_out, *w_ff1, *w_ff2, *fg;
    float* out; unsigned char* ws;
};
__device__ __forceinline__ const float* xrow(const P& p, int m) { return m < NP ? p.xp + (size_t)m * D : p.xs + (size_t)(m - NP) * D; }

__global__ void k_wt(const float* W, int ldw, int K, bf16_t* WT) {
    __shared__ float t[32][33];
    const int n0 = blockIdx.x * 32, k0 = blockIdx.y * 32, tx = threadIdx.x, ty = threadIdx.y;
    for (int i = ty; i < 32; i += 8) t[i][tx] = W[(size_t)(k0 + i) * ldw + n0 + tx];
    __syncthreads();
    for (int i = ty; i < 32; i += 8) WT[(size_t)(n0 + i) * K + k0 + tx] = f2bf(t[tx][i]);
}

__global__ void k_mod(P p) {
    const int j = blockIdx.x * 256 + threadIdx.x, cnd = blockIdx.y;
    const float* cv = cnd == 0 ? p.cctx : p.c + (size_t)(cnd - 1) * D;
    float acc = 0.f;
    for (int k = 0; k < D; ++k) acc += siluf(cv[k]) * p.w_ada[(size_t)k * 6144 + j];
    ((float*)(p.ws + WS_MOD))[cnd * 6144 + j] = acc + p.b_ada[j];
}

__global__ void k_rope(P p) {
    const int pos = blockIdx.x, f = threadIdx.x;
    const float inv = (float)exp(-(double)f / 32.0 * log(10000.0));
    const float ang = (float)pos * inv;
    float* rc = (float*)(p.ws + WS_ROPE);
    rc[pos * 32 + f] = (float)cos((double)ang);
    rc[2048 + pos * 32 + f] = (float)sin((double)ang);
}

__device__ __forceinline__ float block_sum256(float v, float* red) {
    for (int o = 32; o > 0; o >>= 1) v += __shfl_xor(v, o);
    __syncthreads();
    if ((threadIdx.x & 63) == 0) red[threadIdx.x >> 6] = v;
    __syncthreads();
    return red[0] + red[1] + red[2] + red[3];
}

__global__ void k_norm(P p, int which) {
    __shared__ float red[4];
    __shared__ float gsum[16][4];
    const int m = blockIdx.x, tid = threadIdx.x, cnd = cond_of(m);
    const float* xr = which == 0 ? xrow(p, m) : p.out + O_Y + (size_t)m * D;
    const float* mod = (const float*)(p.ws + WS_MOD) + cnd * 6144;
    const float* sh = mod + (which == 0 ? 0 : 3072);
    const float* sc = mod + (which == 0 ? 1024 : 4096);
    const float* g = which == 0 ? p.n1g : p.n2g;
    float v[4], ss = 0.f;
    for (int i = 0; i < 4; ++i) { v[i] = xr[tid + 256 * i]; ss += v[i] * v[i]; }
    ss = block_sum256(ss, red);
    const float rstd = rsqrtf(ss * (1.f / D) + EPS);
    bf16_t* H = (bf16_t*)(p.ws + WS_H) + (size_t)m * D;
    float h[4];
    for (int i = 0; i < 4; ++i) { const int k = tid + 256 * i; h[i] = v[i] * rstd * g[k] * (1.f + sc[k]) + sh[k]; H[k] = f2bf(h[i]); }
    if (which == 0) {
        float ga[16];
        for (int j = 0; j < 16; ++j) ga[j] = 0.f;
        for (int i = 0; i < 4; ++i) { const int k = tid + 256 * i; const float* wr = p.w_in + (size_t)k * INC + 4096;
            for (int j = 0; j < 16; ++j) ga[j] += h[i] * wr[j]; }
        for (int j = 0; j < 16; ++j) { float s = ga[j]; for (int o = 32; o > 0; o >>= 1) s += __shfl_xor(s, o); if ((tid & 63) == 0) gsum[j][tid >> 6] = s; }
        __syncthreads();
        if (tid < 16) ((float*)(p.ws + WS_GATES))[(size_t)m * 16 + tid] = gsum[tid][0] + gsum[tid][1] + gsum[tid][2] + gsum[tid][3] + p.gbias[tid];
    }
}

enum { EPI_PROJ = 0, EPI_RES1 = 1, EPI_RELU2 = 2, EPI_RES2 = 3 };
template <int EPI>
__global__ void __launch_bounds__(256) k_gemm(P p, const bf16_t* A, const bf16_t* WT, int K) {
    __shared__ float As[16][68];
    __shared__ float Bs[16][132];
    __shared__ float Cs[64][129];
    const int tid = threadIdx.x, m0 = blockIdx.y * 64, n0 = blockIdx.x * 128;
    const int ty = tid >> 4, tx = tid & 15;
    float acc[4][8];
    for (int i = 0; i < 4; ++i) for (int j = 0; j < 8; ++j) acc[i][j] = 0.f;
    for (int k0 = 0; k0 < K; k0 += 16) {
        { const int r = tid >> 2, kk = (tid & 3) * 4; const bf16_t* a = A + (size_t)(m0 + r) * K + k0 + kk;
          for (int j = 0; j < 4; ++j) As[kk + j][r] = bf2f(a[j]); }
        { const int r = tid >> 1, kk = (tid & 1) * 8; const bf16_t* b = WT + (size_t)(n0 + r) * K + k0 + kk;
          for (int j = 0; j < 8; ++j) Bs[kk + j][r] = bf2f(b[j]); }
        __syncthreads();
        for (int kk = 0; kk < 16; ++kk) {
            float a[4], b[8];
            for (int i = 0; i < 4; ++i) a[i] = As[kk][ty * 4 + i];
            for (int j = 0; j < 8; ++j) b[j] = Bs[kk][tx * 8 + j];
            for (int i = 0; i < 4; ++i) for (int j = 0; j < 8; ++j) acc[i][j] += a[i] * b[j];
        }
        __syncthreads();
    }
    for (int i = 0; i < 4; ++i) for (int j = 0; j < 8; ++j) Cs[ty * 4 + i][tx * 8 + j] = acc[i][j];
    __syncthreads();
    if (EPI == EPI_PROJ) {
        const int sec = n0 / 512, hc = n0 % 512;
        const float* rc = (const float*)(p.ws + WS_ROPE);
        for (int e = tid; e < 64 * 128; e += 256) {
            const int r = e >> 7, d = e & 127, m = m0 + r;
            float v = Cs[r][d];
            if (sec <= 1) {
                if (sec == 1) v *= 0.08838834764831845f;
                if (m >= NP) {
                    const int t = (m - NP) % TS, dd = d & 63, f = dd & 31, pos = dd < 32 ? t / 64 : t % 64;
                    const float cs = rc[pos * 32 + f], sn = rc[2048 + pos * 32 + f];
                    float o = Cs[r][d ^ 64]; if (sec == 1) o *= 0.08838834764831845f;
                    v = d < 64 ? v * cs - o * sn : o * sn + v * cs;
                }
                ((bf16_t*)(p.ws + (sec == 0 ? WS_RQ : WS_RK)))[(size_t)m * W5 + hc + d] = f2bf(v);
            } else if (sec == 2) ((bf16_t*)(p.ws + WS_RV))[(size_t)m * W5 + hc + d] = f2bf(v);
            else if (sec == 3) ((bf16_t*)(p.ws + WS_RG))[(size_t)m * W5 + hc + d] = f2bf(siluf(v));
            else if (sec <= 5) ((bf16_t*)(p.ws + WS_MQKP))[(size_t)m * 1024 + (n0 - 2048) + d] = f2bf(v);
            else if (sec == 6) ((bf16_t*)(p.ws + WS_MV))[(size_t)m * W5 + hc + d] = f2bf(v);
            else ((bf16_t*)(p.ws + WS_MO))[(size_t)m * W5 + hc + d] = f2bf(sigmf(v));
        }
    } else if (EPI == EPI_RES1) {
        for (int e = tid; e < 64 * 128; e += 256) { const int r = e >> 7, n = n0 + (e & 127), m = m0 + r;
            const float g1 = ((const float*)(p.ws + WS_MOD))[cond_of(m) * 6144 + 2048 + n];
            p.out[O_Y + (size_t)m * D + n] = xrow(p, m)[n] + g1 * Cs[r][e & 127]; }
    } else if (EPI == EPI_RELU2) {
        for (int e = tid; e < 64 * 128; e += 256) { const int r = e >> 7, n = n0 + (e & 127), m = m0 + r;
            const float v = fmaxf(Cs[r][e & 127], 0.f);
            ((bf16_t*)(p.ws + WS_U))[(size_t)m * FF + n] = f2bf(v * v); }
    } else {
        for (int e = tid; e < 64 * 128; e += 256) { const int r = e >> 7, n = n0 + (e & 127), m = m0 + r;
            const float g2 = ((const float*)(p.ws + WS_MOD))[cond_of(m) * 6144 + 5120 + n];
            p.out[O_Y + (size_t)m * D + n] += g2 * Cs[r][e & 127]; }
    }
}

__global__ void k_conv(P p) {
    const int m = blockIdx.x, T = m < NP ? TP : TS, t = m < NP ? m % TP : (m - NP) % TS;
    const bf16_t* X = (const bf16_t*)(p.ws + WS_MQKP);
    for (int c = threadIdx.x; c < 1024; c += 256) {
        float v = p.conv_w[1024 + c] * bf2f(X[(size_t)m * 1024 + c]);
        if (t > 0) v += p.conv_w[c] * bf2f(X[(size_t)(m - 1) * 1024 + c]);
        if (t < T - 1) v += p.conv_w[2048 + c] * bf2f(X[(size_t)(m + 1) * 1024 + c]);
        v = siluf(v);
        if (c < 512) ((bf16_t*)(p.ws + WS_MQ))[(size_t)m * W5 + c] = f2bf(v);
        else ((bf16_t*)(p.ws + WS_MK))[(size_t)m * W5 + c - 512] = f2bf(v * 0.08838834764831845f);
    }
}

__global__ void k_gates(P p) {
    const int id = blockIdx.x * 64 + threadIdx.x;
    if (id >= 34 * 8) return;
    const int seq = id / 8, h = id % 4, dir = (id / 4) % 2;
    const int T = seq < 32 ? TP : TS, mbase = seq < 32 ? seq * TP : NP + (seq - 32) * TS;
    const float* G = (const float*)(p.ws + WS_GATES);
    float* LI = (float*)(p.ws + WS_GLI) + (size_t)(dir * 4 + h) * M;
    float* CU = (float*)(p.ws + WS_GCUM) + (size_t)(dir * 4 + h) * M;
    float cum = 0.f;
    for (int i = 0; i < T; ++i) {
        const int m = mbase + (dir == 0 ? i : T - 1 - i);
        cum += logsigf(G[(size_t)m * 16 + dir * 8 + 4 + h]);
        CU[m] = cum; LI[m] = G[(size_t)m * 16 + dir * 8 + h];
    }
}

__global__ void __launch_bounds__(256) k_mix(P p) {
    __shared__ float qs[16][128];
    __shared__ float ks[32][129];
    __shared__ float vs[32][128];
    __shared__ float pf[16][32], pb[16][32];
    __shared__ float os[16][129];
    const int tid = threadIdx.x, m0 = blockIdx.x * 16, h = blockIdx.y, type = blockIdx.z;
    const bool lat = m0 >= NP;
    const int T = lat ? TS : TP, sb = lat ? NP + ((m0 - NP) / TS) * TS : (m0 / TP) * TP, t0 = m0 - sb;
    const bf16_t* Q = (const bf16_t*)(p.ws + (type == 0 ? WS_RQ : WS_MQ));
    const bf16_t* Kp = (const bf16_t*)(p.ws + (type == 0 ? WS_RK : WS_MK));
    const bf16_t* V = (const bf16_t*)(p.ws + (type == 0 ? WS_RV : WS_MV));
    const float lgf = logsigf(p.decay[h]), lgb = logsigf(p.decay[4 + h]);
    const float* LI0 = (const float*)(p.ws + WS_GLI) + (size_t)h * M;
    const float* LI1 = (const float*)(p.ws + WS_GLI) + (size_t)(4 + h) * M;
    const float* CU0 = (const float*)(p.ws + WS_GCUM) + (size_t)h * M;
    const float* CU1 = (const float*)(p.ws + WS_GCUM) + (size_t)(4 + h) * M;
    for (int e = tid; e < 16 * 128; e += 256) qs[e >> 7][e & 127] = bf2f(Q[(size_t)(m0 + (e >> 7)) * W5 + h * HD + (e & 127)]);
    const int e_ = tid & 127, rh = tid >> 7;
    float of[8], ob[8];
    for (int i = 0; i < 8; ++i) { of[i] = 0.f; ob[i] = 0.f; }
    float den = 0.f;
    for (int s0 = 0; s0 < T; s0 += 32) {
        __syncthreads();
        for (int e = tid; e < 32 * 128; e += 256) { const int s = e >> 7, d = e & 127; const size_t a = (size_t)(sb + s0 + s) * W5 + h * HD + d;
            ks[s][d] = bf2f(Kp[a]); vs[s][d] = bf2f(V[a]); }
        __syncthreads();
        for (int e = tid; e < 16 * 32; e += 256) {
            const int r = e >> 5, s = e & 31, t = t0 + r, sg = s0 + s;
            float dot = 0.f;
            for (int d = 0; d < 128; ++d) dot += qs[r][d] * ks[s][d];
            float wf, wb;
            if (type == 0) {
                wf = sg < t ? __expf(lgf * (float)(t - sg)) : (sg > t ? __expf(lgb * (float)(sg - t)) : 2.f);
                wb = 0.f;
            } else {
                wf = sg <= t ? __expf(CU0[sb + t] - CU0[sb + sg] + LI0[sb + sg]) : 0.f;
                wb = sg >= t ? __expf(CU1[sb + t] - CU1[sb + sg] + LI1[sb + sg]) : 0.f;
            }
            pf[r][s] = dot * wf; pb[r][s] = dot * wb;
        }
        __syncthreads();
        if (tid < 32) { const int r = tid & 15; float a = 0.f; for (int s = 0; s < 32; ++s) a += (tid < 16 ? pf[r][s] : pb[r][s]); den += a; }
        for (int s = 0; s < 32; ++s) { const float v = vs[s][e_];
            for (int i = 0; i < 8; ++i) { of[i] += pf[rh * 8 + i][s] * v; ob[i] += pb[rh * 8 + i][s] * v; } }
    }
    __syncthreads();
    float* dens = &pf[0][0];
    if (tid < 32) dens[tid] = den;
    __syncthreads();
    if (lat) {
        const int b = (m0 - NP) / TS;
        const float* S0f = (type == 0 ? p.st_ret : p.st_C) + ((size_t)((b * 2 + 0) * 4 + h)) * 128 * 128;
        const float* S0b = (type == 0 ? p.st_ret : p.st_C) + ((size_t)((b * 2 + 1) * 4 + h)) * 128 * 128;
        for (int i = 0; i < 8; ++i) {
            const int r = rh * 8 + i, t = t0 + r;
            float af = 0.f, ab = 0.f;
            for (int d = 0; d < 128; ++d) { af += qs[r][d] * S0f[d * 128 + e_]; ab += qs[r][d] * S0b[d * 128 + e_]; }
            float cf, cb;
            if (type == 0) { cf = __expf(lgf * (float)(t + 1)); cb = __expf(lgb * (float)(T - t)); }
            else { cf = __expf(CU0[sb + t] + p.st_m[(b * 2 + 0) * 4 + h]); cb = __expf(CU1[sb + t] + p.st_m[(b * 2 + 1) * 4 + h]); }
            of[i] += cf * af; ob[i] += cb * ab;
        }
        if (type == 1 && tid < 32) {
            const int r = tid & 15, dir = tid >> 4, t = t0 + r;
            const float* n0 = p.st_n + (size_t)((b * 2 + dir) * 4 + h) * 128;
            float a = 0.f; for (int d = 0; d < 128; ++d) a += qs[r][d] * n0[d];
            const float cfb = __expf((dir == 0 ? CU0 : CU1)[sb + t] + p.st_m[(b * 2 + dir) * 4 + h]);
            dens[tid] += cfb * a;
        }
        __syncthreads();
    }
    for (int i = 0; i < 8; ++i) {
        const int r = rh * 8 + i;
        float o;
        if (type == 0) o = of[i] + ob[i];
        else o = of[i] / fmaxf(fabsf(dens[r]), 1.f) + ob[i] / fmaxf(fabsf(dens[16 + r]), 1.f);
        os[r][e_] = o;
    }
    __syncthreads();
    for (int i = 0; i < 8; ++i) {
        const int r = rh * 8 + i, m = m0 + r;
        float mu = 0.f; for (int d = 0; d < 128; ++d) mu += os[r][d];
        mu *= (1.f / 128.f);
        float var = 0.f; for (int d = 0; d < 128; ++d) { const float x = os[r][d] - mu; var += x * x; }
        var *= (1.f / 128.f);
        const float y = (os[r][e_] - mu) * rsqrtf(var + EPS);
        const float g = (type == 0 ? p.rgn : p.mgn)[h * HD + e_];
        const float gate = bf2f(((const bf16_t*)(p.ws + (type == 0 ? WS_RG : WS_MO)))[(size_t)m * W5 + h * HD + e_]);
        ((bf16_t*)(p.ws + WS_MIX))[(size_t)m * D + type * 512 + h * HD + e_] = f2bf(y * g * gate);
    }
}

__global__ void __launch_bounds__(256) k_states(P p) {
    __shared__ float ks[32][128], vs[32][128], ws_[256];
    __shared__ float red[4];
    const int tid = threadIdx.x, b = blockIdx.x, h = blockIdx.y, type = blockIdx.z >> 1, dir = blockIdx.z & 1;
    const int sb = b * TP;
    const bf16_t* Kp = (const bf16_t*)(p.ws + (type == 0 ? WS_RK : WS_MK));
    const bf16_t* V = (const bf16_t*)(p.ws + (type == 0 ? WS_RV : WS_MV));
    float mfin = 0.f;
    {
        const int s = tid; float lw;
        if (type == 0) { const float lg = logsigf(p.decay[dir * 4 + h]); lw = lg * (float)(dir == 0 ? TP - 1 - s : s); }
        else {
            const float* LI = (const float*)(p.ws + WS_GLI) + (size_t)(dir * 4 + h) * M;
            const float* CU = (const float*)(p.ws + WS_GCUM) + (size_t)(dir * 4 + h) * M;
            const float tot = CU[sb + (dir == 0 ? TP - 1 : 0)];
            lw = tot - CU[sb + s] + LI[sb + s];
            float mx = lw; for (int o = 32; o > 0; o >>= 1) mx = fmaxf(mx, __shfl_xor(mx, o));
            if ((tid & 63) == 0) red[tid >> 6] = mx;
            __syncthreads();
            mfin = fmaxf(fmaxf(fmaxf(red[0], red[1]), fmaxf(red[2], red[3])), tot);
            lw -= mfin;
        }
        ws_[s] = __expf(lw);
    }
    const int dk0 = (tid >> 4) * 8, dv0 = (tid & 15) * 8;
    float acc[8][8]; float nacc = 0.f;
    for (int i = 0; i < 8; ++i) for (int j = 0; j < 8; ++j) acc[i][j] = 0.f;
    for (int s0 = 0; s0 < TP; s0 += 32) {
        __syncthreads();
        for (int e = tid; e < 32 * 128; e += 256) { const int s = e >> 7, d = e & 127; const size_t a = (size_t)(sb + s0 + s) * W5 + h * HD + d;
            ks[s][d] = bf2f(Kp[a]); vs[s][d] = bf2f(V[a]); }
        __syncthreads();
        for (int s = 0; s < 32; ++s) {
            const float w = ws_[s0 + s];
            float kk[8], vv[8];
            for (int i = 0; i < 8; ++i) { kk[i] = ks[s][dk0 + i] * w; vv[i] = vs[s][dv0 + i]; }
            for (int i = 0; i < 8; ++i) for (int j = 0; j < 8; ++j) acc[i][j] += kk[i] * vv[j];
            if (tid < 128) nacc += w * ks[s][tid];
        }
    }
    float* O = p.out + (type == 0 ? O_RET : O_C) + (size_t)((b * 2 + dir) * 4 + h) * 128 * 128;
    for (int i = 0; i < 8; ++i) for (int j = 0; j < 8; ++j) O[(dk0 + i) * 128 + dv0 + j] = acc[i][j];
    if (type == 1) {
        if (tid < 128) p.out[O_N + (size_t)((b * 2 + dir) * 4 + h) * 128 + tid] = nacc;
        if (tid == 0) p.out[O_M + (b * 2 + dir) * 4 + h] = mfin;
    }
}

__global__ void k_final(P p) {
    __shared__ float red[4];
    const int m = blockIdx.x, tid = threadIdx.x;
    float* xr = p.out + O_Y + (size_t)m * D;
    float v[4], ss = 0.f;
    for (int i = 0; i < 4; ++i) { v[i] = xr[tid + 256 * i]; ss += v[i] * v[i]; }
    ss = block_sum256(ss, red);
    const float rstd = rsqrtf(ss * (1.f / D) + EPS);
    for (int i = 0; i < 4; ++i) xr[tid + 256 * i] = v[i] * rstd * p.fg[tid + 256 * i];
}


namespace pg8 {
#define PG8_LAS __attribute__((address_space(3)))
typedef short bf16x8 __attribute__((ext_vector_type(8)));
typedef float f32x4 __attribute__((ext_vector_type(4)));
typedef unsigned u32x4 __attribute__((ext_vector_type(4)));
constexpr int BM = 256, BK = 64, HALF = 128, HTB = HALF * BK * 2  , STAGE_BYTES = 8 * HTB, NXCD = 8, WGM = 8;

__host__ __device__ __forceinline__ int lds_byte(int r, int c) { const int st = (r >> 4) * 2 + (c >> 5), rr = r & 15, cc = c & 31, ob = rr * 64 + cc * 2; return st * 1024 + (ob ^ (((ob >> 9) & 1) << 5)); }
__host__ __device__ __forceinline__ void stage_rc(int b, int& R, int& C) { const int st = b / 1024, sb = b % 1024, swz = sb ^ (((sb >> 9) & 1) << 5); R = (st >> 1) * 16 + swz / 64; C = (st & 1) * 32 + (swz % 64) / 2; }
__host__ __device__ __forceinline__ int perm32(int rho) { const int n = rho >> 4, i = rho & 15; return 8 * (i >> 2) + 4 * n + (i & 3); }

struct Unit { int pm, pn; };
struct Gemm { const bf16_t* A; const bf16_t* Bt; int M, N, K; };

struct StaticOrder {
    int nM, nN, nwg, G, c;
    __host__ __device__ void init(int M, int N, int G_, int c_) { nM = M / BM; nN = N / BM; nwg = nM * nN; G = G_; c = c_; }
    __host__ __device__ bool next(int i, Unit& u) const {
        const long L = (long)i * G + c; if (L >= nwg) return false;
        int wgid = (int)L; { const int q = nwg / NXCD, r = nwg % NXCD, xcd = wgid % NXCD, off = wgid / NXCD; wgid = (xcd < r ? xcd * (q + 1) : r * (q + 1) + (xcd - r) * q) + off; }
        const int nig = WGM * nN, gid = wgid / nig, fm = gid * WGM, gsz = (nM - fm) < WGM ? (nM - fm) : WGM;
        u.pm = fm + ((wgid % nig) % gsz); u.pn = (wgid % nig) / gsz; return true;
    }
    __device__ __forceinline__ void a_ready(const Unit&) const {}
    __device__ __forceinline__ void done(const Unit&) const {}
};


__device__ __forceinline__ unsigned cvt_pk_bf16(float lo, float hi) { unsigned r; asm volatile("v_cvt_pk_bf16_f32 %0, %1, %2" : "=v"(r) : "v"(lo), "v"(hi)); return r; }
__device__ __forceinline__ u32x4 pack8(const f32x4& a, const f32x4& b) { u32x4 w; w.x = cvt_pk_bf16(a[0], a[1]); w.y = cvt_pk_bf16(a[2], a[3]); w.z = cvt_pk_bf16(b[0], b[1]); w.w = cvt_pk_bf16(b[2], b[3]); return w; }
__device__ __forceinline__ f32x4 silu4(const f32x4& v) { f32x4 o; for (int i = 0; i < 4; ++i) o[i] = v[i] / (1.f + __expf(-v[i])); return o; }
__device__ __forceinline__ f32x4 sigm4(const f32x4& v) { f32x4 o; for (int i = 0; i < 4; ++i) o[i] = 1.f / (1.f + __expf(-v[i])); return o; }

struct EpiProj {
    static constexpr bool PERM = true, PAIR = true, AFTER_DRAIN = false;
    unsigned char* ws; const float* rope;
    __device__ __forceinline__ void operator()(const f32x4 (&acc)[2][2][4][2], const Unit& u, int wr, int wc, int fr, int fq) const {
        const int sec = u.pn >> 1, hh = wc >> 1, dl = 32 * (wc & 1) + 8 * fq;
        bf16_t* dst; int ld, colb;
        if (sec == 4 || sec == 5) { dst = (bf16_t*)(ws + WS_MQKP); ld = 1024; colb = (u.pn - 8) * 256 + hh * 128; }
        else { const size_t off = sec == 0 ? WS_RQ : sec == 1 ? WS_RK : sec == 2 ? WS_RV : sec == 3 ? WS_RG : sec == 6 ? WS_MV : WS_MO;
               dst = (bf16_t*)(ws + off); ld = 512; colb = (u.pn & 1) * 256 + hh * 128; }
        const bool lat = u.pm >= NP / 256;
#pragma unroll
        for (int ai = 0; ai < 2; ++ai)
#pragma unroll
            for (int m = 0; m < 4; ++m) {
                const int row = u.pm * BM + ai * HALF + wr * 64 + m * 16 + fr;
                f32x4 a0 = acc[ai][0][m][0], a1 = acc[ai][0][m][1], b0 = acc[ai][1][m][0], b1 = acc[ai][1][m][1];
                if (sec <= 1) {
                    if (sec == 1) { a0 = a0 * 0.08838834764831845f; a1 = a1 * 0.08838834764831845f; b0 = b0 * 0.08838834764831845f; b1 = b1 * 0.08838834764831845f; }
                    if (lat) {
                        const int t = (row - NP) & (TS - 1), pos = (wc & 1) ? (t & 63) : (t >> 6);
                        const float* rp = rope + pos * 32 + 8 * fq;
                        const f32x4 c0 = *(const f32x4*)rp, c1 = *(const f32x4*)(rp + 4), s0 = *(const f32x4*)(rp + 2048), s1 = *(const f32x4*)(rp + 2052);
                        const f32x4 n0 = a0 * c0 - b0 * s0, n1 = a1 * c1 - b1 * s1, m0 = a0 * s0 + b0 * c0, m1 = a1 * s1 + b1 * c1;
                        a0 = n0; a1 = n1; b0 = m0; b1 = m1;
                    }
                } else if (sec == 3) { a0 = silu4(a0); a1 = silu4(a1); b0 = silu4(b0); b1 = silu4(b1); }
                else if (sec == 7) { a0 = sigm4(a0); a1 = sigm4(a1); b0 = sigm4(b0); b1 = sigm4(b1); }
                bf16_t* rp = dst + (size_t)row * ld + colb + dl;
                *(u32x4*)rp = pack8(a0, a1);
                *(u32x4*)(rp + 64) = pack8(b0, b1);
            }
    }
};
struct EpiRelu2 {
    static constexpr bool PERM = true, PAIR = false, AFTER_DRAIN = false;
    bf16_t* U;
    __device__ __forceinline__ void operator()(const f32x4 (&acc)[2][2][4][2], const Unit& u, int wr, int wc, int fr, int fq) const {
        const int row0 = u.pm * BM + wr * 64 + fr, col0 = u.pn * BM + wc * 32 + 8 * fq;
#pragma unroll
        for (int ai = 0; ai < 2; ++ai)
#pragma unroll
            for (int m = 0; m < 4; ++m) { bf16_t* rowp = U + (size_t)(row0 + ai * HALF + m * 16) * FF + col0;
#pragma unroll
                for (int bj = 0; bj < 2; ++bj) { f32x4 v0 = acc[ai][bj][m][0], v1 = acc[ai][bj][m][1];
                    for (int i = 0; i < 4; ++i) { const float x = fmaxf(v0[i], 0.f), y = fmaxf(v1[i], 0.f); v0[i] = x * x; v1[i] = y * y; }
                    *(u32x4*)(rowp + bj * HALF) = pack8(v0, v1); } }
    }
};
struct EpiRes {
    static constexpr bool PERM = false, PAIR = false, AFTER_DRAIN = false;
    const float* base_p; const float* base_s; float* out; const float* gate;
    __device__ __forceinline__ void operator()(const f32x4 (&acc)[2][2][4][2], const Unit& u, int wr, int wc, int fr, int fq) const {
        const int row0 = u.pm * BM + wr * 64 + fr, col0 = u.pn * BM + wc * 32 + 4 * fq;
        const int cnd = u.pm < NP / 256 ? 0 : 1 + (u.pm - NP / 256) / (TS / 256);
        const float* base = u.pm < NP / 256 ? base_p : base_s - (size_t)NP * D;
        f32x4 gv[2][2];
#pragma unroll
        for (int bj = 0; bj < 2; ++bj)
#pragma unroll
            for (int n = 0; n < 2; ++n) gv[bj][n] = *(const f32x4*)(gate + cnd * 6144 + col0 + bj * HALF + n * 16);
#pragma unroll
        for (int ai = 0; ai < 2; ++ai)
#pragma unroll
            for (int m = 0; m < 4; ++m) { const size_t off = (size_t)(row0 + ai * HALF + m * 16) * D + col0;
#pragma unroll
                for (int bj = 0; bj < 2; ++bj)
#pragma unroll
                    for (int n = 0; n < 2; ++n) { const f32x4 b = *(const f32x4*)(base + off + bj * HALF + n * 16);
                        *(f32x4*)(out + off + bj * HALF + n * 16) = b + gv[bj][n] * acc[ai][bj][m][n]; } }
    }
};
template <class Epi, class Sched, bool ALIGN_EPI = false, bool SP2 = false>
__device__ __forceinline__ void gemm_phase(PG8_LAS unsigned char* lds, const Gemm g, const Sched& S, const Epi& E) {
    const int tid = threadIdx.x, wid = __builtin_amdgcn_readfirstlane(tid >> 6), lane = tid & 63, wr = wid >> 2, wc = wid & 3, fr = lane & 15, fq = lane >> 4;
    const int K = g.K, nt = K / BK;
    unsigned voffA[2], voffB[2];
#pragma unroll
    for (int i = 0; i < 2; ++i) { int R, C; stage_rc(tid * 16 + i * 8192, R, C); int Rb = Epi::PERM ? ((R & ~31) + perm32(R & 31)) : R;
        if (Epi::PAIR) Rb = (Rb >> 6) * 128 + (Rb & 63);
        voffA[i] = (unsigned)(R * K + C) * 2u; voffB[i] = (unsigned)(Rb * K + C) * 2u; }
    const size_t kstep = (size_t)(BK * 2);
    const size_t hstep = (size_t)HALF * K * 2;
    const size_t hstepB = Epi::PAIR ? hstep / 2 : hstep;
    const size_t tstep = 2 * hstep;
    const unsigned ldsw = (unsigned)wid * 1024u;
    const int aoff = lds_byte(wr * 64 + fr, fq * 8), boff = lds_byte(wc * 32 + fr, fq * 8);
#define PG8_SA(b, h) (((b) * 2 + (h)) * HTB)
#define PG8_SB(b, h) ((4 + (b) * 2 + (h)) * HTB)
#define PG8_STAGE(bufoff, gbase, voff) do { _Pragma("unroll") for (int _i = 0; _i < 2; ++_i) \
        __builtin_amdgcn_global_load_lds((const unsigned*)((const char*)(gbase) + (voff)[_i]), (PG8_LAS unsigned*)(lds + (bufoff) + ldsw + _i * 8192), 16, 0, 0); } while (0)
#define PG8_LDA(dst, b, h) do { _Pragma("unroll") for (int m = 0; m < 4; ++m) _Pragma("unroll") for (int k = 0; k < 2; ++k) dst[m][k] = *(const PG8_LAS bf16x8*)(lds + PG8_SA(b, h) + aoff + m * 2048 + k * 1024); } while (0)
#define PG8_LDB(dst, b, h) do { _Pragma("unroll") for (int n = 0; n < 2; ++n) _Pragma("unroll") for (int k = 0; k < 2; ++k) dst[n][k] = *(const PG8_LAS bf16x8*)(lds + PG8_SB(b, h) + boff + n * 2048 + k * 1024); } while (0)
#define PG8_MMA(ai, bj, At, Bt) do { __builtin_amdgcn_s_setprio(1); _Pragma("unroll") for (int m = 0; m < 4; ++m) _Pragma("unroll") for (int n = 0; n < 2; ++n) _Pragma("unroll") for (int k = 0; k < 2; ++k) \
        acc[ai][bj][m][n] = __builtin_amdgcn_mfma_f32_16x16x32_bf16(Bt[n][k], At[m][k], acc[ai][bj][m][n], 0, 0, 0); __builtin_amdgcn_s_setprio(0); } while (0)
#define PG8_WAIT_V(n) asm volatile("s_waitcnt vmcnt(" #n ")" ::: "memory")
#define PG8_WAIT_L(n) asm volatile("s_waitcnt lgkmcnt(" #n ")" ::: "memory")
#define PG8_BAR __builtin_amdgcn_s_barrier()
#define PG8_SCHED __builtin_amdgcn_sched_barrier(0)
    Unit cur, nxt; int ui = 0;
    if (!S.next(0, cur)) return;
    f32x4 acc[2][2][4][2];
#pragma unroll
    for (int a = 0; a < 2; ++a)
#pragma unroll
        for (int b = 0; b < 2; ++b)
#pragma unroll
            for (int m = 0; m < 4; ++m)
#pragma unroll
                for (int n = 0; n < 2; ++n) acc[a][b][m][n] = (f32x4){0.f, 0.f, 0.f, 0.f};
    bf16x8 At[4][2], B0[2][2], B1[2][2];
    const char* cA = (const char*)g.A + (size_t)cur.pm * tstep; const char* cB = (const char*)g.Bt + (size_t)cur.pn * tstep;
    S.a_ready(cur);
    if constexpr (SP2) {
        PG8_STAGE(PG8_SB(0, 0), cB, voffB); PG8_STAGE(PG8_SB(0, 1), cB + hstepB, voffB); PG8_STAGE(PG8_SA(0, 0), cA, voffA); PG8_STAGE(PG8_SA(0, 1), cA + hstep, voffA);
        if (wr == 1) PG8_BAR;
        PG8_WAIT_V(2); PG8_BAR;
        PG8_STAGE(PG8_SB(1, 0), cB + kstep, voffB); PG8_STAGE(PG8_SA(1, 0), cA + kstep, voffA); PG8_STAGE(PG8_SB(1, 1), cB + hstepB + kstep, voffB);
        PG8_WAIT_V(6); PG8_BAR;
    } else {
        PG8_STAGE(PG8_SB(0, 0), cB, voffB); PG8_STAGE(PG8_SA(0, 0), cA, voffA); PG8_STAGE(PG8_SB(0, 1), cB + hstepB, voffB); PG8_STAGE(PG8_SA(0, 1), cA + hstep, voffA);
        if (wr == 1) PG8_BAR;
        PG8_WAIT_V(4); PG8_BAR;
        PG8_STAGE(PG8_SB(1, 0), cB + kstep, voffB); PG8_STAGE(PG8_SA(1, 0), cA + kstep, voffA); PG8_STAGE(PG8_SB(1, 1), cB + hstepB + kstep, voffB);
        PG8_WAIT_V(6); PG8_BAR;
    }
    for (;;) {
        const bool has_next = S.next(ui + 1, nxt);
        const char* nA = has_next ? (const char*)g.A + (size_t)nxt.pm * tstep : cA; const char* nB = has_next ? (const char*)g.Bt + (size_t)nxt.pn * tstep : cB;
        for (int t = 0; t < nt; t += 2) {
            const bool last = (t == nt - 2);
            const char* a1 = cA + (size_t)(t + 1) * kstep;
            const char* a2 = last ? nA : cA + (size_t)(t + 2) * kstep; const char* b2 = last ? nB : cB + (size_t)(t + 2) * kstep;
            const char* a3 = a2 + kstep; const char* b3 = b2 + kstep;
            if (last && has_next) S.a_ready(nxt);
            if constexpr (SP2) {
            PG8_LDB(B0, 0, 0); PG8_LDB(B1, 0, 1); PG8_SCHED; PG8_LDA(At, 0, 0); PG8_STAGE(PG8_SA(1, 1), a1 + hstep, voffA);
            PG8_WAIT_V(8); PG8_WAIT_L(0); PG8_BAR; PG8_MMA(0, 0, At, B0); PG8_MMA(0, 1, At, B1); PG8_BAR; PG8_SCHED;
            PG8_LDA(At, 0, 1); PG8_STAGE(PG8_SB(0, 0), b2, voffB); PG8_STAGE(PG8_SB(0, 1), b2 + hstepB, voffB); PG8_STAGE(PG8_SA(0, 0), a2, voffA);
            PG8_WAIT_V(8); PG8_WAIT_L(0); PG8_BAR; PG8_MMA(1, 0, At, B0); PG8_MMA(1, 1, At, B1); PG8_BAR; PG8_SCHED;
            PG8_LDB(B0, 1, 0); PG8_LDB(B1, 1, 1); PG8_SCHED; PG8_LDA(At, 1, 0); PG8_STAGE(PG8_SA(0, 1), a2 + hstep, voffA);
            PG8_WAIT_V(8); PG8_WAIT_L(0); PG8_BAR; PG8_MMA(0, 0, At, B0); PG8_MMA(0, 1, At, B1); PG8_BAR; PG8_SCHED;
            PG8_LDA(At, 1, 1); PG8_STAGE(PG8_SB(1, 0), b3, voffB); PG8_STAGE(PG8_SB(1, 1), b3 + hstepB, voffB); PG8_STAGE(PG8_SA(1, 0), a3, voffA);
            PG8_WAIT_V(8); PG8_WAIT_L(0); PG8_BAR; PG8_MMA(1, 0, At, B0); PG8_MMA(1, 1, At, B1); PG8_BAR; PG8_SCHED;
            } else {
            PG8_LDB(B0, 0, 0); PG8_SCHED; PG8_LDA(At, 0, 0); PG8_STAGE(PG8_SA(1, 1), a1 + hstep, voffA);
            PG8_WAIT_L(8); PG8_BAR; PG8_WAIT_L(0); PG8_MMA(0, 0, At, B0); PG8_BAR; PG8_SCHED;
            PG8_LDB(B1, 0, 1); PG8_STAGE(PG8_SB(0, 0), b2, voffB);
            PG8_BAR; PG8_WAIT_L(0); PG8_MMA(0, 1, At, B1); PG8_BAR;
            PG8_LDA(At, 0, 1); PG8_STAGE(PG8_SA(0, 0), a2, voffA);
            PG8_BAR; PG8_WAIT_L(0); PG8_MMA(1, 0, At, B0); PG8_BAR; PG8_SCHED;
            PG8_STAGE(PG8_SB(0, 1), b2 + hstepB, voffB);
            PG8_WAIT_V(6); PG8_BAR; PG8_MMA(1, 1, At, B1); PG8_BAR;
            PG8_LDB(B0, 1, 0); PG8_SCHED; PG8_LDA(At, 1, 0); PG8_STAGE(PG8_SA(0, 1), a2 + hstep, voffA);
            PG8_WAIT_L(8); PG8_BAR; PG8_WAIT_L(0); PG8_MMA(0, 0, At, B0); PG8_BAR; PG8_SCHED;
            PG8_LDB(B1, 1, 1); PG8_STAGE(PG8_SB(1, 0), b3, voffB);
            PG8_BAR; PG8_WAIT_L(0); PG8_MMA(0, 1, At, B1); PG8_BAR;
            PG8_LDA(At, 1, 1); PG8_STAGE(PG8_SA(1, 0), a3, voffA);
            PG8_BAR; PG8_WAIT_L(0); PG8_MMA(1, 0, At, B0); PG8_BAR; PG8_SCHED;
            PG8_STAGE(PG8_SB(1, 1), b3 + hstepB, voffB);
            PG8_WAIT_V(6); PG8_BAR; PG8_MMA(1, 1, At, B1); PG8_BAR;
            }
        }
        if constexpr (ALIGN_EPI) { if (wr == 0) PG8_BAR; }
        if constexpr (!Epi::AFTER_DRAIN) { E(acc, cur, wr, wc, fr, fq); S.done(cur); }
        if (!has_next) break;
#pragma unroll
        for (int a = 0; a < 2; ++a)
#pragma unroll
            for (int b = 0; b < 2; ++b)
#pragma unroll
                for (int m = 0; m < 4; ++m)
#pragma unroll
                    for (int n = 0; n < 2; ++n) acc[a][b][m][n] = (f32x4){0.f, 0.f, 0.f, 0.f};
        cur = nxt; cA = nA; cB = nB; ++ui;
        if constexpr (ALIGN_EPI) { if (wr == 1) PG8_BAR; }
    }
    PG8_WAIT_V(0);
    if constexpr (!ALIGN_EPI) { if (wr == 0) PG8_BAR; }
    PG8_BAR;
    if constexpr (Epi::AFTER_DRAIN) { E.fused(acc, cur, wr, wc, fr, fq, lds, wid, lane); S.done(cur); }
#undef PG8_SA
#undef PG8_SB
#undef PG8_STAGE
#undef PG8_LDA
#undef PG8_LDB
#undef PG8_MMA
#undef PG8_WAIT_V
#undef PG8_WAIT_L
#undef PG8_BAR
#undef PG8_SCHED
}
}


constexpr int NWAVES = 8;
constexpr int RING_OFF = 0, RING_BYTES = 131072;
constexpr int LDS_BYTES = 163840;
constexpr int LDSCTL_OFF = LDS_BYTES - 2048, MISC_OFF = LDSCTL_OFF + 320;
#define GAS __attribute__((address_space(1)))
#define LAS __attribute__((address_space(3)))
typedef unsigned v4u __attribute__((ext_vector_type(4)));
typedef float f32x4 __attribute__((ext_vector_type(4)));
typedef GAS unsigned gu32;
#define LDS_WAIT() asm volatile("s_waitcnt lgkmcnt(0)" ::: "memory")
#define VM_WAIT() asm volatile("s_waitcnt vmcnt(0)" ::: "memory")
constexpr int CW_BAR = 4096;
constexpr size_t CTL_ZERO_BYTES = 256 * 1024;

#define XB_TMO      128
#define XB_XCNT(j)  (256  + 64 * (j))
#define XB_XSUB(j)  (1280 + 64 * (j))
#define XB_XGEN(j)  (2304 + 64 * (j))
#define XB_TOP      3328
#define XB_TOPGEN   3392
#define XCD_BAR_WORDS 3456
#define XB_SPIN_CAP (1u << 18)
__device__ __forceinline__ unsigned xb_ld(unsigned* p)              { return __hip_atomic_load(p, __ATOMIC_RELAXED, __HIP_MEMORY_SCOPE_AGENT); }
__device__ __forceinline__ unsigned xb_add(unsigned* p, unsigned v) { return __hip_atomic_fetch_add(p, v, __ATOMIC_RELAXED, __HIP_MEMORY_SCOPE_AGENT); }
__device__ __forceinline__ unsigned xb_xcc_id() { return (unsigned)__builtin_amdgcn_s_getreg((3 << 11) | 20) & 0xFu; }
#define XB_SPIN(cond, bar) do { unsigned _sp = 0; while (cond) { __builtin_amdgcn_s_sleep(1); \
    if ((++_sp & 255u) == 0u) { if (xb_ld(&(bar)[XB_TMO])) break; if (_sp > XB_SPIN_CAP) { atomicAdd(&(bar)[XB_TMO], 1u); break; } } } } while (0)
struct XcdBarrier { unsigned* bar; unsigned x; volatile LAS unsigned* st; };
__device__ __forceinline__ XcdBarrier xcd_barrier_post(unsigned* bar, volatile LAS unsigned* st) {
    XcdBarrier b; b.bar = bar; b.x = xb_xcc_id(); b.st = st;
    if (threadIdx.x == 0) (void)xb_add(&bar[XB_XCNT(b.x)], 1u);
    return b;
}
__device__ __forceinline__ void xcd_barrier_complete(unsigned* bar, unsigned x, unsigned& nloc, unsigned& nx) {
    const unsigned G = gridDim.x * gridDim.y * gridDim.z;
    unsigned sum, cnt, mine, sp = 0u;
    for (;;) {
        sum = 0u; cnt = 0u; mine = 0u;
#pragma unroll
        for (unsigned j = 0; j < 16; ++j) { const unsigned c = xb_ld(&bar[XB_XCNT(j)]); sum += c; cnt += (c > 0u) ? 1u : 0u; mine = (j == x) ? c : mine; }
        if (sum == G) break;
        __builtin_amdgcn_s_sleep(1);
        if ((++sp & 255u) == 0u) { if (xb_ld(&bar[XB_TMO])) break; if (sp > XB_SPIN_CAP) { atomicAdd(&bar[XB_TMO], 1u); break; } }
    }
    nloc = mine > 0u ? mine : 1u; nx = cnt > 0u ? cnt : 1u;
}
__device__ __forceinline__ void xcd_barrier(const XcdBarrier& b) {
    asm volatile("s_waitcnt vmcnt(0)" ::: "memory");
    __syncthreads();
    if (threadIdx.x == 0) {
        unsigned* bar = b.bar;
        __builtin_amdgcn_s_waitcnt(0);
        unsigned nloc = b.st[0], nx = b.st[1];
        if (nloc == 0u) { xcd_barrier_complete(bar, b.x, nloc, nx); b.st[0] = nloc; b.st[1] = nx; }
        const unsigned old = xb_add(&bar[XB_XSUB(b.x)], 1u);
        const unsigned gen = old / nloc;
        if (old + 1u == (gen + 1u) * nloc) {
            __builtin_amdgcn_fence(__ATOMIC_RELEASE, "agent");
            asm volatile("s_waitcnt vmcnt(0)" ::: "memory");
            const unsigned og = xb_add(&bar[XB_TOP], 1u);
            const unsigned tg = og / nx;
            if (og + 1u == (tg + 1u) * nx) xb_add(&bar[XB_TOPGEN], 1u);
            else XB_SPIN(xb_ld(&bar[XB_TOPGEN]) == tg, bar);
            __builtin_amdgcn_fence(__ATOMIC_ACQUIRE, "agent");
            xb_add(&bar[XB_XGEN(b.x)], 1u);
            asm volatile("s_waitcnt vmcnt(0)" ::: "memory");
        } else {
            XB_SPIN(xb_ld(&bar[XB_XGEN(b.x)]) == gen, bar);
            __builtin_amdgcn_fence(__ATOMIC_ACQUIRE, "agent");
            asm volatile("s_waitcnt vmcnt(0)" ::: "memory");
        }
    }
    __syncthreads();
}

struct Frame {
    LAS unsigned char* lds; volatile LAS unsigned* MISC; gu32* ctl;
    int tid, lane, wave, vcu, G;
};
__device__ __forceinline__ float wave_sum(float v) {
#pragma unroll
    for (int o = 1; o < 64; o <<= 1) v += __shfl_xor(v, o);
    return v;
}
__device__ __forceinline__ unsigned pk2(float lo, float hi) { return (unsigned)f2bf(lo) | ((unsigned)f2bf(hi) << 16); }
__device__ __forceinline__ void p0_transpose_item(const float* W, int K, int N, int ldw, bf16_t* WT, LAS float* scr, int item, int lane) {
    const int nblk = N / 32, kb = item / nblk, nb = item % nblk, k0 = 64 * kb, n0 = 32 * nb;
    float wv[32];
#pragma unroll
    for (int i = 0; i < 32; ++i) wv[i] = W[(size_t)(k0 + 2 * i + (lane >> 5)) * ldw + n0 + (lane & 31)];
#pragma unroll
    for (int i = 0; i < 32; ++i) scr[(2 * i + (lane >> 5)) * 33 + (lane & 31)] = wv[i];
    LDS_WAIT(); asm volatile("" ::: "memory");
    const int c = lane & 7;
#pragma unroll
    for (int j = 0; j < 4; ++j) { const int n = (lane >> 3) + 8 * j; const LAS float* s = scr + (8 * c) * 33 + n;
        v4u o; o.x = pk2(s[0 * 33], s[1 * 33]); o.y = pk2(s[2 * 33], s[3 * 33]); o.z = pk2(s[4 * 33], s[5 * 33]); o.w = pk2(s[6 * 33], s[7 * 33]);
        *(GAS v4u*)(WT + (size_t)(n0 + n) * K + k0 + 8 * c) = o; }
    LDS_WAIT(); asm volatile("" ::: "memory");
}

struct Args { const float* in[22]; float* out; unsigned char* ws; int ph_lo, ph_hi, li, pad; };

constexpr int TI_IN = (D / 64) * (4096 / 32), TI_O = TI_IN + (D / 64) * (D / 32), TI_1 = TI_O + (D / 64) * (FF / 32), TI_2 = TI_1 + (FF / 64) * (D / 32);
__device__ __forceinline__ void transpose_items(Frame& F, const Args& a, int lo, int hi) {
    unsigned char* ws = a.ws;
    LAS float* scr = (LAS float*)(F.lds + RING_OFF + F.wave * 16384);
    const int gw = F.vcu * NWAVES + F.wave, NGW = F.G * NWAVES;
    for (int it = hi - 1 - gw; it >= lo; it -= NGW) {
        if (it < TI_IN) p0_transpose_item(a.in[12], D, 4096, INC, (bf16_t*)(ws + WS_WIN), scr, it, F.lane);
        else if (it < TI_O) p0_transpose_item(a.in[18], D, D, D, (bf16_t*)(ws + WS_WOUT), scr, it - TI_IN, F.lane);
        else if (it < TI_1) p0_transpose_item(a.in[19], D, FF, FF, (bf16_t*)(ws + WS_W1), scr, it - TI_O, F.lane);
        else p0_transpose_item(a.in[20], FF, D, D, (bf16_t*)(ws + WS_W2), scr, it - TI_1, F.lane);
    }
}
__device__ __forceinline__ void p0_prologue(Frame& F, const Args& a) {
    unsigned char* ws = a.ws;
    if (F.vcu < 96) {
        LAS float* sc = (LAS float*)(F.lds + RING_OFF + 8 * 16384);
        LAS float* part = sc + 3 * 1024;
        for (int e = F.tid; e < 3 * D; e += NWAVES * 64) { const int c = e >> 10, k = e & 1023; sc[e] = siluf(c == 0 ? a.in[7][k] : a.in[6][(c - 1) * D + k]); }
        __syncthreads();
        const int j = F.vcu * 64 + F.lane, k0 = F.wave * 128;
        const float* wa = a.in[8] + (size_t)k0 * 6144 + j;
        float a0 = 0.f, a1 = 0.f, a2 = 0.f;
#pragma unroll 16
        for (int k = 0; k < 128; ++k) { const float w = wa[(size_t)k * 6144]; a0 += sc[k0 + k] * w; a1 += sc[1024 + k0 + k] * w; a2 += sc[2048 + k0 + k] * w; }
        part[(F.wave * 3 + 0) * 64 + F.lane] = a0; part[(F.wave * 3 + 1) * 64 + F.lane] = a1; part[(F.wave * 3 + 2) * 64 + F.lane] = a2;
        __syncthreads();
        if (F.tid < 192) { const int c = F.tid >> 6, l = F.tid & 63; float t = 0.f;
#pragma unroll
            for (int w = 0; w < 8; ++w) t += part[(w * 3 + c) * 64 + l];
            ((float*)(ws + WS_MOD))[c * 6144 + F.vcu * 64 + l] = t + a.in[9][F.vcu * 64 + l]; }
        __syncthreads();
    }
    if (F.vcu == 100) {
        for (int e = F.tid; e < 2048; e += NWAVES * 64) { const int pos = e >> 5, f = e & 31;
            const float inv = exp2f(-(float)f * (13.287712379549449f / 32.f)); const float ang = (float)pos * inv;
            float sn, cs; sincosf(ang, &sn, &cs);
            float* rc = (float*)(ws + WS_ROPE); rc[e] = cs; rc[2048 + e] = sn; }
    }
    transpose_items(F, a, 0, TI_IN);
}

__device__ __forceinline__ void p1_norm_gates(Frame& F, const Args& a) {
    LAS float* wg = (LAS float*)(F.lds + RING_OFF);
    for (int e = F.tid; e < 1024 * 16; e += NWAVES * 64) { const int k = e >> 4, j = e & 15; wg[k * 20 + j] = a.in[12][(size_t)k * INC + 4096 + j]; }
    __syncthreads();
    const int gw = F.vcu * NWAVES + F.wave, NGW = F.G * NWAVES, lane = F.lane;
    const float* mod = (const float*)(a.ws + WS_MOD);
    float A1[16], S1[16]; int cur = -1;
    float vn[16];
    { const float* xr = gw < NP ? a.in[0] + (size_t)gw * D : a.in[1] + (size_t)(gw - NP) * D;
#pragma unroll
      for (int i = 0; i < 16; ++i) vn[i] = xr[lane + 64 * i]; }
    for (int m = gw; m < M; m += NGW) {
        const int cnd = cond_of(m);
        if (cnd != cur) { cur = cnd;
#pragma unroll
            for (int i = 0; i < 16; ++i) { const int k = lane + 64 * i; A1[i] = a.in[10][k] * (1.f + mod[cnd * 6144 + 1024 + k]); S1[i] = mod[cnd * 6144 + k]; } }
        float v[16]; float ss = 0.f;
#pragma unroll
        for (int i = 0; i < 16; ++i) { v[i] = vn[i]; ss += v[i] * v[i]; }
        { const int mn = m + NGW < M ? m + NGW : m;
          const float* xr = mn < NP ? a.in[0] + (size_t)mn * D : a.in[1] + (size_t)(mn - NP) * D;
#pragma unroll
          for (int i = 0; i < 16; ++i) vn[i] = xr[lane + 64 * i]; }
        ss = wave_sum(ss);
        const float rstd = rsqrtf(ss * (1.f / D) + EPS);
        bf16_t* H = (bf16_t*)(a.ws + WS_H) + (size_t)m * D;
        float ga[16];
#pragma unroll
        for (int j = 0; j < 16; ++j) ga[j] = 0.f;
#pragma unroll
        for (int i = 0; i < 16; ++i) {
            const float h = v[i] * rstd * A1[i] + S1[i];
            H[lane + 64 * i] = f2bf(h);
            const LAS f32x4* wr = (const LAS f32x4*)(wg + (lane + 64 * i) * 20);
            const f32x4 w0 = wr[0], w1 = wr[1], w2 = wr[2], w3 = wr[3];
#pragma unroll
            for (int j = 0; j < 4; ++j) { ga[j] += h * w0[j]; ga[4 + j] += h * w1[j]; ga[8 + j] += h * w2[j]; ga[12 + j] += h * w3[j]; }
            if (i & 1) asm volatile("" ::: "memory");
        }
        { const bool hi = lane & 32;
#pragma unroll
          for (int j = 0; j < 8; ++j) { const float keep = hi ? ga[j + 8] : ga[j], give = hi ? ga[j] : ga[j + 8]; ga[j] = keep + __shfl_xor(give, 32); } }
        { const bool hi = lane & 16;
#pragma unroll
          for (int j = 0; j < 4; ++j) { const float keep = hi ? ga[j + 4] : ga[j], give = hi ? ga[j] : ga[j + 4]; ga[j] = keep + __shfl_xor(give, 16); } }
        { const bool hi = lane & 8;
#pragma unroll
          for (int j = 0; j < 2; ++j) { const float keep = hi ? ga[j + 2] : ga[j], give = hi ? ga[j] : ga[j + 2]; ga[j] = keep + __shfl_xor(give, 8); } }
        { const bool hi = lane & 4; const float keep = hi ? ga[1] : ga[0], give = hi ? ga[0] : ga[1]; ga[0] = keep + __shfl_xor(give, 4); }
        ga[0] += __shfl_xor(ga[0], 2); ga[0] += __shfl_xor(ga[0], 1);
        if ((lane & 3) == 0) ((float*)(a.ws + WS_GATES))[(size_t)m * 16 + (lane >> 2)] = ga[0] + a.in[15][lane >> 2];
    }
}


__device__ __forceinline__ void p3_conv_cumsum(Frame& F, const Args& a) {
    unsigned char* ws = a.ws;
    const int gw = F.vcu * NWAVES + F.wave, NGW = F.G * NWAVES, lane = F.lane;
    if (F.vcu < 48) {
        const bool lng = F.vcu < 16;
        const int sid = lng ? F.vcu : gw - 128;
        const int seq = lng ? 32 + (sid >> 3) : sid >> 3, dir = (sid >> 2) & 1, h = sid & 3;
        const int T = lng ? TS : TP, mbase = lng ? NP + (seq - 32) * TS : seq * TP, c0 = lng ? 256 * F.wave : 0;
        const float* G = (const float*)(ws + WS_GATES);
        float* LI = (float*)(ws + WS_GLI) + (size_t)(dir * 4 + h) * M;
        float* CU = (float*)(ws + WS_GCUM) + (size_t)(dir * 4 + h) * M;
        float lf[4], li[4]; int mm[4];
#pragma unroll
        for (int i = 0; i < 4; ++i) { const int p = c0 + 4 * lane + i; mm[i] = mbase + (dir == 0 ? p : T - 1 - p);
            lf[i] = G[(size_t)mm[i] * 16 + dir * 8 + 4 + h]; li[i] = G[(size_t)mm[i] * 16 + dir * 8 + h]; }
#pragma unroll
        for (int i = 0; i < 4; ++i) lf[i] = logsigf(lf[i]);
        lf[1] += lf[0]; lf[2] += lf[1]; lf[3] += lf[2];
        float incl = lf[3];
#pragma unroll
        for (int o = 1; o < 64; o <<= 1) { const float v = __shfl_up(incl, o); if (lane >= o) incl += v; }
        float carry = 0.f;
        if (lng) {
            LAS float* tot = (LAS float*)(F.lds + RING_OFF + 8 * 16384);
            if (lane == 63) tot[F.wave] = incl;
            __syncthreads();
            for (int w = 0; w < F.wave; ++w) carry += tot[w];
        }
        const float excl = carry + incl - lf[3];
#pragma unroll
        for (int i = 0; i < 4; ++i) { CU[mm[i]] = excl + lf[i]; LI[mm[i]] = li[i]; }
    }
    const bf16_t* X = (const bf16_t*)(ws + WS_MQKP);
    constexpr int STRIP = 6;
    static_assert(M % STRIP == 0, "conv strips");
    for (int st = gw; st < M / STRIP; st += NGW) {
        const int m0 = st * STRIP;
#pragma unroll
        for (int i = 0; i < 2; ++i) {
            v4u x[STRIP + 2];
#pragma unroll
            for (int r = 0; r < STRIP + 2; ++r) { int mr = m0 - 1 + r; mr = mr < 0 ? 0 : (mr > M - 1 ? M - 1 : mr); x[r] = *(const v4u*)(X + (size_t)mr * 1024 + (lane + 64 * i) * 8); }
            float cw[3][8];
#pragma unroll
            for (int j = 0; j < 3; ++j) { const f32x4 c0 = *(const f32x4*)(a.in[13] + j * 1024 + (lane + 64 * i) * 8), c1 = *(const f32x4*)(a.in[13] + j * 1024 + (lane + 64 * i) * 8 + 4);
#pragma unroll
                for (int e = 0; e < 4; ++e) { cw[j][e] = c0[e]; cw[j][4 + e] = c1[e]; } }
#pragma unroll
            for (int r = 0; r < STRIP; ++r) {
                const int m = m0 + r, T = m < NP ? TP : TS, t = m < NP ? (m & (TP - 1)) : ((m - NP) & (TS - 1));
                const bool has0 = t > 0, has2 = t < T - 1;
                float o[8];
#pragma unroll
                for (int e = 0; e < 8; ++e) {
                    const unsigned w0 = x[r][e >> 1], w1 = x[r + 1][e >> 1], w2 = x[r + 2][e >> 1];
                    const float f0 = __uint_as_float((e & 1) ? (w0 & 0xffff0000u) : (w0 << 16)), f1 = __uint_as_float((e & 1) ? (w1 & 0xffff0000u) : (w1 << 16)), f2 = __uint_as_float((e & 1) ? (w2 & 0xffff0000u) : (w2 << 16));
                    float v = cw[1][e] * f1 + (has0 ? cw[0][e] * f0 : 0.f) + (has2 ? cw[2][e] * f2 : 0.f);
                    v = siluf(v);
                    o[e] = i == 0 ? v : v * 0.08838834764831845f;
                }
                v4u w; w.x = pk2(o[0], o[1]); w.y = pk2(o[2], o[3]); w.z = pk2(o[4], o[5]); w.w = pk2(o[6], o[7]);
                *(v4u*)((bf16_t*)(ws + (i == 0 ? WS_MQ : WS_MK)) + (size_t)m * W5 + lane * 8) = w;
            }
        }
    }
    transpose_items(F, a, TI_IN, TI_O);
}

typedef short bf16x8 __attribute__((ext_vector_type(8)));
typedef short s16x4 __attribute__((ext_vector_type(4)));
typedef short v4i16_t __attribute__((ext_vector_type(4)));
typedef float f32x16 __attribute__((ext_vector_type(16)));
typedef float f32x2_t __attribute__((ext_vector_type(2)));
typedef __bf16 bf16x2_t __attribute__((ext_vector_type(2)));
#define MFMA32(a_, b_, c_) __builtin_amdgcn_mfma_f32_32x32x16_bf16((a_), (b_), (c_), 0, 0, 0)
constexpr int RS = 272, TRS = 320;
constexpr int MX_QS = 0, MX_KS = 34816, MX_VS = 75776, MX_PX = 116736, MX_SM = 149504;
constexpr int MX_CF = MX_SM, MX_CB = MX_SM + 512, MX_DEN = MX_SM + 1024, MX_ST = MX_SM + 3072, MX_W = MX_SM + 5120, MX_RED = MX_SM + 7168;
static_assert(MX_RED + 64 <= LDSCTL_OFF && MX_KS + 128 * TRS <= MX_VS && MX_VS + 128 * TRS <= MX_PX && MX_PX + 32768 <= MX_SM, "mixer LDS map");
__device__ __forceinline__ unsigned cvtpk(float lo, float hi) { f32x2_t v = {lo, hi}; bf16x2_t b = __builtin_convertvector(v, bf16x2_t); return __builtin_bit_cast(unsigned, b); }
__device__ __forceinline__ s16x4 vtr(const LAS unsigned char* p) { return __builtin_bit_cast(s16x4, __builtin_amdgcn_ds_read_tr16_b64_v4i16((LAS v4i16_t*)p)); }
#define ROW_FRAG(base_r, row0, ks) (*(const LAS bf16x8*)((base_r) + (row0) * RS + (ks) * 32))
__device__ __forceinline__ bf16x8 tr_frag2(const LAS unsigned char* base_t, int off0, int off1) {
    const s16x4 lo = vtr(base_t + off0), hi = vtr(base_t + off1);
    return __builtin_shufflevector(lo, hi, 0, 1, 2, 3, 4, 5, 6, 7);
}
#define TR_FRAG(base_t, r0, r1, c) tr_frag2((base_t), (r0) * TRS + (c) * 64, (r1) * TRS + (c) * 64)
__device__ __forceinline__ void stage_tile(LAS unsigned char* dst, int rs, const bf16_t* src, int ld, int tid) {
#pragma unroll
    for (int i = 0; i < 4; ++i) { const int n = tid + 512 * i, row = n >> 4, ch = n & 15;
        const v4u v = *(const v4u*)(src + (size_t)row * ld + ch * 8);
        *(LAS v4u*)(dst + row * rs + ch * 16) = v; }
}
__device__ __forceinline__ void stage_tile_f32(LAS unsigned char* dst, const float* src, int tid) {
#pragma unroll
    for (int i = 0; i < 4; ++i) { const int n = tid + 512 * i, row = n >> 4, ch = n & 15;
        const f32x4 x = *(const f32x4*)(src + row * 128 + ch * 8), y = *(const f32x4*)(src + row * 128 + ch * 8 + 4);
        v4u v; v.x = cvtpk(x[0], x[1]); v.y = cvtpk(x[2], x[3]); v.z = cvtpk(y[0], y[1]); v.w = cvtpk(y[2], y[3]);
        *(LAS v4u*)(dst + row * TRS + ch * 16) = v; }
}

struct MixSrc { const bf16_t *Q, *K, *V, *GT; const float *cumF, *liF, *cumB, *liB, *gain; float lgf, lgb; };

__device__ __forceinline__ void mix_pv(f32x16 (&O)[2], const LAS unsigned char* vbase, const LAS unsigned char* pxbase) {
#pragma unroll
    for (int khp = 0; khp < 2; ++khp)
#pragma unroll
        for (int f = 0; f < 4; ++f) {
            const bf16x8 pb = *(const LAS bf16x8*)(pxbase + (khp * 4 + f) * 1024);
            const int kb0 = 64 * khp + 32 * (f >> 1) + 16 * (f & 1);
#pragma unroll
            for (int eb = 0; eb < 2; ++eb) O[eb] = MFMA32(TR_FRAG(vbase, kb0, kb0 + 8, eb), pb, O[eb]);
            if (f & 1) asm volatile("" ::: "memory");
        }
}

__device__ __forceinline__ void mix_attn_item(Frame& F, const Args& a, const MixSrc& X, int type, int seq, int h, int qt, bool chunked) {
    LAS unsigned char* lds = F.lds;
    int tid = F.tid; asm volatile("" : "+v"(tid));
    const int lane = tid & 63, wave = F.wave, rg = wave >> 1, kh = wave & 1, c31 = lane & 31, hh = lane >> 5;
    const int T = seq < 32 ? TP : TS, sb = seq < 32 ? seq * TP : NP + (seq - 32) * TS, nk = T / 128;
    const int t_rel = 32 * rg + c31, t_seq = 128 * qt + t_rel, m_t = sb + t_seq;
    LAS float* CF = (LAS float*)(lds + MX_CF); LAS float* CB = (LAS float*)(lds + MX_CB);
    const LAS unsigned char* qbase = lds + MX_QS + (32 * rg + c31) * RS + hh * 16;
    const LAS unsigned char* kbase = lds + MX_KS + (64 * kh + c31) * RS + hh * 16;
    const int trl = ((lane & 15) >> 2) * TRS + ((lane >> 4) & 1) * 32 + (lane & 3) * 8;
    const LAS unsigned char* vbase = lds + MX_VS + trl + hh * 4 * TRS + kh * 128;
    const LAS unsigned char* vnat = lds + MX_VS + trl + hh * 8 * TRS + kh * 128;
    LAS unsigned char* pxw = lds + MX_PX + wave * 4096 + lane * 16;
    const LAS unsigned char* pxr = lds + MX_PX + (wave & ~1) * 4096 + lane * 16;
    float cumF_t, cumB_t, refF, refB;
    if (type == 1) { cumF_t = X.cumF[m_t]; cumB_t = X.cumB[m_t]; refF = qt == 0 ? 0.f : X.cumF[sb + 128 * qt - 1]; refB = qt == nk - 1 ? 0.f : X.cumB[sb + 128 * (qt + 1)]; }
    else { cumF_t = X.lgf * (float)(t_seq + 1); cumB_t = X.lgb * (float)(T - t_seq); refF = X.lgf * (float)(128 * qt); refB = X.lgb * (float)(T - 128 * (qt + 1)); }
    f32x16 Of[2], Ob[2];
#pragma unroll
    for (int e = 0; e < 2; ++e)
#pragma unroll
        for (int r = 0; r < 16; ++r) { Of[e][r] = 0.f; Ob[e][r] = 0.f; }
    float denf = 0.f, denb = 0.f;
    __syncthreads();
    stage_tile(lds + MX_QS, RS, X.Q + (size_t)(sb + 128 * qt) * W5 + h * HD, W5, tid);
    if (chunked) {
        const bf16_t* SF = (const bf16_t*)(a.ws + WS_SST) + (size_t)(((((type * 2 + (seq - 32)) * 4 + h) * 16 + qt) * 2) * ST_ELEMS);
        const bf16_t* SB = SF + ST_ELEMS;
        stage_tile(lds + MX_VS, TRS, SF, 128, tid);
        stage_tile(lds + MX_KS, TRS, SB, 128, tid);
        { const int row = tid >> 4, ch = tid & 15; v4u v = {0u, 0u, 0u, 0u};
          if (row < 2) v = *(const v4u*)((row == 0 ? SF : SB) + 128 * 128 + ch * 8);
          *(LAS v4u*)(lds + MX_PX + row * RS + ch * 16) = v; }
        __syncthreads();
        f32x16 Sx;
#pragma unroll
        for (int r = 0; r < 16; ++r) Sx[r] = 0.f;
        const LAS unsigned char* nbase = lds + MX_PX + c31 * RS + hh * 16;
        const LAS unsigned char* vnatb = lds + MX_KS + trl + hh * 8 * TRS + kh * 128;
#pragma unroll
        for (int ks = 0; ks < 8; ++ks) {
            const bf16x8 qf = ROW_FRAG(qbase, 0, ks);
            Sx = MFMA32(ROW_FRAG(nbase, 0, ks), qf, Sx);
#pragma unroll
            for (int eb = 0; eb < 2; ++eb) { Of[eb] = MFMA32(TR_FRAG(vnat, 16 * ks, 16 * ks + 4, eb), qf, Of[eb]); Ob[eb] = MFMA32(TR_FRAG(vnatb, 16 * ks, 16 * ks + 4, eb), qf, Ob[eb]); }
            if (ks & 1) asm volatile("" ::: "memory");
        }
        if (kh == 0 && hh == 0) { denf = Sx[0]; denb = Sx[1]; }
        __syncthreads();
    }
    f32x16 S[2];
    v4u kreg[4], vreg[4]; float aFr = 0.f, aBr = 0.f;
    const int srow = tid >> 4, sch = tid & 15;
#define MIX_LOAD(j_) do { \
        const bf16_t* kp_ = X.K + (size_t)(sb + 128 * (j_) + srow) * W5 + h * HD + sch * 8; const bf16_t* vp_ = X.V + (size_t)(sb + 128 * (j_) + srow) * W5 + h * HD + sch * 8; \
        _Pragma("unroll") for (int i = 0; i < 4; ++i) { kreg[i] = *(const v4u*)(kp_ + (size_t)i * 32 * W5); vreg[i] = *(const v4u*)(vp_ + (size_t)i * 32 * W5); } \
        { const int ts = 128 * (j_) + (tid & 127), ms = sb + ts; \
          if (type == 1) { aFr = X.liF[ms] - X.cumF[ms]; aBr = X.liB[ms] - X.cumB[ms]; } \
          else { aFr = -X.lgf * (float)(ts + 1); aBr = -X.lgb * (float)(T - ts); } } } while (0)
#define MIX_STORE_SCORES(mode_) do { \
        _Pragma("unroll") for (int i = 0; i < 4; ++i) { *(LAS v4u*)(lds + MX_KS + (srow + 32 * i) * RS + sch * 16) = kreg[i]; *(LAS v4u*)(lds + MX_VS + (srow + 32 * i) * TRS + sch * 16) = vreg[i]; } \
        if (tid < 128) { \
            if ((mode_) == 0) CF[tid] = __expf(refF + aFr); \
            else if ((mode_) == 1) CF[tid] = __expf(refB + aBr); \
            else { CF[tid] = aFr; CB[tid] = aBr; } \
        } } while (0)
#define MIX_SCORES() do { \
        _Pragma("unroll") for (int kb = 0; kb < 2; ++kb) _Pragma("unroll") for (int r = 0; r < 16; ++r) S[kb][r] = 0.f; \
        _Pragma("unroll") for (int ks = 0; ks < 8; ++ks) { \
            const bf16x8 qf = ROW_FRAG(qbase, 0, ks); \
            _Pragma("unroll") for (int kb = 0; kb < 2; ++kb) S[kb] = MFMA32(ROW_FRAG(kbase, 32 * kb, ks), qf, S[kb]); \
            if (ks & 1) asm volatile("" ::: "memory"); \
        } } while (0)
    const int nloop = chunked ? 0 : nk - 1;
#define MIX_TILE_OF(step_) ((step_) >= nloop ? qt : ((step_) < qt ? (step_) : nk - 1 - ((step_) - qt)))
    MIX_LOAD(MIX_TILE_OF(0));
    const LAS float* cfl = CF + 64 * kh + 4 * hh; const LAS float* cbl = CB + 64 * kh + 4 * hh;
    for (int step = 0; step < nloop; ++step) {
        const int j = MIX_TILE_OF(step);
        const int mode = j < qt ? 0 : 1;
        MIX_STORE_SCORES(mode);
        MIX_LOAD(MIX_TILE_OF(step + 1));
        __syncthreads();
        MIX_SCORES();
        float dsum = 0.f;
#pragma unroll
        for (int f = 0; f < 4; ++f) {
            v4u w;
#pragma unroll
            for (int g2 = 0; g2 < 2; ++g2) { const int g = 2 * (f & 1) + g2; const f32x4 c = *(const LAS f32x4*)(cfl + 32 * (f >> 1) + 8 * g);
                const float p0 = S[f >> 1][4 * g + 0] * c[0], p1 = S[f >> 1][4 * g + 1] * c[1], p2 = S[f >> 1][4 * g + 2] * c[2], p3 = S[f >> 1][4 * g + 3] * c[3];
                dsum += (p0 + p1) + (p2 + p3);
                if (g2 == 0) { w.x = cvtpk(p0, p1); w.y = cvtpk(p2, p3); } else { w.z = cvtpk(p0, p1); w.w = cvtpk(p2, p3); } }
            *(LAS v4u*)(pxw + f * 1024) = w;
        }
        __syncthreads();
        if (mode == 0) { denf += dsum; mix_pv(Of, vbase, pxr); } else { denb += dsum; mix_pv(Ob, vbase, pxr); }
        __syncthreads();
    }
    {
        const float rf = __expf(cumF_t - refF), rb = __expf(cumB_t - refB);
#pragma unroll
        for (int eb = 0; eb < 2; ++eb) { Of[eb] = Of[eb] * rf; Ob[eb] = Ob[eb] * rb; }
        denf *= rf; denb *= rb;
        MIX_STORE_SCORES(2);
        __syncthreads();
        MIX_SCORES();
        int t_loc = t_rel; asm volatile("" : "+v"(t_loc));
#pragma unroll
        for (int dirp = 0; dirp < 2; ++dirp) {
            float dsum = 0.f;
#pragma unroll
            for (int f = 0; f < 4; ++f) {
                v4u w;
#pragma unroll
                for (int g2 = 0; g2 < 2; ++g2) { const int g = 2 * (f & 1) + g2, s0 = 64 * kh + 32 * (f >> 1) + 8 * g + 4 * hh;
                    const f32x4 c = *(const LAS f32x4*)((dirp == 0 ? cfl : cbl) + 32 * (f >> 1) + 8 * g);
                    float pv[4];
#pragma unroll
                    for (int i = 0; i < 4; ++i) { const bool on = dirp == 0 ? (s0 + i) <= t_loc : (s0 + i) >= t_loc;
                        const float wgt = on ? __expf((dirp == 0 ? cumF_t : cumB_t) + c[i]) : 0.f; pv[i] = S[f >> 1][4 * g + i] * wgt; dsum += pv[i]; }
                    if (g2 == 0) { w.x = cvtpk(pv[0], pv[1]); w.y = cvtpk(pv[2], pv[3]); } else { w.z = cvtpk(pv[0], pv[1]); w.w = cvtpk(pv[2], pv[3]); } }
                *(LAS v4u*)(pxw + f * 1024) = w;
            }
            __syncthreads();
            if (dirp == 0) { denf += dsum; mix_pv(Of, vbase, pxr); } else { denb += dsum; mix_pv(Ob, vbase, pxr); }
            __syncthreads();
        }
    }
#undef MIX_LOAD
#undef MIX_STORE_SCORES
#undef MIX_SCORES
#undef MIX_TILE_OF
    LAS float* DEN = (LAS float*)(lds + MX_DEN); LAS float* ST = (LAS float*)(lds + MX_ST);
    float hv[2][16];
    if (type == 1) {
        denf += __shfl_xor(denf, 32); denb += __shfl_xor(denb, 32);
        if (hh == 0) { DEN[(wave * 2 + 0) * 32 + c31] = denf; DEN[(wave * 2 + 1) * 32 + c31] = denb; }
        __syncthreads();
        denf += DEN[((wave ^ 1) * 2 + 0) * 32 + c31]; denb += DEN[((wave ^ 1) * 2 + 1) * 32 + c31];
        const float inf_ = 1.f / fmaxf(fabsf(denf), 1.f), inb_ = 1.f / fmaxf(fabsf(denb), 1.f);
#pragma unroll
        for (int eb = 0; eb < 2; ++eb)
#pragma unroll
            for (int r = 0; r < 16; ++r) hv[eb][r] = Of[eb][r] * inf_ + Ob[eb][r] * inb_;
    } else {
#pragma unroll
        for (int eb = 0; eb < 2; ++eb)
#pragma unroll
            for (int r = 0; r < 16; ++r) hv[eb][r] = Of[eb][r] + Ob[eb][r];
    }
    float s1 = 0.f;
#pragma unroll
    for (int eb = 0; eb < 2; ++eb)
#pragma unroll
        for (int r = 0; r < 16; ++r) s1 += hv[eb][r];
    s1 += __shfl_xor(s1, 32);
    if (hh == 0) ST[(wave * 2 + 0) * 32 + c31] = s1;
    __syncthreads();
    const float mean = (s1 + ST[((wave ^ 1) * 2 + 0) * 32 + c31]) * (1.f / 128.f);
    float s2 = 0.f;
#pragma unroll
    for (int eb = 0; eb < 2; ++eb)
#pragma unroll
        for (int r = 0; r < 16; ++r) { hv[eb][r] -= mean; s2 += hv[eb][r] * hv[eb][r]; }
    s2 += __shfl_xor(s2, 32);
    if (hh == 0) ST[(wave * 2 + 1) * 32 + c31] = s2;
    __syncthreads();
    const float rstd = rsqrtf((s2 + ST[((wave ^ 1) * 2 + 1) * 32 + c31]) * (1.f / 128.f) + EPS);
    bf16_t* outp = (bf16_t*)(a.ws + WS_MIX) + (size_t)m_t * D + type * 512 + h * HD;
    const bf16_t* gtp = X.GT + (size_t)m_t * W5 + h * HD;
#pragma unroll
    for (int eb = 0; eb < 2; ++eb)
#pragma unroll
        for (int g = 0; g < 4; ++g) {
            const int e0 = 64 * kh + 32 * eb + 8 * g + 4 * hh;
            const f32x4 gn = *(const f32x4*)(X.gain + h * HD + e0);
            const unsigned long long gw_ = *(const unsigned long long*)(gtp + e0);
            const unsigned g01 = (unsigned)gw_, g23 = (unsigned)(gw_ >> 32);
            const float y0 = hv[eb][4 * g + 0] * rstd * gn[0] * __uint_as_float(g01 << 16), y1 = hv[eb][4 * g + 1] * rstd * gn[1] * __uint_as_float(g01 & 0xffff0000u);
            const float y2 = hv[eb][4 * g + 2] * rstd * gn[2] * __uint_as_float(g23 << 16), y3 = hv[eb][4 * g + 3] * rstd * gn[3] * __uint_as_float(g23 & 0xffff0000u);
            *(unsigned long long*)(outp + e0) = (unsigned long long)cvtpk(y0, y1) | ((unsigned long long)cvtpk(y2, y3) << 32);
        }
}

__device__ __forceinline__ void mix_state_item(Frame& F, const Args& a, const MixSrc& X, int type, int seq, int h, int c) {
    LAS unsigned char* lds = F.lds;
    int tid = F.tid; asm volatile("" : "+v"(tid));
    const bool local = c >= 0; const int b = seq;
    const int lane = tid & 63, wave = F.wave, c31 = lane & 31, hh = lane >> 5, sb = local ? NP + (seq - 32) * TS + 128 * c : seq * TP;
    LAS float* WSM = (LAS float*)(lds + MX_W); LAS float* RED = (LAS float*)(lds + MX_RED);
    __syncthreads();
    {
        const int dir = tid >> 8, s = tid & 255; float lw, mfin = 0.f;
        if (local) {
            const int sc = s & 127;
            if (type == 1) { const float* cu = dir == 0 ? X.cumF : X.cumB; const float* li = dir == 0 ? X.liF : X.liB; lw = cu[sb + (dir == 0 ? 127 : 0)] - cu[sb + sc] + li[sb + sc]; }
            else lw = (dir == 0 ? X.lgf : X.lgb) * (float)(dir == 0 ? 127 - sc : sc);
        } else if (type == 1) {
            const float* cu = dir == 0 ? X.cumF : X.cumB; const float* li = dir == 0 ? X.liF : X.liB;
            const float tot = cu[sb + (dir == 0 ? TP - 1 : 0)];
            lw = tot - cu[sb + s] + li[sb + s];
            float mx = lw;
#pragma unroll
            for (int o = 32; o > 0; o >>= 1) mx = fmaxf(mx, __shfl_xor(mx, o));
            if (lane == 0) RED[wave] = mx;
            __syncthreads();
            mfin = fmaxf(fmaxf(fmaxf(RED[dir * 4 + 0], RED[dir * 4 + 1]), fmaxf(RED[dir * 4 + 2], RED[dir * 4 + 3])), tot);
            lw -= mfin;
            if (s == 0) a.out[O_M + (b * 2 + dir) * 4 + h] = mfin;
        } else lw = (dir == 0 ? X.lgf : X.lgb) * (float)(dir == 0 ? TP - 1 - s : s);
        WSM[dir * 256 + s] = __expf(lw);
    }
    const int dir = wave >> 2, dkb = wave & 3;
    const int trl = ((lane & 15) >> 2) * TRS + ((lane >> 4) & 1) * 32 + (lane & 3) * 8 + hh * 8 * TRS;
    const LAS unsigned char* kt = lds + MX_KS + trl + dkb * 64;
    const LAS unsigned char* vt = lds + MX_VS + trl;
    const LAS float* wl = WSM + dir * 256 + 8 * hh;
    f32x16 acc[4], accn;
#pragma unroll
    for (int r = 0; r < 16; ++r) { accn[r] = 0.f;
#pragma unroll
        for (int v = 0; v < 4; ++v) acc[v][r] = 0.f; }
    bf16x8 ones;
#pragma unroll
    for (int j = 0; j < 8; ++j) ones[j] = (short)0x3F80;
    const int ntile = local ? 1 : 2;
    for (int jt = 0; jt < ntile; ++jt) {
        __syncthreads();
        stage_tile(lds + MX_KS, TRS, X.K + (size_t)(sb + 128 * jt) * W5 + h * HD, W5, tid);
        stage_tile(lds + MX_VS, TRS, X.V + (size_t)(sb + 128 * jt) * W5 + h * HD, W5, tid);
        __syncthreads();
#pragma unroll
        for (int ks = 0; ks < 8; ++ks) {
            const bf16x8 kr = TR_FRAG(kt, 16 * ks, 16 * ks + 4, 0);
            const f32x4 w0 = *(const LAS f32x4*)(wl + 128 * jt + 16 * ks), w1 = *(const LAS f32x4*)(wl + 128 * jt + 16 * ks + 4);
            const v4u ku = __builtin_bit_cast(v4u, kr);
            v4u kw;
            kw.x = cvtpk(__uint_as_float(ku.x << 16) * w0[0], __uint_as_float(ku.x & 0xffff0000u) * w0[1]);
            kw.y = cvtpk(__uint_as_float(ku.y << 16) * w0[2], __uint_as_float(ku.y & 0xffff0000u) * w0[3]);
            kw.z = cvtpk(__uint_as_float(ku.z << 16) * w1[0], __uint_as_float(ku.z & 0xffff0000u) * w1[1]);
            kw.w = cvtpk(__uint_as_float(ku.w << 16) * w1[2], __uint_as_float(ku.w & 0xffff0000u) * w1[3]);
            const bf16x8 ka = __builtin_bit_cast(bf16x8, kw);
#pragma unroll
            for (int v = 0; v < 4; ++v) acc[v] = MFMA32(ka, TR_FRAG(vt, 16 * ks, 16 * ks + 4, v), acc[v]);
            if (type == 1 || local) accn = MFMA32(ka, ones, accn);
        }
    }
    float* O; float* On;
    if (local) { O = (float*)(a.ws + WS_LOC) + (size_t)(((((type * 2 + (seq - 32)) * 4 + h) * 16 + c) * 2 + dir)) * ST_ELEMS; On = O + 128 * 128; }
    else { O = a.out + (type == 0 ? O_RET : O_C) + (size_t)((b * 2 + dir) * 4 + h) * 16384; On = a.out + O_N + (size_t)((b * 2 + dir) * 4 + h) * 128; }
#pragma unroll
    for (int v = 0; v < 4; ++v)
#pragma unroll
        for (int r = 0; r < 16; ++r) O[(32 * dkb + (r & 3) + 8 * (r >> 2) + 4 * hh) * 128 + 32 * v + c31] = acc[v][r];
    if ((type == 1 || local) && c31 == 0) {
#pragma unroll
        for (int r = 0; r < 16; ++r) On[32 * dkb + (r & 3) + 8 * (r >> 2) + 4 * hh] = accn[r];
    }
}

__device__ __forceinline__ void mix_src(MixSrc& X, const Args& a, int type, int h) {
    unsigned char* ws = a.ws;
    X.Q = (const bf16_t*)(ws + (type == 0 ? WS_RQ : WS_MQ)); X.K = (const bf16_t*)(ws + (type == 0 ? WS_RK : WS_MK)); X.V = (const bf16_t*)(ws + (type == 0 ? WS_RV : WS_MV));
    X.GT = (const bf16_t*)(ws + (type == 0 ? WS_RG : WS_MO)); X.gain = type == 0 ? a.in[16] : a.in[17];
    X.cumF = (const float*)(ws + WS_GCUM) + (size_t)h * M; X.cumB = (const float*)(ws + WS_GCUM) + (size_t)(4 + h) * M;
    X.liF = (const float*)(ws + WS_GLI) + (size_t)h * M; X.liB = (const float*)(ws + WS_GLI) + (size_t)(4 + h) * M;
    X.lgf = logsigf(a.in[14][h]); X.lgb = logsigf(a.in[14][4 + h]);
}
__device__ __forceinline__ void p4_mixer_a(Frame& F, const Args& a) {
    for (int item = F.vcu; item < 768; item += F.G) {
        const int kind = item >> 8, idx = item & 255, type = idx >> 7, r = idx & 127;
        int h, seq, c = -1;
        if (kind == 0) { seq = 32 + (r >> 6); h = (r >> 4) & 3; c = r & 15; } else { seq = r >> 2; h = r & 3; }
        MixSrc X; mix_src(X, a, type, h);
        if (SPIN_PHASE >= 16 && blockIdx.x == SPIN_BLOCK && F.tid == 0) F.MISC[48 + kind] = (unsigned)__builtin_amdgcn_s_memrealtime();
        if (kind == 1) { for (int q = 0; q < 2; ++q) mix_attn_item(F, a, X, type, seq, h, q, false); }
        else mix_state_item(F, a, X, type, seq, h, c);
    }
    __syncthreads();
    if (SPIN_PHASE >= 16 && blockIdx.x == SPIN_BLOCK && F.tid == 0) F.MISC[51] = (unsigned)__builtin_amdgcn_s_memrealtime();
}
__device__ __forceinline__ void p5_scan(Frame& F, const Args& a) {
    unsigned char* ws = a.ws;
    const int NG = ST_ELEMS / 4;
    for (int g = blockIdx.x * (NWAVES * 64) + F.tid; g < 32 * NG; g += F.G * NWAVES * 64) {
        const int chain = g / NG, e4 = g - chain * NG, dir = chain & 1, tbh = chain >> 1, h = tbh & 3, b = (tbh >> 2) & 1, type = tbh >> 3;
        const int sbq = NP + b * TS;
        const float* cu = (const float*)(ws + WS_GCUM) + (size_t)(dir * 4 + h) * M;
        const float lg = logsigf(a.in[14][dir * 4 + h]);
        f32x4 S;
        if (e4 < 128 * 32) { S = *(const f32x4*)((type == 0 ? a.in[2] : a.in[3]) + (size_t)((b * 2 + dir) * 4 + h) * 16384 + e4 * 4); }
        else if (type == 1) S = *(const f32x4*)(a.in[4] + (size_t)((b * 2 + dir) * 4 + h) * 128 + (e4 - 128 * 32) * 4);
        else S = (f32x4){0.f, 0.f, 0.f, 0.f};
        if (type == 1) S = S * __expf(a.in[5][(b * 2 + dir) * 4 + h]);
        const float* L = (const float*)(ws + WS_LOC) + (size_t)(tbh * 16) * 2 * ST_ELEMS + (size_t)dir * ST_ELEMS + e4 * 4;
        bf16_t* O = (bf16_t*)(ws + WS_SST) + (size_t)(tbh * 16) * 2 * ST_ELEMS + (size_t)dir * ST_ELEMS + e4 * 4;
#pragma unroll 4
        for (int i = 0; i < 16; ++i) {
            const int c = dir == 0 ? i : 15 - i;
            *(unsigned long long*)(O + (size_t)c * 2 * ST_ELEMS) = (unsigned long long)cvtpk(S[0], S[1]) | ((unsigned long long)cvtpk(S[2], S[3]) << 32);
            float dec;
            if (type == 1) dec = dir == 0 ? __expf(cu[sbq + 128 * c + 127] - (c > 0 ? cu[sbq + 128 * c - 1] : 0.f)) : __expf(cu[sbq + 128 * c] - (c < 15 ? cu[sbq + 128 * c + 128] : 0.f));
            else dec = __expf(lg * 128.f);
            S = S * dec + *(const f32x4*)(L + (size_t)c * 2 * ST_ELEMS);
        }
    }
}
__device__ __forceinline__ void p6_mixer_c(Frame& F, const Args& a) {
    for (int item = F.vcu; item < 256; item += F.G) {
        const int type = item >> 7, r = item & 127, seq = 32 + (r >> 6), h = (r >> 4) & 3, qt = r & 15;
        MixSrc X; mix_src(X, a, type, h);
        mix_attn_item(F, a, X, type, seq, h, qt, true);
    }
    __syncthreads();
}

__device__ __forceinline__ void p6_norm2(Frame& F, const Args& a) {
    const int gw = F.vcu * NWAVES + F.wave, NGW = F.G * NWAVES, lane = F.lane;
    const float* mod = (const float*)(a.ws + WS_MOD);
    for (int m = gw; m < M; m += NGW) {
        const int cnd = cond_of(m);
        const f32x4* xr = (const f32x4*)(a.out + O_Y + (size_t)m * D) + lane;
        f32x4 v[4]; float ss = 0.f;
#pragma unroll
        for (int j = 0; j < 4; ++j) { v[j] = xr[64 * j]; ss += (v[j].x * v[j].x + v[j].y * v[j].y) + (v[j].z * v[j].z + v[j].w * v[j].w); }
        const float rstd = rsqrtf(wave_sum(ss) * (1.f / D) + EPS);
        unsigned long long* o8 = (unsigned long long*)((bf16_t*)(a.ws + WS_H) + (size_t)m * D) + lane;
#pragma unroll
        for (int j = 0; j < 4; ++j) { const int k = 4 * (lane + 64 * j);
            const f32x4 g = *(const f32x4*)(a.in[11] + k), sc = *(const f32x4*)(mod + cnd * 6144 + 4096 + k), sh = *(const f32x4*)(mod + cnd * 6144 + 3072 + k);
            const f32x4 hh_ = v[j] * rstd * g * (sc + 1.f) + sh;
            o8[64 * j] = (unsigned long long)cvtpk(hh_.x, hh_.y) | ((unsigned long long)cvtpk(hh_.z, hh_.w) << 32); }
    }
}
__device__ __forceinline__ void p9_final(Frame& F, const Args& a) {
    const int gw = F.vcu * NWAVES + F.wave, NGW = F.G * NWAVES, lane = F.lane;
    for (int m = gw; m < M; m += NGW) {
        const f32x4* xr = (const f32x4*)((const float*)(a.ws + WS_X2) + (size_t)m * D) + lane;
        f32x4* yr = (f32x4*)(a.out + O_Y + (size_t)m * D) + lane;
        f32x4 v[4]; float ss = 0.f;
#pragma unroll
        for (int j = 0; j < 4; ++j) { v[j] = xr[64 * j]; ss += (v[j].x * v[j].x + v[j].y * v[j].y) + (v[j].z * v[j].z + v[j].w * v[j].w); }
        const float rstd = rsqrtf(wave_sum(ss) * (1.f / D) + EPS);
#pragma unroll
        for (int j = 0; j < 4; ++j) yr[64 * j] = v[j] * rstd * *(const f32x4*)(a.in[21] + 4 * (lane + 64 * j));
    }
}

__global__ void __launch_bounds__(NWAVES * 64, 2) mega(Args args) {
    extern __shared__ __attribute__((aligned(16))) unsigned char lds[];
    Frame F;
    F.lds = (LAS unsigned char*)lds;
    F.MISC = (volatile LAS unsigned*)(F.lds + MISC_OFF);
    F.tid = threadIdx.x; F.lane = F.tid & 63; F.wave = __builtin_amdgcn_readfirstlane(F.tid >> 6);
    F.G = gridDim.x; { const int bx = blockIdx.x; F.vcu = (F.G % 8 == 0) ? (bx % 8) * (F.G / 8) + bx / 8 : bx; }
    unsigned char* ws = args.ws;
    F.ctl = (gu32*)(ws + WS_CTL);
    for (int u = F.tid; u < (LDS_BYTES - LDSCTL_OFF) / 4; u += NWAVES * 64) ((LAS unsigned*)(F.lds + LDSCTL_OFF))[u] = 0u;
    __syncthreads();
    XcdBarrier bar = xcd_barrier_post((unsigned*)(F.ctl + CW_BAR) + args.li * XCD_BAR_WORDS, F.MISC + 8);
    const int lo = args.ph_lo, hi = args.ph_hi;
#define IN(k) (lo <= (k) && (k) < hi)
#define STAMP(k) do { if (SPIN_PHASE >= 0 && blockIdx.x == SPIN_BLOCK && F.tid == 0) F.MISC[32 + (k)] = (unsigned)__builtin_amdgcn_s_memrealtime(); } while (0)
#define BOTH(k) (IN(k) && IN((k) + 1))
    STAMP(0);
    if (IN(0)) { p0_prologue(F, args); if (BOTH(0)) xcd_barrier(bar); }
    STAMP(1);
    if (IN(1)) { p1_norm_gates(F, args); if (BOTH(1)) xcd_barrier(bar); }
    STAMP(2);
    if (IN(2)) {
        pg8::Gemm g{(const bf16_t*)(ws + WS_H), (const bf16_t*)(ws + WS_WIN), M, 4096, D}; pg8::StaticOrder S; S.init(M, 4096, F.G, (int)blockIdx.x);
        pg8::EpiProj E{ws, (const float*)(ws + WS_ROPE)};
        pg8::gemm_phase<pg8::EpiProj, pg8::StaticOrder, true, true>(F.lds + RING_OFF, g, S, E);
        if (BOTH(2)) xcd_barrier(bar);
    }
    STAMP(3);
    if (IN(3)) { p3_conv_cumsum(F, args); if (BOTH(3)) xcd_barrier(bar); }
    STAMP(4);
    if (IN(4)) { p4_mixer_a(F, args); if (BOTH(4)) xcd_barrier(bar); }
    STAMP(5);
    if (IN(5)) { p5_scan(F, args); transpose_items(F, args, TI_O, TI_2); if (BOTH(5)) xcd_barrier(bar); }
    STAMP(6);
    if (IN(6)) { p6_mixer_c(F, args); if (BOTH(6)) xcd_barrier(bar); }
    STAMP(7);
    if (IN(7)) {
        pg8::Gemm g{(const bf16_t*)(ws + WS_MIX), (const bf16_t*)(ws + WS_WOUT), M, D, D}; pg8::StaticOrder S; S.init(M, D, F.G, (int)blockIdx.x);
        pg8::EpiRes E{args.in[0], args.in[1], args.out + O_Y, (const float*)(ws + WS_MOD) + 2048};
        pg8::gemm_phase<pg8::EpiRes, pg8::StaticOrder, true, true>(F.lds + RING_OFF, g, S, E);
        if (BOTH(7)) xcd_barrier(bar);
    }
    STAMP(8);
    if (IN(8)) { p6_norm2(F, args); if (BOTH(8)) xcd_barrier(bar); }
    STAMP(9);
    if (IN(9)) {
        pg8::Gemm g{(const bf16_t*)(ws + WS_H), (const bf16_t*)(ws + WS_W1), M, FF, D}; pg8::StaticOrder S; S.init(M, FF, F.G, (int)blockIdx.x);
        pg8::EpiRelu2 E{(bf16_t*)(ws + WS_U)};
        pg8::gemm_phase<pg8::EpiRelu2, pg8::StaticOrder, true, true>(F.lds + RING_OFF, g, S, E);
        if (BOTH(9)) xcd_barrier(bar);
    }
    STAMP(10);
    if (IN(10)) {
        pg8::Gemm g{(const bf16_t*)(ws + WS_U), (const bf16_t*)(ws + WS_W2), M, D, FF}; pg8::StaticOrder S; S.init(M, D, F.G, (int)blockIdx.x);
        pg8::EpiRes E{args.out + O_Y, args.out + O_Y + (size_t)NP * D, (float*)(ws + WS_X2), (const float*)(ws + WS_MOD) + 5120};
        pg8::gemm_phase<pg8::EpiRes, pg8::StaticOrder, true, true>(F.lds + RING_OFF, g, S, E);
        if (BOTH(10)) xcd_barrier(bar);
    }
    STAMP(11);
    if (IN(11)) { p9_final(F, args); }
    STAMP(12);
    if (SPIN_PHASE >= 0 && blockIdx.x == SPIN_BLOCK && F.tid == 0) {
        const unsigned dt = F.MISC[32 + SPIN_PHASE + 1] - F.MISC[32 + SPIN_PHASE];
        const unsigned long long t0 = __builtin_amdgcn_s_memrealtime();
        while (__builtin_amdgcn_s_memrealtime() - t0 < (unsigned long long)dt) __builtin_amdgcn_s_sleep(4);
    }
#undef IN
#undef BOTH
}

extern "C" void kernel_launch(void* const* d_in, const int* in_sizes, int n_in, void* d_out, int out_size, void* d_ws, size_t ws_size, hipStream_t stream) {
    static int grid = 0;
    if (grid == 0) {
        if (n_in != 22 || ws_size < WS_END) { fprintf(stderr, "kernel_launch: unexpected n_in %d / ws_size %zu\n", n_in, ws_size); grid = -1; return; }
        int dev = 0, cus = 0, per_cu = 0;
        if (hipGetDevice(&dev) != hipSuccess || hipDeviceGetAttribute(&cus, hipDeviceAttributeMultiprocessorCount, dev) != hipSuccess) { grid = -1; return; }
        if (hipFuncSetAttribute((const void*)mega, hipFuncAttributeMaxDynamicSharedMemorySize, LDS_BYTES) != hipSuccess) { fprintf(stderr, "kernel_launch: hipFuncSetAttribute failed\n"); grid = -1; return; }
        if (hipOccupancyMaxActiveBlocksPerMultiprocessor(&per_cu, (const void*)mega, NWAVES * 64, LDS_BYTES) != hipSuccess || per_cu < 1) fprintf(stderr, "kernel_launch: occupancy query says %d\n", per_cu);
        (void)hipGetLastError();
        grid = cus;
    }
    if (grid < 0) return;
    P p{};
    p.xp = (const float*)d_in[0]; p.xs = (const float*)d_in[1]; p.st_ret = (const float*)d_in[2]; p.st_C = (const float*)d_in[3];
    p.st_n = (const float*)d_in[4]; p.st_m = (const float*)d_in[5]; p.c = (const float*)d_in[6]; p.cctx = (const float*)d_in[7];
    p.w_ada = (const float*)d_in[8]; p.b_ada = (const float*)d_in[9]; p.n1g = (const float*)d_in[10]; p.n2g = (const float*)d_in[11];
    p.w_in = (const float*)d_in[12]; p.conv_w = (const float*)d_in[13]; p.decay = (const float*)d_in[14]; p.gbias = (const float*)d_in[15];
    p.rgn = (const float*)d_in[16]; p.mgn = (const float*)d_in[17]; p.w_out = (const float*)d_in[18]; p.w_ff1 = (const float*)d_in[19];
    p.w_ff2 = (const float*)d_in[20]; p.fg = (const float*)d_in[21];
    p.out = (float*)d_out; p.ws = (unsigned char*)d_ws;
    (void)hipMemsetAsync((char*)d_ws + WS_CTL, 0, CTL_ZERO_BYTES, stream);
    Args a{};
    for (int i = 0; i < 22; ++i) a.in[i] = (const float*)d_in[i];
    a.out = (float*)d_out; a.ws = (unsigned char*)d_ws;
    int li = 0;
#define MEGA(lo_, hi_) do { a.ph_lo = (lo_); a.ph_hi = (hi_); a.li = li++; hipLaunchKernelGGL(mega, dim3(grid), dim3(NWAVES * 64), LDS_BYTES, stream, a); } while (0)
#ifndef MIX_NAIVE
#define MIX_NAIVE 0
#endif
#if MIX_NAIVE
    MEGA(0, 4);
    k_mix<<<dim3(M / 16, 4, 2), 256, 0, stream>>>(p);
    k_states<<<dim3(32, 4, 4), 256, 0, stream>>>(p);
    MEGA(5, 10);
#else
    MEGA(0, 12);
#endif
}
```
